# Optimizing an MI355X kernel written in HIP

```python
import jax, jax.numpy as jnp
from jax import lax
import numpy as np

D_MODEL = 1024
BATCH = 16
SEQ = 2048
DEPTH = 1

CHUNK = 64

N_HEADS_A = 16
HEAD_A = D_MODEL // N_HEADS_A
WIDTH_A = N_HEADS_A * HEAD_A
D_DECAY_LORA = 64
D_AAA_LORA = 64
D_GATE_LORA = 160
GN_EPS = 64e-5
SPLITS_A = (WIDTH_A, WIDTH_A, WIDTH_A, D_DECAY_LORA, D_AAA_LORA, D_GATE_LORA)
COLS_A = sum(SPLITS_A)

GMLP_CHUNK = 2 * CHUNK
N_GROUPS_B = 8
GROUP_B = 128
WIDTH_B = N_GROUPS_B * GROUP_B
LN_EPS = 1e-5

N_BRANCHES = 2
IN_COLS = COLS_A + 2 * WIDTH_B + N_BRANCHES * D_MODEL

N_EXPERTS = 32
TOP_K = 4
D_FF_EXPERT = D_MODEL
SWIGLU_LIMIT = 7.0
SWIGLU_ALPHA = 1.702
MOE_BLOCK = 128

RMS_EPS = 1e-5

kernel_name = "hybrid_rwkv7_gmlp_gated_moe_block"


def rms_norm(x, g):
    xf = x.astype(jnp.float32)
    y = xf * lax.rsqrt(jnp.mean(xf * xf, axis=-1, keepdims=True) + RMS_EPS)
    return (y * g.astype(jnp.float32)).astype(x.dtype)


def token_shift(z):
    return jnp.pad(z[:, :-1], ((0, 0), (1, 0), (0, 0)))


def rwkv7_time_mix(z, time_mix, w_decay_up, w0, a_up, a0, g_up, k_k, k_a, r_k, gn_w, gn_b):
    B, S, _ = z.shape
    f32 = jnp.float32
    H, N = N_HEADS_A, HEAD_A
    z = z + (token_shift(z) - z) * time_mix
    idx = [int(i) for i in np.cumsum(SPLITS_A)[:-1]]
    r, k, v, zw, za, zg = jnp.split(z, idx, axis=-1)
    w_log = -jax.nn.softplus(-(w0 + jnp.tanh(zw) @ w_decay_up).astype(f32)) - 0.5
    decay = jnp.exp(-jnp.exp(w_log))
    a = jax.nn.sigmoid((a0 + za @ a_up).astype(f32))
    g = jax.nn.sigmoid(zg) @ g_up

    def heads(t):
        return t.astype(f32).reshape(B, S, H, N)

    r, k, v, decay, a = heads(r), heads(k), heads(v), heads(decay), heads(a)
    kk = k * k_k.astype(f32).reshape(H, N)
    kk = kk / jnp.maximum(jnp.sqrt(jnp.sum(kk * kk, axis=-1, keepdims=True)), 1e-12)
    k = k * (1.0 + (a - 1.0) * k_a.astype(f32).reshape(H, N))

    def step(state, inp):
        r_t, k_t, v_t, w_t, kk_t, a_t = inp
        sa = jnp.einsum('bhij,bhj->bhi', state, -kk_t)
        state = (state * w_t[:, :, None, :]
                 + sa[..., None] * (kk_t * a_t)[:, :, None, :]
                 + v_t[..., None] * k_t[:, :, None, :])
        y_t = jnp.einsum('bhij,bhj->bhi', state, r_t)
        return state, y_t

    xs = tuple(jnp.moveaxis(t, 1, 0) for t in (r, k, v, decay, kk, a))
    _, y = lax.scan(step, jnp.zeros((B, H, N, N), f32), xs)
    y = jnp.moveaxis(y, 0, 1)
    mean = jnp.mean(y, axis=-1, keepdims=True)
    var = jnp.mean(jnp.square(y - mean), axis=-1, keepdims=True)
    y = ((y - mean) * lax.rsqrt(var + GN_EPS) * gn_w.astype(f32).reshape(H, N)
         + gn_b.astype(f32).reshape(H, N))
    y = y + jnp.sum(r * k * r_k.astype(f32).reshape(H, N), axis=-1, keepdims=True) * v
    y = y.reshape(B, S, WIDTH_A) * g.astype(f32)
    return y.astype(z.dtype)


def gmlp_spatial_gate(u_raw, v_raw, ln_v_g, ln_v_b, w_spatial, b_spatial):
    B, S, _ = u_raw.shape
    f32 = jnp.float32
    u = jax.nn.gelu(u_raw.astype(f32), approximate=False)
    vf = jax.nn.gelu(v_raw.astype(f32), approximate=False)
    mean = jnp.mean(vf, axis=-1, keepdims=True)
    var = jnp.mean(jnp.square(vf - mean), axis=-1, keepdims=True)
    vn = (vf - mean) * lax.rsqrt(var + LN_EPS) * ln_v_g.astype(f32) + ln_v_b.astype(f32)
    vc = vn.reshape(B, S // GMLP_CHUNK, GMLP_CHUNK, N_GROUPS_B, GROUP_B)
    mask = jnp.tril(jnp.ones((GMLP_CHUNK, GMLP_CHUNK), dtype=bool))
    ws = jnp.where(mask[None], w_spatial.astype(f32), 0.0)
    s = jnp.einsum('gij,bcjgd->bcigd', ws, vc) + b_spatial.astype(f32).T[:, :, None]
    return (u * s.reshape(B, S, WIDTH_B)).astype(u_raw.dtype)


def moe_ffn(h, w_router, b_router, w_gate_up, b_gate_up, w_down, b_down):
    B, S, D = h.shape
    T = B * S
    n_assign = T * TOP_K
    n_blocks = n_assign // MOE_BLOCK + N_EXPERTS
    xt = h.reshape(T, D)
    logits = (xt @ w_router + b_router).astype(jnp.float32)
    top_v, top_i = lax.top_k(logits, TOP_K)
    gates = jax.nn.softmax(top_v, axis=-1)
    flat_e = top_i.reshape(-1).astype(jnp.int32)
    flat_tok = jnp.arange(n_assign, dtype=jnp.int32) // TOP_K
    order = jnp.argsort(flat_e, stable=True)
    sorted_e = flat_e[order]
    counts = jnp.bincount(flat_e, length=N_EXPERTS).astype(jnp.int32)
    padded = (counts + MOE_BLOCK - 1) // MOE_BLOCK * MOE_BLOCK
    pad_end = jnp.cumsum(padded)
    pad_start = pad_end - padded
    grp_start = jnp.cumsum(counts) - counts
    dest = pad_start[sorted_e] + jnp.arange(n_assign, dtype=jnp.int32) - grp_start[sorted_e]
    slot_tok = jnp.zeros((n_blocks * MOE_BLOCK,), jnp.int32).at[dest].set(flat_tok[order])
    block_start = jnp.arange(n_blocks, dtype=jnp.int32) * MOE_BLOCK
    block_expert = jnp.minimum(jnp.searchsorted(pad_end, block_start, side='right'),
                               N_EXPERTS - 1).astype(jnp.int32)

    def expert_block(args):
        tok, e = args
        hgu = xt[tok] @ w_gate_up[e] + b_gate_up[e]
        gate = jnp.minimum(hgu[:, 0::2], SWIGLU_LIMIT)
        up = jnp.clip(hgu[:, 1::2], -SWIGLU_LIMIT, SWIGLU_LIMIT)
        act = gate * jax.nn.sigmoid(SWIGLU_ALPHA * gate) * (up + 1.0)
        return act @ w_down[e] + b_down[e]

    y_slots = lax.map(expert_block, (slot_tok.reshape(n_blocks, MOE_BLOCK), block_expert))
    y_slots = y_slots.reshape(n_blocks * MOE_BLOCK, D)
    slot_of_assign = jnp.zeros((n_assign,), jnp.int32).at[order].set(dest)
    y_sel = y_slots[slot_of_assign].reshape(T, TOP_K, D)
    out = jnp.einsum('tk,tkd->td', gates.astype(h.dtype), y_sel)
    return out.reshape(B, S, D)


def setup_inputs(seed: int = 0) -> dict:
    key = jax.random.key(seed)
    ks = jax.random.split(key, 32)
    L, D = DEPTH, D_MODEL
    f32 = jnp.float32

    def nrm(k, shape, scale):
        return jax.random.normal(k, shape, f32) * scale

    return {
        "x": jax.random.normal(ks[0], (BATCH, SEQ, D), f32),
        "norm1_g": 1.0 + nrm(ks[1], (L, D), 0.05),
        "w_in": nrm(ks[2], (L, D, IN_COLS), D ** -0.5),
        "b_gate": nrm(ks[3], (L, N_BRANCHES * D), 0.1),
        "time_mix": jax.random.uniform(ks[4], (L, COLS_A), f32),
        "w_decay_up": nrm(ks[5], (L, D_DECAY_LORA, WIDTH_A), D_DECAY_LORA ** -0.5),
        "w0": jax.random.uniform(ks[6], (L, WIDTH_A), f32, minval=-5.0, maxval=-1.0),
        "a_up": nrm(ks[7], (L, D_AAA_LORA, WIDTH_A), D_AAA_LORA ** -0.5),
        "a0": nrm(ks[8], (L, WIDTH_A), 0.1),
        "g_up": nrm(ks[9], (L, D_GATE_LORA, WIDTH_A), D_GATE_LORA ** -0.5),
        "k_k": 0.85 + nrm(ks[10], (L, WIDTH_A), 0.05),
        "k_a": 1.0 + nrm(ks[11], (L, WIDTH_A), 0.05),
        "r_k": nrm(ks[12], (L, WIDTH_A), 0.1),
        "gn_w": 1.0 + nrm(ks[13], (L, WIDTH_A), 0.05),
        "gn_b": nrm(ks[14], (L, WIDTH_A), 0.02),
        "ln_v_g": 1.0 + nrm(ks[15], (L, WIDTH_B), 0.05),
        "ln_v_b": nrm(ks[16], (L, WIDTH_B), 0.02),
        "w_spatial": nrm(ks[17], (L, N_GROUPS_B, GMLP_CHUNK, GMLP_CHUNK), GMLP_CHUNK ** -0.5),
        "b_spatial": 1.0 + nrm(ks[18], (L, N_GROUPS_B, GMLP_CHUNK), 0.1),
        "w_out": nrm(ks[19], (L, D, D), D ** -0.5),
        "norm2_g": 1.0 + nrm(ks[20], (L, D), 0.05),
        "w_router": nrm(ks[21], (L, D, N_EXPERTS), D ** -0.5),
        "b_router": nrm(ks[22], (L, N_EXPERTS), 0.01),
        "w_gate_up": nrm(ks[23], (L, N_EXPERTS, D, 2 * D_FF_EXPERT), D ** -0.5),
        "b_gate_up": nrm(ks[24], (L, N_EXPERTS, 2 * D_FF_EXPERT), 0.02),
        "w_down": nrm(ks[25], (L, N_EXPERTS, D_FF_EXPERT, D), D_FF_EXPERT ** -0.5),
        "b_down": nrm(ks[26], (L, N_EXPERTS, D), 0.02),
        "norm_f_g": 1.0 + nrm(ks[27], (D,), 0.05),
    }


def reference(x, norm1_g, w_in, b_gate, time_mix, w_decay_up, w0, a_up, a0, g_up, k_k, k_a, r_k,
              gn_w, gn_b, ln_v_g, ln_v_b, w_spatial, b_spatial, w_out, norm2_g, w_router, b_router,
              w_gate_up, b_gate_up, w_down, b_down, norm_f_g):
    for l in range(DEPTH):
        h = rms_norm(x, norm1_g[l])
        z = h @ w_in[l]
        z_a, u_raw, v_raw, gate_logits = jnp.split(
            z, [COLS_A, COLS_A + WIDTH_B, COLS_A + 2 * WIDTH_B], axis=-1)
        y_a = rwkv7_time_mix(z_a, time_mix[l], w_decay_up[l], w0[l], a_up[l], a0[l], g_up[l],
                             k_k[l], k_a[l], r_k[l], gn_w[l], gn_b[l])
        y_b = gmlp_spatial_gate(u_raw, v_raw, ln_v_g[l], ln_v_b[l], w_spatial[l], b_spatial[l])
        gates = jax.nn.sigmoid(gate_logits + b_gate[l])
        g_a, g_b = jnp.split(gates, N_BRANCHES, axis=-1)
        x = x + (g_a * y_a + g_b * y_b) @ w_out[l]
        x = x + moe_ffn(rms_norm(x, norm2_g[l]), w_router[l], b_router[l], w_gate_up[l],
                        b_gate_up[l], w_down[l], b_down[l])
    return rms_norm(x, norm_f_g)
```

```cpp
#include <hip/hip_runtime.h>
#include <cstdio>
#include <cstdint>

#ifndef MK_N_LAUNCHES
#define MK_N_LAUNCHES 1
#endif

#ifndef PROBE_REP
#define PROBE_REP -1
#endif
#define GAS __attribute__((address_space(1)))
#define LAS __attribute__((address_space(3)))
typedef unsigned short bf16_t;
typedef short bf16x8 __attribute__((ext_vector_type(8)));
typedef float f32x4 __attribute__((ext_vector_type(4)));
typedef float f32x2 __attribute__((ext_vector_type(2)));
typedef unsigned u32x4 __attribute__((ext_vector_type(4)));
typedef unsigned u32x2 __attribute__((ext_vector_type(2)));

constexpr int NB_ = 16, SEQ = 2048, D = 1024, T = NB_ * SEQ;
constexpr int NH = 16, HD = 64;
constexpr int NZ = 7680;
constexpr int ZC_R = 0, ZC_K = 1024, ZC_V = 2048, ZC_L = 3072, ZC_U = 3584, ZC_VG = 4608, ZC_GA = 5632, ZC_GB = 6656;
constexpr int TM_R = 0, TM_K = 1024, TM_V = 2048, TM_DL = 3072, TM_AL = 3136, TM_GL = 3200;
constexpr int NE = 32, TOPK = 4, FF = 1024;
constexpr int NSLOT_MAX = T * TOPK + NE * 256;
constexpr float RMS_EPS = 1e-5f, GN_EPS = 64e-5f, LN_EPS = 1e-5f;

constexpr size_t MiB = 1u << 20;
constexpr size_t WS_CTL = 0, CTL_ZERO_BYTES = 1 * MiB;
constexpr size_t WS_BIN = 2 * MiB;
constexpr size_t WS_BOUT = 18 * MiB;
constexpr size_t WS_BGU = 20 * MiB;
constexpr size_t WS_BD = 148 * MiB;
constexpr size_t WS_MISC = 212 * MiB;
constexpr size_t WS_TOK = 216 * MiB;
constexpr size_t WS_H = 220 * MiB;
constexpr size_t WS_Z = 284 * MiB;
constexpr size_t WS_M = 764 * MiB;
constexpr size_t WS_M2 = 828 * MiB;
constexpr size_t WS_H2 = 892 * MiB;
constexpr size_t WS_END = 956 * MiB;
constexpr size_t WS_ACT = WS_Z;
constexpr size_t WS_YS = WS_Z + 272 * MiB;
static_assert((size_t)NSLOT_MAX * FF * 2 == 272 * MiB && WS_YS + 272 * MiB == WS_M2, "ws map");
constexpr size_t MO_BIASZ = 0;
constexpr size_t MO_BGU = 64 * 1024;
constexpr size_t MO_WRT = 512 * 1024;
constexpr size_t MO_ASG = 1 * MiB;
constexpr size_t MO_GATE = 2 * MiB;
constexpr int CW_TMO = 0, CW_CODE = 1;
constexpr int CW_BAR = 4096;
constexpr int CW_CNT = 8192;

constexpr int RING_OFF = 0, RING_BYTES = 131072;
constexpr int LDSCTL_OFF = RING_BYTES, MISC_OFF = LDSCTL_OFF + 320;
constexpr int SCHED_OFF = LDSCTL_OFF + 1024;
constexpr int LDS_BYTES = 147456;
constexpr int NWAVES = 8;

#define RLX_AGENT __ATOMIC_RELAXED, __HIP_MEMORY_SCOPE_AGENT
#define LDS_WAIT() asm volatile("s_waitcnt lgkmcnt(0)" ::: "memory")
#define VM_WAIT() asm volatile("s_waitcnt vmcnt(0)" ::: "memory")
__device__ __forceinline__ unsigned cvt_pk_bf16(float lo, float hi) { unsigned r; asm volatile("v_cvt_pk_bf16_f32 %0, %1, %2" : "=v"(r) : "v"(lo), "v"(hi)); return r; }
__device__ __forceinline__ float bf_lo(unsigned u) { return __builtin_bit_cast(float, u << 16); }
__device__ __forceinline__ float bf_hi(unsigned u) { return __builtin_bit_cast(float, u & 0xffff0000u); }
__device__ __forceinline__ float bf2f(bf16_t b) { return __builtin_bit_cast(float, ((unsigned)b) << 16); }
template <int CTRL> __device__ __forceinline__ float dpp(float x) { return __builtin_bit_cast(float, __builtin_amdgcn_mov_dpp(__builtin_bit_cast(int, x), CTRL, 0xf, 0xf, true)); }
__device__ __forceinline__ float allsum16(float x) {
    x += dpp<0xB1>(x); x += dpp<0x4E>(x); x += dpp<0x141>(x); x += dpp<0x140>(x); return x;
}
__device__ __forceinline__ float wave_sum(float v) {
#pragma unroll
    for (int o = 1; o < 64; o <<= 1) v += __shfl_xor(v, o);
    return v;
}
__device__ __forceinline__ float sigmoidf_(float x) { return __builtin_amdgcn_rcpf(1.0f + __expf(-x)); }
__device__ __forceinline__ f32x2 gelu_pk(f32x2 v) {
    const f32x2 av = __builtin_elementwise_abs(v), d = av * 0.2316418882f + 1.0f;
    f32x2 t; t.x = __builtin_amdgcn_rcpf(d.x); t.y = __builtin_amdgcn_rcpf(d.y);
    f32x2 q = t * 0.5307027145f + (-0.7265760135f); q = q * t + 0.7107068705f; q = q * t + (-0.142248368f); q = q * t + 0.127414796f; q = q * t;
    const f32x2 s = (v * v) * (-0.72134752044f);
    f32x2 e; e.x = __builtin_amdgcn_exp2f(s.x); e.y = __builtin_amdgcn_exp2f(s.y);
    const f32x2 m = v * (q * e), r = v - m;
    f32x2 o; o.x = v.x < 0.f ? m.x : r.x; o.y = v.y < 0.f ? m.y : r.y; return o;
}

namespace pg8 {
constexpr int BM = 256, BK = 64, HALF = 128, HTB = HALF * BK * 2, STAGE_BYTES = 8 * HTB, NXCD = 8, WGM = 8;
constexpr int KK = 1024;
__host__ __device__ __forceinline__ int lds_byte(int r, int c) { const int st = (r >> 4) * 2 + (c >> 5), rr = r & 15, cc = c & 31, ob = rr * 64 + cc * 2; return st * 1024 + (ob ^ (((ob >> 9) & 1) << 5)); }
__host__ __device__ __forceinline__ void stage_rc(int b, int& R, int& C) { const int st = b / 1024, sb = b % 1024, swz = sb ^ (((sb >> 9) & 1) << 5); R = (st >> 1) * 16 + swz / 64; C = (st & 1) * 32 + (swz % 64) / 2; }
__host__ __device__ __forceinline__ int perm32(int rho) { const int n = rho >> 4, i = rho & 15; return 8 * (i >> 2) + 4 * n + (i & 3); }

struct Unit { const char* A; const char* B; int r0, c0, e, aux; };

struct StaticOrder {
    const char* A; const char* B; int nM, nN, nwg, G, c;
    static constexpr bool GATHER = false;
    __device__ void init(const void* A_, const void* B_, int M, int N, int G_, int c_) { A = (const char*)A_; B = (const char*)B_; nM = M / BM; nN = N / BM; nwg = nM * nN; G = G_; c = c_; }
    __device__ bool next(int i, Unit& u) const {
        const long L = (long)i * G + c; if (L >= nwg) return false;
        int wgid = (int)L; { const int q = nwg / NXCD, r = nwg % NXCD, xcd = wgid % NXCD, off = wgid / NXCD; wgid = (xcd < r ? xcd * (q + 1) : r * (q + 1) + (xcd - r) * q) + off; }
        const int nig = WGM * nN, gid = wgid / nig, fm = gid * WGM, gsz = (nM - fm) < WGM ? (nM - fm) : WGM;
        const int pm = fm + ((wgid % nig) % gsz), pn = (wgid % nig) / gsz;
        u.A = A + (size_t)pm * (BM * KK * 2); u.B = B + (size_t)pn * (BM * KK * 2); u.r0 = pm * BM; u.c0 = pn * BM; u.e = 0; u.aux = 0; return true;
    }
    __device__ __forceinline__ void a_offs(const Unit&, unsigned (&ga)[2][2], const int (&R)[2], const int (&C)[2]) const {
#pragma unroll
        for (int h = 0; h < 2; ++h)
#pragma unroll
            for (int i = 0; i < 2; ++i) ga[h][i] = (unsigned)((h * HALF + R[i]) * KK + C[i]) * 2u;
    }
};

template <class Epi, class Sched, bool ALIGN_EPI = false>
__device__ __forceinline__ void gemm_phase(LAS unsigned char* lds, const Sched& S, const Epi& E) {
    const int tid = threadIdx.x, wid = __builtin_amdgcn_readfirstlane(tid >> 6), lane = tid & 63, wr = wid >> 2, wc = wid & 3, fr = lane & 15, fq = lane >> 4;
    constexpr int K = KK, nt = K / BK;
    unsigned voffB[2]; int Rr[2], Cc[2];
#pragma unroll
    for (int i = 0; i < 2; ++i) { int R, C; stage_rc(tid * 16 + i * 8192, R, C); const int Rb = Epi::PERM ? ((R & ~31) + perm32(R & 31)) : R;
        Rr[i] = R; Cc[i] = C; voffB[i] = (unsigned)(Rb * K + C) * 2u; }
    const size_t kstep = (size_t)(BK * 2);
    const size_t hstep = (size_t)HALF * K * 2;
    const unsigned ldsw = (unsigned)wid * 1024u;
    const int aoff = lds_byte(wr * 64 + fr, fq * 8), boff = lds_byte(wc * 32 + fr, fq * 8);
#define PG8_SA(b, h) (((b) * 2 + (h)) * HTB)
#define PG8_SB(b, h) ((4 + (b) * 2 + (h)) * HTB)
#define PG8_STAGE(bufoff, gbase, voff) do { _Pragma("unroll") for (int _i = 0; _i < 2; ++_i) \
        __builtin_amdgcn_global_load_lds((const unsigned*)((const char*)(gbase) + (voff)[_i]), (LAS unsigned*)(lds + (bufoff) + ldsw + _i * 8192), 16, 0, 0); } while (0)
#define PG8_LDA(dst, b, h) do { _Pragma("unroll") for (int m = 0; m < 4; ++m) _Pragma("unroll") for (int k = 0; k < 2; ++k) dst[m][k] = *(const LAS bf16x8*)(lds + PG8_SA(b, h) + aoff + m * 2048 + k * 1024); } while (0)
#define PG8_LDB(dst, b, h) do { _Pragma("unroll") for (int n = 0; n < 2; ++n) _Pragma("unroll") for (int k = 0; k < 2; ++k) dst[n][k] = *(const LAS bf16x8*)(lds + PG8_SB(b, h) + boff + n * 2048 + k * 1024); } while (0)
#define PG8_MMA(ai, bj, At, Bt) do { __builtin_amdgcn_s_setprio(1); _Pragma("unroll") for (int m = 0; m < 4; ++m) _Pragma("unroll") for (int n = 0; n < 2; ++n) _Pragma("unroll") for (int k = 0; k < 2; ++k) \
        acc[ai][bj][m][n] = __builtin_amdgcn_mfma_f32_16x16x32_bf16(Bt[n][k], At[m][k], acc[ai][bj][m][n], 0, 0, 0); __builtin_amdgcn_s_setprio(0); } while (0)
#define PG8_WAIT_V(n) asm volatile("s_waitcnt vmcnt(" #n ")" ::: "memory")
#define PG8_WAIT_L(n) asm volatile("s_waitcnt lgkmcnt(" #n ")" ::: "memory")
#define PG8_BAR __builtin_amdgcn_s_barrier()
#define PG8_SCHED __builtin_amdgcn_sched_barrier(0)
    Unit cur, nxt; int ui = 0;
    if (!S.next(0, cur)) return;
    f32x4 acc[2][2][4][2];
#pragma unroll
    for (int a = 0; a < 2; ++a)
#pragma unroll
        for (int b = 0; b < 2; ++b)
#pragma unroll
            for (int m = 0; m < 4; ++m)
#pragma unroll
                for (int n = 0; n < 2; ++n) acc[a][b][m][n] = (f32x4){0.f, 0.f, 0.f, 0.f};
    bf16x8 At[4][2], B0[2][2], B1[2][2];
    unsigned ga[2][2], gn[2][2];
    S.a_offs(cur, ga, Rr, Cc);
    const char* cA = cur.A; const char* cB = cur.B;
    PG8_STAGE(PG8_SB(0, 0), cB, voffB); PG8_STAGE(PG8_SB(0, 1), cB + hstep, voffB); PG8_STAGE(PG8_SA(0, 0), cA, ga[0]); PG8_STAGE(PG8_SA(0, 1), cA, ga[1]);
    if (wr == 1) PG8_BAR;
    PG8_WAIT_V(2); PG8_BAR;
    PG8_STAGE(PG8_SB(1, 0), cB + kstep, voffB); PG8_STAGE(PG8_SA(1, 0), cA + kstep, ga[0]); PG8_STAGE(PG8_SB(1, 1), cB + hstep + kstep, voffB);
    PG8_WAIT_V(6); PG8_BAR;
    for (;;) {
        const bool has_next = S.next(ui + 1, nxt);
        const char* nA = has_next ? nxt.A : cA; const char* nB = has_next ? nxt.B : cB;
#pragma unroll
        for (int h = 0; h < 2; ++h)
#pragma unroll
            for (int i = 0; i < 2; ++i) gn[h][i] = ga[h][i];
        for (int t = 0; t < nt; t += 2) {
            const bool last = (t == nt - 2);
            if (Sched::GATHER && last && has_next) S.a_offs(nxt, gn, Rr, Cc);
            const char* a1 = cA + (size_t)(t + 1) * kstep;
            const char* a2 = last ? nA : cA + (size_t)(t + 2) * kstep; const char* b2 = last ? nB : cB + (size_t)(t + 2) * kstep;
            const char* a3 = a2 + kstep; const char* b3 = b2 + kstep;
            unsigned g2[2][2];
#pragma unroll
            for (int h = 0; h < 2; ++h)
#pragma unroll
                for (int i = 0; i < 2; ++i) g2[h][i] = last ? gn[h][i] : ga[h][i];
            PG8_LDB(B0, 0, 0); PG8_LDB(B1, 0, 1); PG8_SCHED; PG8_LDA(At, 0, 0); PG8_STAGE(PG8_SA(1, 1), a1, ga[1]);
            PG8_WAIT_V(8); PG8_WAIT_L(0); PG8_BAR; PG8_MMA(0, 0, At, B0); PG8_MMA(0, 1, At, B1); PG8_BAR; PG8_SCHED;
            PG8_LDA(At, 0, 1); PG8_STAGE(PG8_SB(0, 0), b2, voffB); PG8_STAGE(PG8_SB(0, 1), b2 + hstep, voffB); PG8_STAGE(PG8_SA(0, 0), a2, g2[0]);
            PG8_WAIT_V(8); PG8_WAIT_L(0); PG8_BAR; PG8_MMA(1, 0, At, B0); PG8_MMA(1, 1, At, B1); PG8_BAR; PG8_SCHED;
            PG8_LDB(B0, 1, 0); PG8_LDB(B1, 1, 1); PG8_SCHED; PG8_LDA(At, 1, 0); PG8_STAGE(PG8_SA(0, 1), a2, g2[1]);
            PG8_WAIT_V(8); PG8_WAIT_L(0); PG8_BAR; PG8_MMA(0, 0, At, B0); PG8_MMA(0, 1, At, B1); PG8_BAR; PG8_SCHED;
            PG8_LDA(At, 1, 1); PG8_STAGE(PG8_SB(1, 0), b3, voffB); PG8_STAGE(PG8_SB(1, 1), b3 + hstep, voffB); PG8_STAGE(PG8_SA(1, 0), a3, g2[0]);
            PG8_WAIT_V(8); PG8_WAIT_L(0); PG8_BAR; PG8_MMA(1, 0, At, B0); PG8_MMA(1, 1, At, B1); PG8_BAR; PG8_SCHED;
        }
        if constexpr (ALIGN_EPI) { if (wr == 0) PG8_BAR; }
        E(acc, cur, wr, wc, fr, fq);
        if (!has_next) break;
#pragma unroll
        for (int a = 0; a < 2; ++a)
#pragma unroll
            for (int b = 0; b < 2; ++b)
#pragma unroll
                for (int m = 0; m < 4; ++m)
#pragma unroll
                    for (int n = 0; n < 2; ++n) acc[a][b][m][n] = (f32x4){0.f, 0.f, 0.f, 0.f};
        cur = nxt; cA = nA; cB = nB; ++ui;
#pragma unroll
        for (int h = 0; h < 2; ++h)
#pragma unroll
            for (int i = 0; i < 2; ++i) ga[h][i] = gn[h][i];
        if constexpr (ALIGN_EPI) { if (wr == 1) PG8_BAR; }
    }
    PG8_WAIT_V(0);
    if constexpr (!ALIGN_EPI) { if (wr == 0) PG8_BAR; }
    PG8_BAR;
#undef PG8_SA
#undef PG8_SB
#undef PG8_STAGE
#undef PG8_LDA
#undef PG8_LDB
#undef PG8_MMA
#undef PG8_WAIT_V
#undef PG8_WAIT_L
#undef PG8_BAR
#undef PG8_SCHED
}


struct EpiZ {
    static constexpr bool PERM = true;
    bf16_t* O; const float* bias;
    __device__ __forceinline__ void operator()(const f32x4 (&acc)[2][2][4][2], const Unit& u, int wr, int wc, int fr, int fq) const {
        const int row0 = u.r0 + wr * 64 + fr, col0 = u.c0 + wc * 32 + 8 * fq;
        const int mode = (u.c0 < ZC_U) ? 0 : (u.c0 < ZC_GA ? 1 : 2);
        f32x4 bv[2][2];
#pragma unroll
        for (int bj = 0; bj < 2; ++bj)
#pragma unroll
            for (int n = 0; n < 2; ++n) bv[bj][n] = *(const f32x4*)(bias + col0 + bj * HALF + 4 * n);
#pragma unroll
        for (int ai = 0; ai < 2; ++ai)
#pragma unroll
            for (int m = 0; m < 4; ++m) { bf16_t* rowp = O + (size_t)(row0 + ai * HALF + m * 16) * NZ + col0;
#pragma unroll
                for (int bj = 0; bj < 2; ++bj) { f32x4 v0 = acc[ai][bj][m][0] + bv[bj][0], v1 = acc[ai][bj][m][1] + bv[bj][1];
                    if (mode == 1) { f32x2 a = gelu_pk((f32x2){v0[0], v0[1]}), b = gelu_pk((f32x2){v0[2], v0[3]}), c = gelu_pk((f32x2){v1[0], v1[1]}), d = gelu_pk((f32x2){v1[2], v1[3]});
                        v0 = (f32x4){a.x, a.y, b.x, b.y}; v1 = (f32x4){c.x, c.y, d.x, d.y}; }
                    else if (mode == 2) {
#pragma unroll
                        for (int j = 0; j < 4; ++j) { v0[j] = sigmoidf_(v0[j]); v1[j] = sigmoidf_(v1[j]); } }
                    u32x4 w; w.x = cvt_pk_bf16(v0[0], v0[1]); w.y = cvt_pk_bf16(v0[2], v0[3]); w.z = cvt_pk_bf16(v1[0], v1[1]); w.w = cvt_pk_bf16(v1[2], v1[3]);
                    *(u32x4*)(rowp + bj * HALF) = w; } }
    }
};
struct EpiRes {
    static constexpr bool PERM = false;
    float* C; const float* base;
    __device__ __forceinline__ void operator()(const f32x4 (&acc)[2][2][4][2], const Unit& u, int wr, int wc, int fr, int fq) const {
        const int row0 = u.r0 + wr * 64 + fr, col0 = u.c0 + wc * 32 + 4 * fq;
#pragma unroll
        for (int ai = 0; ai < 2; ++ai)
#pragma unroll
            for (int m = 0; m < 4; ++m) { const size_t ro = (size_t)(row0 + ai * HALF + m * 16) * D + col0;
#pragma unroll
                for (int bj = 0; bj < 2; ++bj)
#pragma unroll
                    for (int n = 0; n < 2; ++n) *(f32x4*)(C + ro + bj * HALF + n * 16) = acc[ai][bj][m][n] + *(const f32x4*)(base + ro + bj * HALF + n * 16); }
    }
};
struct EpiSwiglu {
    static constexpr bool PERM = true;
    bf16_t* O; const float* bias;
    __device__ __forceinline__ void operator()(const f32x4 (&acc)[2][2][4][2], const Unit& u, int wr, int wc, int fr, int fq) const {
        const int row0 = u.r0 + wr * 64 + fr, fl = wc * 32 + 8 * fq;
        const float* bp = bias + (size_t)u.e * 2048 + u.c0 + fl;
        f32x4 bg[2], bu[2];
#pragma unroll
        for (int n = 0; n < 2; ++n) { bg[n] = *(const f32x4*)(bp + 4 * n); bu[n] = *(const f32x4*)(bp + HALF + 4 * n); }
        const int f0 = (u.c0 >> 1) + fl;
#pragma unroll
        for (int ai = 0; ai < 2; ++ai)
#pragma unroll
            for (int m = 0; m < 4; ++m) { bf16_t* rowp = O + (size_t)(row0 + ai * HALF + m * 16) * FF + f0;
                float a[8];
#pragma unroll
                for (int n = 0; n < 2; ++n)
#pragma unroll
                    for (int j = 0; j < 4; ++j) { float g = acc[ai][0][m][n][j] + bg[n][j], up = acc[ai][1][m][n][j] + bu[n][j];
                        g = fminf(g, 7.0f); up = fminf(fmaxf(up, -7.0f), 7.0f);
                        a[n * 4 + j] = g * sigmoidf_(1.702f * g) * (up + 1.0f); }
                u32x4 w; w.x = cvt_pk_bf16(a[0], a[1]); w.y = cvt_pk_bf16(a[2], a[3]); w.z = cvt_pk_bf16(a[4], a[5]); w.w = cvt_pk_bf16(a[6], a[7]);
                *(u32x4*)rowp = w; }
    }
};
struct EpiDown {
    static constexpr bool PERM = true;
    bf16_t* O; const float* bias;
    __device__ __forceinline__ void operator()(const f32x4 (&acc)[2][2][4][2], const Unit& u, int wr, int wc, int fr, int fq) const {
        const int row0 = u.r0 + wr * 64 + fr, col0 = u.c0 + wc * 32 + 8 * fq;
        const float* bp = bias + (size_t)u.e * D + col0;
        f32x4 bv[2][2];
#pragma unroll
        for (int bj = 0; bj < 2; ++bj)
#pragma unroll
            for (int n = 0; n < 2; ++n) bv[bj][n] = *(const f32x4*)(bp + bj * HALF + 4 * n);
#pragma unroll
        for (int ai = 0; ai < 2; ++ai)
#pragma unroll
            for (int m = 0; m < 4; ++m) { bf16_t* rowp = O + (size_t)(row0 + ai * HALF + m * 16) * D + col0;
#pragma unroll
                for (int bj = 0; bj < 2; ++bj) { const f32x4 v0 = acc[ai][bj][m][0] + bv[bj][0], v1 = acc[ai][bj][m][1] + bv[bj][1];
                    u32x4 w; w.x = cvt_pk_bf16(v0[0], v0[1]); w.y = cvt_pk_bf16(v0[2], v0[3]); w.z = cvt_pk_bf16(v1[0], v1[1]); w.w = cvt_pk_bf16(v1[2], v1[3]);
                    *(u32x4*)(rowp + bj * HALF) = w; } }
    }
};
}

#define XB_TMO      128
#define XB_XCNT(j)  (256  + 64 * (j))
#define XB_XSUB(j)  (1280 + 64 * (j))
#define XB_XGEN(j)  (2304 + 64 * (j))
#define XB_TOP      3328
#define XB_TOPGEN   3392
#define XCD_BAR_WORDS 3456
#define XB_SPIN_CAP (1u << 18)
__device__ __forceinline__ unsigned xb_ld(unsigned* p)              { return __hip_atomic_load(p, __ATOMIC_RELAXED, __HIP_MEMORY_SCOPE_AGENT); }
__device__ __forceinline__ unsigned xb_add(unsigned* p, unsigned v) { return __hip_atomic_fetch_add(p, v, __ATOMIC_RELAXED, __HIP_MEMORY_SCOPE_AGENT); }
__device__ __forceinline__ unsigned xb_xcc_id() { return (unsigned)__builtin_amdgcn_s_getreg((3 << 11) | 20) & 0xFu; }
#define XB_SPIN(cond, bar) do { unsigned _sp = 0; while (cond) { __builtin_amdgcn_s_sleep(1); \
    if ((++_sp & 255u) == 0u) { if (xb_ld(&(bar)[XB_TMO])) break; if (_sp > XB_SPIN_CAP) { atomicAdd(&(bar)[XB_TMO], 1u); break; } } } } while (0)
struct XcdBarrier { unsigned* bar; unsigned x; volatile LAS unsigned* st; };
__device__ __forceinline__ XcdBarrier xcd_barrier_post(unsigned* bar, volatile LAS unsigned* st) {
    XcdBarrier b; b.bar = bar; b.x = xb_xcc_id(); b.st = st;
    if (threadIdx.x == 0) (void)xb_add(&bar[XB_XCNT(b.x)], 1u);
    return b;
}
__device__ __forceinline__ void xcd_barrier_complete(unsigned* bar, unsigned x, unsigned& nloc, unsigned& nx) {
    const unsigned G = gridDim.x * gridDim.y * gridDim.z;
    unsigned sum, cnt, mine, sp = 0u;
    for (;;) {
        sum = 0u; cnt = 0u; mine = 0u;
#pragma unroll
        for (unsigned j = 0; j < 16; ++j) { const unsigned c = xb_ld(&bar[XB_XCNT(j)]); sum += c; cnt += (c > 0u) ? 1u : 0u; mine = (j == x) ? c : mine; }
        if (sum == G) break;
        __builtin_amdgcn_s_sleep(1);
        if ((++sp & 255u) == 0u) { if (xb_ld(&bar[XB_TMO])) break; if (sp > XB_SPIN_CAP) { atomicAdd(&bar[XB_TMO], 1u); break; } }
    }
    nloc = mine > 0u ? mine : 1u; nx = cnt > 0u ? cnt : 1u;
}
__device__ __forceinline__ void xcd_barrier(const XcdBarrier& b) {
    asm volatile("s_waitcnt vmcnt(0)" ::: "memory");
    __syncthreads();
    if (threadIdx.x == 0) {
        unsigned* bar = b.bar;
        __builtin_amdgcn_s_waitcnt(0);
        unsigned nloc = b.st[0], nx = b.st[1];
        if (nloc == 0u) { xcd_barrier_complete(bar, b.x, nloc, nx); b.st[0] = nloc; b.st[1] = nx; }
        const unsigned old = xb_add(&bar[XB_XSUB(b.x)], 1u);
        const unsigned gen = old / nloc;
        if (old + 1u == (gen + 1u) * nloc) {
            __builtin_amdgcn_fence(__ATOMIC_RELEASE, "agent");
            asm volatile("s_waitcnt vmcnt(0)" ::: "memory");
            const unsigned og = xb_add(&bar[XB_TOP], 1u);
            const unsigned tg = og / nx;
            if (og + 1u == (tg + 1u) * nx) xb_add(&bar[XB_TOPGEN], 1u);
            else XB_SPIN(xb_ld(&bar[XB_TOPGEN]) == tg, bar);
            __builtin_amdgcn_fence(__ATOMIC_ACQUIRE, "agent");
            xb_add(&bar[XB_XGEN(b.x)], 1u);
            asm volatile("s_waitcnt vmcnt(0)" ::: "memory");
        } else {
            XB_SPIN(xb_ld(&bar[XB_XGEN(b.x)]) == gen, bar);
            __builtin_amdgcn_fence(__ATOMIC_ACQUIRE, "agent");
            asm volatile("s_waitcnt vmcnt(0)" ::: "memory");
        }
    }
    __syncthreads();
}

struct Args {
    const float* in[28]; float* out; unsigned char* ws; int ph_lo, ph_hi;
};
struct Frame {
    LAS unsigned char* lds; volatile LAS unsigned* MISC; unsigned* ctl;
    int tid, lane, wave, G, bid;
};
enum { I_X = 0, I_N1G, I_WIN, I_BGATE, I_TMIX, I_WDU, I_W0, I_AUP, I_A0, I_GUP, I_KK, I_KA, I_RK, I_GNW, I_GNB, I_LNVG, I_LNVB, I_WSP, I_BSP, I_WOUT, I_N2G, I_WR, I_BR, I_WGU, I_BGU, I_WD, I_BDN, I_NFG };

template <class RowMap>
__device__ __forceinline__ void p0_transpose_item(const float* W, int K, int N, bf16_t* WT, const RowMap& rm, LAS float* scr, int item, int lane) {
    const int nblk = N / 32, kb = item / nblk, nb = item % nblk, k0 = 64 * kb, n0 = 32 * nb;
#pragma unroll 8
    for (int i = 0; i < 32; ++i) { const int kk = 2 * i + (lane >> 5); scr[kk * 33 + (lane & 31)] = W[(size_t)(k0 + kk) * N + n0 + (lane & 31)]; }
    LDS_WAIT(); asm volatile("" ::: "memory");
    const int c = lane & 7;
#pragma unroll
    for (int j = 0; j < 4; ++j) { const int n = (lane >> 3) + 8 * j; const LAS float* s = scr + (8 * c) * 33 + n;
        u32x4 o; o.x = cvt_pk_bf16(s[0 * 33], s[1 * 33]); o.y = cvt_pk_bf16(s[2 * 33], s[3 * 33]); o.z = cvt_pk_bf16(s[4 * 33], s[5 * 33]); o.w = cvt_pk_bf16(s[6 * 33], s[7 * 33]);
        *(u32x4*)(WT + (size_t)rm(n0 + n) * K + k0 + 8 * c) = o; }
    LDS_WAIT(); asm volatile("" ::: "memory");
}
struct RmId { __device__ __forceinline__ int operator()(int n) const { return n; } };
struct RmIn { __device__ __forceinline__ int operator()(int n) const { return n < 3360 ? n : n + 224; } };
struct RmGu { __device__ __forceinline__ int operator()(int n) const { const int f = n >> 1, up = n & 1; return (f >> 7) * 256 + up * 128 + (f & 127); } };

__device__ __forceinline__ void p0_prologue(Frame& F, const Args& a) {
    unsigned char* ws = a.ws;
    bf16_t* Bin = (bf16_t*)(ws + WS_BIN); bf16_t* Bout = (bf16_t*)(ws + WS_BOUT); bf16_t* Bgu = (bf16_t*)(ws + WS_BGU); bf16_t* Bd = (bf16_t*)(ws + WS_BD);
    LAS float* scr = (LAS float*)(F.lds + RING_OFF + F.wave * 16384);
    const int gw = F.bid * NWAVES + F.wave, NGW = F.G * NWAVES;
    constexpr int I_IN = (D / 64) * (7456 / 32), I_OUT = (D / 64) * (D / 32), I_GU1 = (D / 64) * (2048 / 32), I_D1 = (FF / 64) * (D / 32);
    constexpr int NITEMS = I_IN + I_OUT + NE * I_GU1 + NE * I_D1;
    for (int it = gw; it < NITEMS; it += NGW) {
        int r = it;
        if (r < I_IN) { p0_transpose_item(a.in[I_WIN], D, 7456, Bin, RmIn(), scr, r, F.lane); continue; } r -= I_IN;
        if (r < I_OUT) { p0_transpose_item(a.in[I_WOUT], D, D, Bout, RmId(), scr, r, F.lane); continue; } r -= I_OUT;
        if (r < NE * I_GU1) { const int e = r / I_GU1; p0_transpose_item(a.in[I_WGU] + (size_t)e * D * 2048, D, 2048, Bgu + (size_t)e * 2048 * D, RmGu(), scr, r % I_GU1, F.lane); continue; } r -= NE * I_GU1;
        { const int e = r / I_D1; p0_transpose_item(a.in[I_WD] + (size_t)e * FF * D, FF, D, Bd + (size_t)e * D * FF, RmId(), scr, r % I_D1, F.lane); }
    }
    const int gt = F.bid * (NWAVES * 64) + F.tid, NGT = F.G * NWAVES * 64;
    {
        u32x4* p = (u32x4*)(Bin + (size_t)3360 * D);
        for (int i = gt; i < 224 * 128; i += NGT) p[i] = (u32x4){0u, 0u, 0u, 0u};
    }
    {   float* bz = (float*)(ws + WS_MISC + MO_BIASZ);
        for (int i = gt; i < NZ; i += NGT) bz[i] = (i >= ZC_GA) ? a.in[I_BGATE][i - ZC_GA] : 0.f;
    }
    {   float* bg = (float*)(ws + WS_MISC + MO_BGU);
        for (int i = gt; i < NE * 2048; i += NGT) { const int e = i >> 11, n = i & 2047; bg[(size_t)e * 2048 + RmGu()(n)] = a.in[I_BGU][i]; }
    }
    {   bf16_t* wh = (bf16_t*)(ws + WS_MISC + MO_WRT); bf16_t* wl = wh + NE * D;
        for (int i = gt; i < NE * D; i += NGT) { const int e = i >> 10, k = i & 1023; const float w = a.in[I_WR][(size_t)k * NE + e];
            const unsigned h = cvt_pk_bf16(w, 0.f) & 0xffffu; const float rlo = w - bf_lo(h); wh[i] = (bf16_t)h; wl[i] = (bf16_t)(cvt_pk_bf16(rlo, 0.f) & 0xffffu); }
    }
    const float* x = a.in[I_X]; const float* g1 = a.in[I_N1G]; bf16_t* Hh = (bf16_t*)(ws + WS_H);
    f32x4 gv[4];
#pragma unroll
    for (int j = 0; j < 4; ++j) gv[j] = *((const f32x4*)g1 + F.lane + 64 * j);
    for (int m = gw; m < T; m += NGW) {
        const f32x4* xr = (const f32x4*)(x + (size_t)m * D) + F.lane;
        f32x4 v[4]; float s = 0.f;
#pragma unroll
        for (int j = 0; j < 4; ++j) { v[j] = xr[64 * j]; s += (v[j].x * v[j].x + v[j].y * v[j].y) + (v[j].z * v[j].z + v[j].w * v[j].w); }
        const float rstd = __builtin_amdgcn_rsqf(wave_sum(s) * (1.f / D) + RMS_EPS);
        u32x2* o8 = (u32x2*)(Hh + (size_t)m * D) + F.lane;
#pragma unroll
        for (int j = 0; j < 4; ++j) { const f32x4 y = v[j] * rstd * gv[j]; o8[64 * j] = (u32x2){cvt_pk_bf16(y.x, y.y), cvt_pk_bf16(y.z, y.w)}; }
    }
}

constexpr int TC = 32;
constexpr int SC_KK = 0, SC_W = 2048, SC_NB = 4096, SC_KP = 6144, SC_R = 8192, SC_V = 10240, SC_A = 12288, SC_G = 14336, SC_Y = 16384;
__device__ __forceinline__ f32x4 ld_bf4(const bf16_t* p) { const u32x2 v = *(const u32x2*)p; return (f32x4){bf_lo(v.x), bf_hi(v.x), bf_lo(v.y), bf_hi(v.y)}; }
__device__ __forceinline__ void ld_bf8(const bf16_t* p, float (&o)[8]) { const u32x4 v = *(const u32x4*)p;
    o[0] = bf_lo(v.x); o[1] = bf_hi(v.x); o[2] = bf_lo(v.y); o[3] = bf_hi(v.y); o[4] = bf_lo(v.z); o[5] = bf_hi(v.z); o[6] = bf_lo(v.w); o[7] = bf_hi(v.w); }
__device__ __forceinline__ bf16x8 pack8(const float (&o)[8]) { u32x4 w; w.x = cvt_pk_bf16(o[0], o[1]); w.y = cvt_pk_bf16(o[2], o[3]); w.z = cvt_pk_bf16(o[4], o[5]); w.w = cvt_pk_bf16(o[6], o[7]); return __builtin_bit_cast(bf16x8, w); }

__device__ __forceinline__ void p2_scan(Frame& F, const Args& a) {
    const bf16_t* Z = (const bf16_t*)(a.ws + WS_Z); bf16_t* Mo = (bf16_t*)(a.ws + WS_M);
    LAS float* L = (LAS float*)(F.lds + RING_OFF);
    const int lane = F.lane, w = F.wave, tid = F.tid;
    const float* tmix = a.in[I_TMIX];
    for (int unit = F.bid; unit < NB_ * NH; unit += F.G) {
        const int b = unit / NH, h = unit % NH;
        const size_t trow0 = (size_t)b * SEQ;
        const int mb = w >> 2, nb = w & 3, fn = lane & 15, kg = lane >> 4;
        bf16x8 Bw[2], Ba[2], Bg[5];
        {   const int col = h * HD + nb * 16 + fn;
#pragma unroll
            for (int s = 0; s < 2; ++s) { float t1[8], t2[8];
#pragma unroll
                for (int j = 0; j < 8; ++j) { const int k = 32 * s + 8 * kg + j; t1[j] = a.in[I_WDU][(size_t)k * D + col]; t2[j] = a.in[I_AUP][(size_t)k * D + col]; }
                Bw[s] = pack8(t1); Ba[s] = pack8(t2); }
#pragma unroll
            for (int s = 0; s < 5; ++s) { float t1[8];
#pragma unroll
                for (int j = 0; j < 8; ++j) { const int k = 32 * s + 8 * kg + j; t1[j] = a.in[I_GUP][(size_t)k * D + col]; }
                Bg[s] = pack8(t1); }
        }
        const int tl = tid >> 4, q = tid & 15, col4 = h * HD + 4 * q;
        const f32x4 tm_r = *(const f32x4*)(tmix + TM_R + col4), tm_k = *(const f32x4*)(tmix + TM_K + col4), tm_v = *(const f32x4*)(tmix + TM_V + col4);
        const f32x4 c_w0 = *(const f32x4*)(a.in[I_W0] + col4), c_a0 = *(const f32x4*)(a.in[I_A0] + col4), c_kk = *(const f32x4*)(a.in[I_KK] + col4), c_ka = *(const f32x4*)(a.in[I_KA] + col4);
        const f32x4 c_rk = *(const f32x4*)(a.in[I_RK] + col4), c_gw = *(const f32x4*)(a.in[I_GNW] + col4), c_gb = *(const f32x4*)(a.in[I_GNB] + col4);
        const int jg = lane & 15, i0 = 8 * w + 2 * (lane >> 4);
        f32x4 s0 = (f32x4){0.f, 0.f, 0.f, 0.f}, s1 = s0;
        for (int ch = 0; ch < SEQ / TC; ++ch) {
            const int t0 = ch * TC;
            {   const int t = t0 + 16 * mb + fn;
                const bf16_t* zc = Z + (trow0 + t) * NZ + ZC_L; const bf16_t* zp = zc - NZ; const bool hasp = (t > 0);
                f32x4 aw = (f32x4){0.f, 0.f, 0.f, 0.f}, aa = aw, ag = aw;
#pragma unroll
                for (int s = 0; s < 9; ++s) {
                    const int kc = (s < 2) ? (32 * s) : (s < 4 ? 64 + 32 * (s - 2) : 128 + 32 * (s - 4));
                    const int tmc = (s < 2) ? (TM_DL + 32 * s) : (s < 4 ? TM_AL + 32 * (s - 2) : TM_GL + 32 * (s - 4));
                    float c[8], p[8], m8[8];
                    ld_bf8(zc + kc + 8 * kg, c);
                    if (hasp) ld_bf8(zp + kc + 8 * kg, p); else {
#pragma unroll
                        for (int j = 0; j < 8; ++j) p[j] = 0.f; }
                    const f32x4 tma = *(const f32x4*)(tmix + tmc + 8 * kg), tmb = *(const f32x4*)(tmix + tmc + 8 * kg + 4);
#pragma unroll
                    for (int j = 0; j < 8; ++j) { const float tmj = (j < 4) ? tma[j] : tmb[j - 4]; float v = c[j] + (p[j] - c[j]) * tmj;
                        if (s < 2) v = tanhf(v); else if (s >= 4) v = sigmoidf_(v);
                        m8[j] = v; }
                    const bf16x8 af = pack8(m8);
                    if (s < 2) aw = __builtin_amdgcn_mfma_f32_16x16x32_bf16(Bw[s], af, aw, 0, 0, 0);
                    else if (s < 4) aa = __builtin_amdgcn_mfma_f32_16x16x32_bf16(Ba[s - 2], af, aa, 0, 0, 0);
                    else ag = __builtin_amdgcn_mfma_f32_16x16x32_bf16(Bg[s - 4], af, ag, 0, 0, 0);
                }
                const int o = (16 * mb + fn) * 64 + nb * 16 + 4 * kg;
                *(LAS f32x4*)(L + SC_W + o) = aw; *(LAS f32x4*)(L + SC_A + o) = aa; *(LAS f32x4*)(L + SC_G + o) = ag;
            }
            __syncthreads();
            {   const int t = t0 + tl; const bf16_t* zc = Z + (trow0 + t) * NZ + col4; const bf16_t* zp = zc - NZ; const bool hasp = (t > 0);
                f32x4 r = ld_bf4(zc + ZC_R), k = ld_bf4(zc + ZC_K), v = ld_bf4(zc + ZC_V);
                f32x4 rp = (f32x4){0.f, 0.f, 0.f, 0.f}, kp_ = rp, vp = rp;
                if (hasp) { rp = ld_bf4(zp + ZC_R); kp_ = ld_bf4(zp + ZC_K); vp = ld_bf4(zp + ZC_V); }
                r = r + (rp - r) * tm_r; k = k + (kp_ - k) * tm_k; v = v + (vp - v) * tm_v;
                const int o = tl * 64 + 4 * q;
                const f32x4 wraw = *(LAS f32x4*)(L + SC_W + o) + c_w0, araw = *(LAS f32x4*)(L + SC_A + o) + c_a0;
                f32x4 dec, av, kk, kpv, nbv; float ss = 0.f;
#pragma unroll
                for (int j = 0; j < 4; ++j) {
                    const float xw = -wraw[j]; const float sp = fmaxf(xw, 0.f) + __logf(1.0f + __expf(-fabsf(xw)));
                    const float wlog = -sp - 0.5f; dec[j] = __expf(-__expf(wlog));
                    av[j] = sigmoidf_(araw[j]);
                    kk[j] = k[j] * c_kk[j]; ss += kk[j] * kk[j];
                    kpv[j] = k[j] * (1.0f + (av[j] - 1.0f) * c_ka[j]);
                }
                ss = allsum16(ss);
                const float inv = 1.0f / fmaxf(sqrtf(ss), 1e-12f);
#pragma unroll
                for (int j = 0; j < 4; ++j) { kk[j] *= inv; nbv[j] = -kk[j] * av[j]; }
                *(LAS f32x4*)(L + SC_KK + o) = kk; *(LAS f32x4*)(L + SC_W + o) = dec; *(LAS f32x4*)(L + SC_NB + o) = nbv;
                *(LAS f32x4*)(L + SC_KP + o) = kpv; *(LAS f32x4*)(L + SC_R + o) = r; *(LAS f32x4*)(L + SC_V + o) = v;
            }
            __syncthreads();
#pragma unroll 4
            for (int tt = 0; tt < TC; ++tt) {
                const int o = tt * 64 + 4 * jg;
                const f32x4 kk = *(LAS f32x4*)(L + SC_KK + o), wv = *(LAS f32x4*)(L + SC_W + o), nbv = *(LAS f32x4*)(L + SC_NB + o), kpv = *(LAS f32x4*)(L + SC_KP + o), rv = *(LAS f32x4*)(L + SC_R + o);
                const f32x2 vv = *(LAS f32x2*)(L + SC_V + tt * 64 + i0);
                float sa0 = (s0[0] * kk[0] + s0[1] * kk[1]) + (s0[2] * kk[2] + s0[3] * kk[3]);
                float sa1 = (s1[0] * kk[0] + s1[1] * kk[1]) + (s1[2] * kk[2] + s1[3] * kk[3]);
                sa0 = allsum16(sa0); sa1 = allsum16(sa1);
                s0 = s0 * wv + sa0 * nbv + vv.x * kpv;
                s1 = s1 * wv + sa1 * nbv + vv.y * kpv;
                float y0 = (s0[0] * rv[0] + s0[1] * rv[1]) + (s0[2] * rv[2] + s0[3] * rv[3]);
                float y1 = (s1[0] * rv[0] + s1[1] * rv[1]) + (s1[2] * rv[2] + s1[3] * rv[3]);
                y0 = allsum16(y0); y1 = allsum16(y1);
                if (jg == 0) *(LAS f32x2*)(L + SC_Y + tt * 64 + i0) = (f32x2){y0, y1};
            }
            __syncthreads();
            {   const int t = t0 + tl; const int o = tl * 64 + 4 * q;
                const f32x4 y = *(LAS f32x4*)(L + SC_Y + o), rv = *(LAS f32x4*)(L + SC_R + o), kpv = *(LAS f32x4*)(L + SC_KP + o), vv = *(LAS f32x4*)(L + SC_V + o), gv = *(LAS f32x4*)(L + SC_G + o);
                const float mean = allsum16((y[0] + y[1]) + (y[2] + y[3])) * (1.0f / 64.0f);
                const f32x4 dv = y - mean;
                const float var = allsum16((dv[0] * dv[0] + dv[1] * dv[1]) + (dv[2] * dv[2] + dv[3] * dv[3])) * (1.0f / 64.0f);
                const float rstd = __builtin_amdgcn_rsqf(var + GN_EPS);
                const float bonus = allsum16((rv[0] * kpv[0] * c_rk[0] + rv[1] * kpv[1] * c_rk[1]) + (rv[2] * kpv[2] * c_rk[2] + rv[3] * kpv[3] * c_rk[3]));
                const f32x4 ga = ld_bf4(Z + (trow0 + t) * NZ + ZC_GA + col4);
                f32x4 ov;
#pragma unroll
                for (int j = 0; j < 4; ++j) ov[j] = ((dv[j] * rstd * c_gw[j] + c_gb[j]) + bonus * vv[j]) * gv[j] * ga[j];
                *(u32x2*)(Mo + (trow0 + t) * D + col4) = (u32x2){cvt_pk_bf16(ov[0], ov[1]), cvt_pk_bf16(ov[2], ov[3])};
            }
            __syncthreads();
        }
    }
}

constexpr int VT_STRIDE = 272;
__device__ __forceinline__ void p3_gmlp(Frame& F, const Args& a) {
    const bf16_t* Z = (const bf16_t*)(a.ws + WS_Z); const bf16_t* Mo = (const bf16_t*)(a.ws + WS_M); bf16_t* M2 = (bf16_t*)(a.ws + WS_M2);
    LAS unsigned char* VT = F.lds + RING_OFF;
    LAS f32x2* ST = (LAS f32x2*)(F.lds + RING_OFF + 128 * VT_STRIDE);
    const int lane = F.lane, w = F.wave, tid = F.tid;
    const float* lng = a.in[I_LNVG]; const float* lnb = a.in[I_LNVB]; const float* wsp = a.in[I_WSP]; const float* bsp = a.in[I_BSP];
    for (int unit = F.bid; unit < NB_ * (SEQ / 128); unit += F.G) {
        const size_t t0 = (size_t)unit * 128;
        for (int rr = 0; rr < 16; ++rr) { const int j = 16 * w + rr;
            const bf16_t* p = Z + (t0 + j) * NZ + ZC_VG + 16 * lane; float c0[8], c1[8]; ld_bf8(p, c0); ld_bf8(p + 8, c1);
            float s = 0.f, s2 = 0.f;
#pragma unroll
            for (int i = 0; i < 8; ++i) { s += c0[i] + c1[i]; s2 += c0[i] * c0[i] + c1[i] * c1[i]; }
            s = wave_sum(s); s2 = wave_sum(s2);
            const float mean = s * (1.0f / 1024.0f), var = fmaxf(s2 * (1.0f / 1024.0f) - mean * mean, 0.f);
            if (lane == 0) ST[j] = (f32x2){mean, __builtin_amdgcn_rsqf(var + LN_EPS)};
        }
        __syncthreads();
        for (int g = 0; g < 8; ++g) {
            {   const int j = tid & 127; const f32x2 st = ST[j];
#pragma unroll
                for (int it = 0; it < 4; ++it) { const int dch = (tid >> 7) + 4 * it;
                    float c[8]; ld_bf8(Z + (t0 + j) * NZ + ZC_VG + g * 128 + dch * 8, c);
                    const f32x4 g0 = *(const f32x4*)(lng + g * 128 + dch * 8), g1 = *(const f32x4*)(lng + g * 128 + dch * 8 + 4);
                    const f32x4 b0 = *(const f32x4*)(lnb + g * 128 + dch * 8), b1 = *(const f32x4*)(lnb + g * 128 + dch * 8 + 4);
#pragma unroll
                    for (int i = 0; i < 8; ++i) { const float gg = (i < 4) ? g0[i] : g1[i - 4], bb = (i < 4) ? b0[i] : b1[i - 4];
                        const float vn = (c[i] - st.x) * st.y * gg + bb;
                        *(LAS bf16_t*)(VT + (dch * 8 + i) * VT_STRIDE + j * 2) = (bf16_t)(cvt_pk_bf16(vn, 0.f) & 0xffffu); }
                }
            }
            __syncthreads();
            {   const int fi = lane & 15, kg = lane >> 4, i = 16 * w + fi;
                f32x4 acc[8];
#pragma unroll
                for (int n = 0; n < 8; ++n) acc[n] = (f32x4){0.f, 0.f, 0.f, 0.f};
                const float* wrow = wsp + ((size_t)g * 128 + i) * 128;
#pragma unroll
                for (int s = 0; s < 4; ++s) {
                    if (32 * s <= 16 * w + 15) {
                        const int jb = 32 * s + 8 * kg;
                        const f32x4 w0 = *(const f32x4*)(wrow + jb), w1 = *(const f32x4*)(wrow + jb + 4);
                        float m8[8];
#pragma unroll
                        for (int jj = 0; jj < 8; ++jj) { const float v = (jj < 4) ? w0[jj] : w1[jj - 4]; m8[jj] = (jb + jj <= i) ? v : 0.f; }
                        const bf16x8 wf = pack8(m8);
#pragma unroll
                        for (int n = 0; n < 8; ++n) { const bf16x8 vf = *(const LAS bf16x8*)(VT + (16 * n + fi) * VT_STRIDE + jb * 2);
                            acc[n] = __builtin_amdgcn_mfma_f32_16x16x32_bf16(vf, wf, acc[n], 0, 0, 0); }
                    }
                }
                const float bs = bsp[g * 128 + i];
                const size_t trow = t0 + i;
#pragma unroll
                for (int n = 0; n < 8; ++n) { const int dcol = g * 128 + 16 * n + 4 * kg;
                    const f32x4 uu = ld_bf4(Z + trow * NZ + ZC_U + dcol), gb = ld_bf4(Z + trow * NZ + ZC_GB + dcol), mm = ld_bf4(Mo + trow * D + dcol);
                    f32x4 o;
#pragma unroll
                    for (int r = 0; r < 4; ++r) o[r] = mm[r] + uu[r] * (acc[n][r] + bs) * gb[r];
                    *(u32x2*)(M2 + trow * D + dcol) = (u32x2){cvt_pk_bf16(o[0], o[1]), cvt_pk_bf16(o[2], o[3])}; }
            }
            __syncthreads();
        }
    }
}

__device__ __forceinline__ void p5_router(Frame& F, const Args& a) {
    const float* X2 = a.out; bf16_t* Hh = (bf16_t*)(a.ws + WS_H2);
    const bf16_t* Wh = (const bf16_t*)(a.ws + WS_MISC + MO_WRT); const bf16_t* Wl = Wh + NE * D;
    int* tok_of = (int*)(a.ws + WS_TOK); int* asg = (int*)(a.ws + WS_MISC + MO_ASG); float* gate = (float*)(a.ws + WS_MISC + MO_GATE);
    const float* g2 = a.in[I_N2G]; const float* br = a.in[I_BR];
    LAS float* LG = (LAS float*)(F.lds + RING_OFF) + F.wave * 512;
    LAS unsigned* LCNT = (LAS unsigned*)(F.lds + RING_OFF + 32768);
    LAS unsigned* LBASE = LCNT + 32;
    const int lane = F.lane, w = F.wave, tid = F.tid, fm = lane & 15, kg = lane >> 4;
    for (int blk = F.bid; blk < T / 128; blk += F.G) {
        if (tid < 32) LCNT[tid] = 0u;
        __syncthreads();
        const int tb = blk * 128 + 16 * w;
        const float* xr = X2 + (size_t)(tb + fm) * D + 8 * kg;
        float ss = 0.f;
        for (int s = 0; s < 32; ++s) { const f32x4 x0 = *(const f32x4*)(xr + 32 * s), x1 = *(const f32x4*)(xr + 32 * s + 4);
            ss += (x0.x * x0.x + x0.y * x0.y) + (x0.z * x0.z + x0.w * x0.w) + (x1.x * x1.x + x1.y * x1.y) + (x1.z * x1.z + x1.w * x1.w); }
        ss += __shfl_xor(ss, 16); ss += __shfl_xor(ss, 32);
        const float rstd = __builtin_amdgcn_rsqf(ss * (1.0f / D) + RMS_EPS);
        f32x4 acc[2]; acc[0] = (f32x4){0.f, 0.f, 0.f, 0.f}; acc[1] = acc[0];
        bf16_t* hrow = Hh + (size_t)(tb + fm) * D + 8 * kg;
        for (int s = 0; s < 32; ++s) {
            const f32x4 x0 = *(const f32x4*)(xr + 32 * s), x1 = *(const f32x4*)(xr + 32 * s + 4);
            const f32x4 ga = *(const f32x4*)(g2 + 32 * s + 8 * kg), gb = *(const f32x4*)(g2 + 32 * s + 8 * kg + 4);
            float hv[8], lo[8];
#pragma unroll
            for (int j = 0; j < 4; ++j) { hv[j] = x0[j] * rstd * ga[j]; hv[4 + j] = x1[j] * rstd * gb[j]; }
            u32x4 hp; hp.x = cvt_pk_bf16(hv[0], hv[1]); hp.y = cvt_pk_bf16(hv[2], hv[3]); hp.z = cvt_pk_bf16(hv[4], hv[5]); hp.w = cvt_pk_bf16(hv[6], hv[7]);
            *(u32x4*)(hrow + 32 * s) = hp;
            lo[0] = hv[0] - bf_lo(hp.x); lo[1] = hv[1] - bf_hi(hp.x); lo[2] = hv[2] - bf_lo(hp.y); lo[3] = hv[3] - bf_hi(hp.y);
            lo[4] = hv[4] - bf_lo(hp.z); lo[5] = hv[5] - bf_hi(hp.z); lo[6] = hv[6] - bf_lo(hp.w); lo[7] = hv[7] - bf_hi(hp.w);
            const bf16x8 ah = __builtin_bit_cast(bf16x8, hp), al = pack8(lo);
#pragma unroll
            for (int n = 0; n < 2; ++n) { const size_t wo = (size_t)(16 * n + fm) * D + 32 * s + 8 * kg;
                const bf16x8 bh = *(const bf16x8*)(Wh + wo), bl = *(const bf16x8*)(Wl + wo);
                acc[n] = __builtin_amdgcn_mfma_f32_16x16x32_bf16(bh, ah, acc[n], 0, 0, 0);
                acc[n] = __builtin_amdgcn_mfma_f32_16x16x32_bf16(bh, al, acc[n], 0, 0, 0);
                acc[n] = __builtin_amdgcn_mfma_f32_16x16x32_bf16(bl, ah, acc[n], 0, 0, 0); }
        }
#pragma unroll
        for (int n = 0; n < 2; ++n) { const f32x4 bb = *(const f32x4*)(br + 16 * n + 4 * kg); *(LAS f32x4*)(LG + fm * 32 + 16 * n + 4 * kg) = acc[n] + bb; }
        LDS_WAIT(); asm volatile("" ::: "memory");
        int se[4] = {0, 0, 0, 0}; unsigned sr[4] = {0u, 0u, 0u, 0u}; float sg[4] = {0.f, 0.f, 0.f, 0.f};
        if (lane < 16) {
            float lv[32];
#pragma unroll
            for (int e4 = 0; e4 < 8; ++e4) { const f32x4 v = *(LAS f32x4*)(LG + lane * 32 + 4 * e4); lv[4 * e4] = v.x; lv[4 * e4 + 1] = v.y; lv[4 * e4 + 2] = v.z; lv[4 * e4 + 3] = v.w; }
            float tv[4];
#pragma unroll
            for (int k = 0; k < 4; ++k) { float best = -3.0e38f; int bi = 0;
#pragma unroll
                for (int e = 0; e < 32; ++e) { const bool taken = (k > 0 && se[0] == e) || (k > 1 && se[1] == e) || (k > 2 && se[2] == e); if (!taken && lv[e] > best) { best = lv[e]; bi = e; } }
                se[k] = bi; tv[k] = best; }
            const float e1 = __expf(tv[1] - tv[0]), e2 = __expf(tv[2] - tv[0]), e3 = __expf(tv[3] - tv[0]); const float inv = 1.0f / (1.0f + e1 + e2 + e3);
            sg[0] = inv; sg[1] = e1 * inv; sg[2] = e2 * inv; sg[3] = e3 * inv;
#pragma unroll
            for (int k = 0; k < 4; ++k) sr[k] = atomicAdd((unsigned*)(LCNT + se[k]), 1u);
        }
        __syncthreads();
        if (tid < 32) LBASE[tid] = atomicAdd(F.ctl + CW_CNT + 64 * tid, (unsigned)LCNT[tid]);
        __syncthreads();
        if (lane < 16) { const int tok = tb + lane;
#pragma unroll
            for (int k = 0; k < 4; ++k) { const int pos = (int)(LBASE[se[k]] + sr[k]);
                tok_of[(size_t)se[k] * T + pos] = tok; asg[(size_t)tok * 8 + 2 * k] = se[k]; asg[(size_t)tok * 8 + 2 * k + 1] = pos; gate[(size_t)tok * 4 + k] = sg[k]; }
        }
        __syncthreads();
    }
}

__device__ __forceinline__ void moe_tables(Frame& F) {
    LAS int* cnt = (LAS int*)(F.lds + SCHED_OFF); LAS int* mts = cnt + 32;
    if (F.tid == 0) { int acc = 0;
        for (int e = 0; e < NE; ++e) { const int c = (int)__hip_atomic_load(F.ctl + CW_CNT + 64 * e, RLX_AGENT); cnt[e] = c; mts[e] = acc; acc += (c + 255) >> 8; }
        mts[NE] = acc; }
    __syncthreads();
}
template <int NTN, bool GATH>
struct MoeOrder {
    static constexpr bool GATHER = GATH;
    LAS const int* cnt; LAS const int* mts; const char* A; const char* B; const int* tok_of; int G, c, Mtiles;
    __device__ void init(Frame& F, const void* A_, const void* B_, const int* tok) { cnt = (LAS const int*)(F.lds + SCHED_OFF); mts = cnt + 32; A = (const char*)A_; B = (const char*)B_; tok_of = tok; G = F.G; c = F.bid; Mtiles = mts[NE]; }
    __device__ bool next(int i, pg8::Unit& u) const {
        constexpr int MPS = 32 / NTN;
        int mt, nt_;
        if ((G & 7) == 0) { const int s = i * 8 + (c & 7), j = (c >> 3) + 0; const int per = G >> 3;
            if (per == 32) { mt = s * MPS + (j % MPS); nt_ = j / MPS; }
            else { const int L = i * G + c; mt = L / NTN; nt_ = L % NTN; } }
        else { const int L = i * G + c; mt = L / NTN; nt_ = L % NTN; }
        if (mt >= Mtiles) return false;
        int e = 0;
        for (int k = 1; k < NE; ++k) e += (mts[k] <= mt) ? 1 : 0;
        const int mloc = mt - mts[e];
        u.e = e; u.r0 = mt * 256; u.c0 = nt_ * 256; u.aux = mloc;
        u.B = B + ((size_t)e * NTN + nt_) * (256 * pg8::KK * 2);
        u.A = GATH ? A : A + (size_t)mt * (256 * pg8::KK * 2);
        return true;
    }
    __device__ __forceinline__ void a_offs(const pg8::Unit& u, unsigned (&ga)[2][2], const int (&R)[2], const int (&C)[2]) const {
        if constexpr (GATH) {
            const int n = cnt[u.e]; const int* tp = tok_of + (size_t)u.e * T + u.aux * 256;
            int tk[2][2];
#pragma unroll
            for (int h = 0; h < 2; ++h)
#pragma unroll
                for (int i = 0; i < 2; ++i) { const int rr = h * 128 + R[i]; tk[h][i] = (u.aux * 256 + rr < n) ? tp[rr] : 0; }
            VM_WAIT();
#pragma unroll
            for (int h = 0; h < 2; ++h)
#pragma unroll
                for (int i = 0; i < 2; ++i) ga[h][i] = (unsigned)(tk[h][i] * pg8::KK + C[i]) * 2u;
        } else {
#pragma unroll
            for (int h = 0; h < 2; ++h)
#pragma unroll
                for (int i = 0; i < 2; ++i) ga[h][i] = (unsigned)((h * 128 + R[i]) * pg8::KK + C[i]) * 2u;
        }
    }
};

__device__ __forceinline__ void p8_final(Frame& F, const Args& a) {
    LAS const int* mts = (LAS const int*)(F.lds + SCHED_OFF) + 32;
    const bf16_t* YS = (const bf16_t*)(a.ws + WS_YS); const int* asg = (const int*)(a.ws + WS_MISC + MO_ASG); const float* gate = (const float*)(a.ws + WS_MISC + MO_GATE);
    float* out = a.out; const float* gf = a.in[I_NFG];
    const int gw = F.bid * NWAVES + F.wave, NGW = F.G * NWAVES;
    f32x4 gv[4];
#pragma unroll
    for (int j = 0; j < 4; ++j) gv[j] = *((const f32x4*)gf + F.lane + 64 * j);
    for (int m = gw; m < T; m += NGW) {
        f32x4* xr = (f32x4*)(out + (size_t)m * D) + F.lane;
        f32x4 v[4];
#pragma unroll
        for (int j = 0; j < 4; ++j) v[j] = xr[64 * j];
#pragma unroll
        for (int k = 0; k < 4; ++k) { const int e = asg[(size_t)m * 8 + 2 * k], pos = asg[(size_t)m * 8 + 2 * k + 1]; const float gk = gate[(size_t)m * 4 + k];
            const bf16_t* yr = YS + ((size_t)mts[e] * 256 + pos) * D + 4 * F.lane;
#pragma unroll
            for (int j = 0; j < 4; ++j) v[j] += gk * ld_bf4(yr + 256 * j); }
        float s = 0.f;
#pragma unroll
        for (int j = 0; j < 4; ++j) s += (v[j].x * v[j].x + v[j].y * v[j].y) + (v[j].z * v[j].z + v[j].w * v[j].w);
        const float rstd = __builtin_amdgcn_rsqf(wave_sum(s) * (1.f / D) + RMS_EPS);
#pragma unroll
        for (int j = 0; j < 4; ++j) xr[64 * j] = v[j] * rstd * gv[j];
    }
}

constexpr int N_PHASES = 9;
__global__ void __launch_bounds__(NWAVES * 64, 2) mk_fwd(Args args) {
    extern __shared__ __attribute__((aligned(16))) unsigned char lds[];
    Frame F;
    F.lds = (LAS unsigned char*)lds;
    F.MISC = (volatile LAS unsigned*)(F.lds + MISC_OFF);
    F.tid = threadIdx.x; F.lane = F.tid & 63; F.wave = __builtin_amdgcn_readfirstlane(F.tid >> 6);
    F.G = gridDim.x; F.bid = blockIdx.x;
    F.ctl = (unsigned*)(args.ws + WS_CTL);
    for (int u = F.tid; u < (LDS_BYTES - LDSCTL_OFF) / 4; u += NWAVES * 64) ((LAS unsigned*)(F.lds + LDSCTL_OFF))[u] = 0u;
    __syncthreads();
    const int lo = args.ph_lo, hi = args.ph_hi;
    const bool multi = (hi - lo) > 1;
    XcdBarrier bar; bar.bar = F.ctl + CW_BAR; bar.x = 0; bar.st = nullptr;
    if (multi) bar = xcd_barrier_post(F.ctl + CW_BAR, F.MISC + 8);
#define IN(k) (lo <= (k) && (k) < hi)
#define SEAM(k) do { if (IN(k) && IN((k) + 1)) xcd_barrier(bar); } while (0)
    unsigned char* ws = args.ws;

#define P1_BODY {     \
        pg8::StaticOrder S; S.init(ws + WS_H, ws + WS_BIN, T, NZ, F.G, F.bid); \
        pg8::EpiZ E{(bf16_t*)(ws + WS_Z), (const float*)(ws + WS_MISC + MO_BIASZ)}; \
        pg8::gemm_phase<pg8::EpiZ, pg8::StaticOrder, true>(F.lds + RING_OFF, S, E); }
#define P4_BODY {     \
        pg8::StaticOrder S; S.init(ws + WS_M2, ws + WS_BOUT, T, D, F.G, F.bid); \
        pg8::EpiRes E{args.out, args.in[I_X]}; \
        pg8::gemm_phase<pg8::EpiRes, pg8::StaticOrder, true>(F.lds + RING_OFF, S, E); }
#define P6_BODY {     \
        moe_tables(F); \
        MoeOrder<8, true> S; S.init(F, ws + WS_H2, ws + WS_BGU, (const int*)(ws + WS_TOK)); \
        pg8::EpiSwiglu E{(bf16_t*)(ws + WS_ACT), (const float*)(ws + WS_MISC + MO_BGU)}; \
        pg8::gemm_phase<pg8::EpiSwiglu, MoeOrder<8, true>, true>(F.lds + RING_OFF, S, E); }
#define P7_BODY {     \
        moe_tables(F); \
        MoeOrder<4, false> S; S.init(F, ws + WS_ACT, ws + WS_BD, nullptr); \
        pg8::EpiDown E{(bf16_t*)(ws + WS_YS), args.in[I_BDN]}; \
        pg8::gemm_phase<pg8::EpiDown, MoeOrder<4, false>, true>(F.lds + RING_OFF, S, E); }
    if (IN(0)) { p0_prologue(F, args); if (PROBE_REP == 0) p0_prologue(F, args); SEAM(0); }
    if (IN(1)) { P1_BODY if (PROBE_REP == 1) P1_BODY SEAM(1); }
    if (IN(2)) { p2_scan(F, args); if (PROBE_REP == 2) p2_scan(F, args); SEAM(2); }
    if (IN(3)) { p3_gmlp(F, args); SEAM(3); }
    if (PROBE_REP == 23) { p2_scan(F, args); xcd_barrier(bar); p3_gmlp(F, args); xcd_barrier(bar); }
    if (IN(4)) { P4_BODY if (PROBE_REP == 4) P4_BODY SEAM(4); }
    if (IN(5)) { p5_router(F, args); SEAM(5); }
    if (IN(6)) { P6_BODY if (PROBE_REP == 6) P6_BODY SEAM(6); }
    if (IN(7)) { P7_BODY if (PROBE_REP == 7) P7_BODY SEAM(7); }
    if (IN(8)) { moe_tables(F); p8_final(F, args); }
#undef IN
#undef SEAM
}

extern "C" void kernel_launch(void* const* d_in, const int* in_sizes, int n_in, void* d_out, int out_size, void* d_ws, size_t ws_size, hipStream_t stream) {
    static int grid = 0;
    if (grid == 0) {
        if (n_in != 28 || out_size != T * D || ws_size < WS_END) { fprintf(stderr, "kernel_launch: unexpected problem (n_in %d, out %d, ws %zu); nothing launched\n", n_in, out_size, ws_size); grid = -1; return; }
        int dev = 0, cus = 0, per_cu = 0;
        if (hipGetDevice(&dev) != hipSuccess || hipDeviceGetAttribute(&cus, hipDeviceAttributeMultiprocessorCount, dev) != hipSuccess) { grid = -1; return; }
        if (hipFuncSetAttribute((const void*)mk_fwd, hipFuncAttributeMaxDynamicSharedMemorySize, LDS_BYTES) != hipSuccess) { fprintf(stderr, "kernel_launch: hipFuncSetAttribute failed\n"); grid = -1; return; }
        if (hipOccupancyMaxActiveBlocksPerMultiprocessor(&per_cu, (const void*)mk_fwd, NWAVES * 64, LDS_BYTES) != hipSuccess || per_cu < 1)
            fprintf(stderr, "kernel_launch: note: occupancy query reports %d workgroups per CU\n", per_cu);
        (void)hipGetLastError();
        grid = cus;
    }
    if (grid < 0) return;
    if (hipMemsetAsync((char*)d_ws + WS_CTL, 0, CTL_ZERO_BYTES, stream) != hipSuccess) return;
    Args a{};
    for (int i = 0; i < 28; ++i) a.in[i] = (const float*)d_in[i];
    a.out = (float*)d_out; a.ws = (unsigned char*)d_ws;
    if (MK_N_LAUNCHES == 1) { a.ph_lo = 0; a.ph_hi = N_PHASES; hipLaunchKernelGGL(mk_fwd, dim3(grid), dim3(NWAVES * 64), LDS_BYTES, stream, a); }
    else for (int p = 0; p < N_PHASES; ++p) { a.ph_lo = p; a.ph_hi = p + 1; hipLaunchKernelGGL(mk_fwd, dim3(grid), dim3(NWAVES * 64), LDS_BYTES, stream, a); }
}
```

```cpp
#include <hip/hip_runtime.h>
#include <cstdio>
#include <cstdint>

#ifndef MK_N_LAUNCHES
#define MK_N_LAUNCHES 1
#endif

#ifndef PROBE_REP
#define PROBE_REP -1
#endif
#define GAS __attribute__((address_space(1)))
#define LAS __attribute__((address_space(3)))
typedef unsigned short bf16_t;
typedef short bf16x8 __attribute__((ext_vector_type(8)));
typedef float f32x4 __attribute__((ext_vector_type(4)));
typedef float f32x2 __attribute__((ext_vector_type(2)));
typedef unsigned u32x4 __attribute__((ext_vector_type(4)));
typedef unsigned u32x2 __attribute__((ext_vector_type(2)));

constexpr int NB_ = 16, SEQ = 2048, D = 1024, T = NB_ * SEQ;
constexpr int NH = 16, HD = 64;
constexpr int NZ = 7680;
constexpr int ZC_R = 0, ZC_K = 1024, ZC_V = 2048, ZC_L = 3072, ZC_U = 3584, ZC_VG = 4608, ZC_GA = 5632, ZC_GB = 6656;
constexpr int TM_R = 0, TM_K = 1024, TM_V = 2048, TM_DL = 3072, TM_AL = 3136, TM_GL = 3200;
constexpr int NE = 32, TOPK = 4, FF = 1024;
constexpr int NSLOT_MAX = T * TOPK + NE * 256;
constexpr float RMS_EPS = 1e-5f, GN_EPS = 64e-5f, LN_EPS = 1e-5f;

constexpr size_t MiB = 1u << 20;
constexpr size_t WS_CTL = 0, CTL_ZERO_BYTES = 1 * MiB;
constexpr size_t WS_BIN = 2 * MiB;
constexpr size_t WS_BOUT = 18 * MiB;
constexpr size_t WS_BGU = 20 * MiB;
constexpr size_t WS_BD = 148 * MiB;
constexpr size_t WS_MISC = 212 * MiB;
constexpr size_t WS_TOK = 216 * MiB;
constexpr size_t WS_H = 220 * MiB;
constexpr size_t WS_Z = 284 * MiB;
constexpr size_t WS_M = 764 * MiB;
constexpr size_t WS_M2 = 828 * MiB;
constexpr size_t WS_H2 = 892 * MiB;
constexpr size_t WS_END = 956 * MiB;
constexpr size_t WS_ACT = WS_Z;
constexpr size_t WS_YS = WS_Z + 272 * MiB;
static_assert((size_t)NSLOT_MAX * FF * 2 == 272 * MiB && WS_YS + 272 * MiB == WS_M2, "ws map");
constexpr size_t MO_BIASZ = 0;
constexpr size_t MO_BGU = 64 * 1024;
constexpr size_t MO_WRT = 512 * 1024;
constexpr size_t MO_ASG = 1 * MiB;
constexpr size_t MO_GATE = 2 * MiB;
constexpr size_t MO_LT = 3 * MiB;
constexpr int CW_TMO = 0, CW_CODE = 1;
constexpr int CW_BAR = 4096;
constexpr int CW_CNT = 8192;

constexpr int RING_OFF = 0, RING_BYTES = 131072;
constexpr int LDSCTL_OFF = RING_BYTES, MISC_OFF = LDSCTL_OFF + 320;
constexpr int SCHED_OFF = LDSCTL_OFF + 1024;
constexpr int LDS_BYTES = 147456;
constexpr int NWAVES = 8;

#define RLX_AGENT __ATOMIC_RELAXED, __HIP_MEMORY_SCOPE_AGENT
#define LDS_WAIT() asm volatile("s_waitcnt lgkmcnt(0)" ::: "memory")
#define VM_WAIT() asm volatile("s_waitcnt vmcnt(0)" ::: "memory")
typedef __bf16 bf16x2_t __attribute__((ext_vector_type(2)));
__device__ __forceinline__ unsigned cvt_pk_bf16(float lo, float hi) { bf16x2_t v; v.x = (__bf16)lo; v.y = (__bf16)hi; return __builtin_bit_cast(unsigned, v); }
__device__ __forceinline__ float bf_lo(unsigned u) { return __builtin_bit_cast(float, u << 16); }
__device__ __forceinline__ float bf_hi(unsigned u) { return __builtin_bit_cast(float, u & 0xffff0000u); }
__device__ __forceinline__ float bf2f(bf16_t b) { return __builtin_bit_cast(float, ((unsigned)b) << 16); }
template <int CTRL> __device__ __forceinline__ float dpp(float x) { return __builtin_bit_cast(float, __builtin_amdgcn_mov_dpp(__builtin_bit_cast(int, x), CTRL, 0xf, 0xf, true)); }
__device__ __forceinline__ float allsum16(float x) {
    x += dpp<0xB1>(x); x += dpp<0x4E>(x); x += dpp<0x141>(x); x += dpp<0x140>(x); return x;
}
__device__ __forceinline__ float wave_sum(float v) {
#pragma unroll
    for (int o = 1; o < 64; o <<= 1) v += __shfl_xor(v, o);
    return v;
}
__device__ __forceinline__ float sigmoidf_(float x) { return __builtin_amdgcn_rcpf(1.0f + __expf(-x)); }
__device__ __forceinline__ f32x2 gelu_pk(f32x2 v) {
    const f32x2 av = __builtin_elementwise_abs(v), d = av * 0.2316418882f + 1.0f;
    f32x2 t; t.x = __builtin_amdgcn_rcpf(d.x); t.y = __builtin_amdgcn_rcpf(d.y);
    f32x2 q = t * 0.5307027145f + (-0.7265760135f); q = q * t + 0.7107068705f; q = q * t + (-0.142248368f); q = q * t + 0.127414796f; q = q * t;
    const f32x2 s = (v * v) * (-0.72134752044f);
    f32x2 e; e.x = __builtin_amdgcn_exp2f(s.x); e.y = __builtin_amdgcn_exp2f(s.y);
    const f32x2 m = v * (q * e), r = v - m;
    f32x2 o; o.x = v.x < 0.f ? m.x : r.x; o.y = v.y < 0.f ? m.y : r.y; return o;
}

namespace pg8 {
constexpr int BM = 256, BK = 64, HALF = 128, HTB = HALF * BK * 2, STAGE_BYTES = 8 * HTB, NXCD = 8, WGM = 8;
constexpr int KK = 1024;
__host__ __device__ __forceinline__ int lds_byte(int r, int c) { const int st = (r >> 4) * 2 + (c >> 5), rr = r & 15, cc = c & 31, ob = rr * 64 + cc * 2; return st * 1024 + (ob ^ (((ob >> 9) & 1) << 5)); }
__host__ __device__ __forceinline__ void stage_rc(int b, int& R, int& C) { const int st = b / 1024, sb = b % 1024, swz = sb ^ (((sb >> 9) & 1) << 5); R = (st >> 1) * 16 + swz / 64; C = (st & 1) * 32 + (swz % 64) / 2; }
__host__ __device__ __forceinline__ int perm32(int rho) { const int n = rho >> 4, i = rho & 15; return 8 * (i >> 2) + 4 * n + (i & 3); }

struct Unit { const char* A; const char* B; int r0, c0, e, aux; };

struct StaticOrder {
    const char* A; const char* B; int nM, nN, nwg, G, c;
    static constexpr bool GATHER = false;
    __device__ void init(const void* A_, const void* B_, int M, int N, int G_, int c_) { A = (const char*)A_; B = (const char*)B_; nM = M / BM; nN = N / BM; nwg = nM * nN; G = G_; c = c_; }
    __device__ bool next(int i, Unit& u) const {
        const long L = (long)i * G + c; if (L >= nwg) return false;
        int wgid = (int)L; { const int q = nwg / NXCD, r = nwg % NXCD, xcd = wgid % NXCD, off = wgid / NXCD; wgid = (xcd < r ? xcd * (q + 1) : r * (q + 1) + (xcd - r) * q) + off; }
        const int nig = WGM * nN, gid = wgid / nig, fm = gid * WGM, gsz = (nM - fm) < WGM ? (nM - fm) : WGM;
        const int pm = fm + ((wgid % nig) % gsz), pn = (wgid % nig) / gsz;
        u.A = A + (size_t)pm * (BM * KK * 2); u.B = B + (size_t)pn * (BM * KK * 2); u.r0 = pm * BM; u.c0 = pn * BM; u.e = 0; u.aux = 0; return true;
    }
    __device__ __forceinline__ void a_offs(const Unit&, unsigned (&ga)[2][2], const int (&R)[2], const int (&C)[2]) const {
#pragma unroll
        for (int h = 0; h < 2; ++h)
#pragma unroll
            for (int i = 0; i < 2; ++i) ga[h][i] = (unsigned)((h * HALF + R[i]) * KK + C[i]) * 2u;
    }
};

template <class Epi, class Sched, bool ALIGN_EPI = false>
__device__ __forceinline__ void gemm_phase(LAS unsigned char* lds, const Sched& S, const Epi& E) {
    const int tid = threadIdx.x, wid = __builtin_amdgcn_readfirstlane(tid >> 6), lane = tid & 63, wr = wid >> 2, wc = wid & 3, fr = lane & 15, fq = lane >> 4;
    constexpr int K = KK, nt = K / BK;
    unsigned voffB[2]; int Rr[2], Cc[2];
#pragma unroll
    for (int i = 0; i < 2; ++i) { int R, C; stage_rc(tid * 16 + i * 8192, R, C); const int Rb = Epi::PERM ? ((R & ~31) + perm32(R & 31)) : R;
        Rr[i] = R; Cc[i] = C; voffB[i] = (unsigned)(Rb * K + C) * 2u; }
    const size_t kstep = (size_t)(BK * 2);
    const size_t hstep = (size_t)HALF * K * 2;
    const unsigned ldsw = (unsigned)wid * 1024u;
    const int aoff = lds_byte(wr * 64 + fr, fq * 8), boff = lds_byte(wc * 32 + fr, fq * 8);
#define PG8_SA(b, h) (((b) * 2 + (h)) * HTB)
#define PG8_SB(b, h) ((4 + (b) * 2 + (h)) * HTB)
#define PG8_STAGE(bufoff, gbase, voff) do { _Pragma("unroll") for (int _i = 0; _i < 2; ++_i) \
        __builtin_amdgcn_global_load_lds((const unsigned*)((const char*)(gbase) + (voff)[_i]), (LAS unsigned*)(lds + (bufoff) + ldsw + _i * 8192), 16, 0, 0); } while (0)
#define PG8_LDA(dst, b, h) do { _Pragma("unroll") for (int m = 0; m < 4; ++m) _Pragma("unroll") for (int k = 0; k < 2; ++k) dst[m][k] = *(const LAS bf16x8*)(lds + PG8_SA(b, h) + aoff + m * 2048 + k * 1024); } while (0)
#define PG8_LDB(dst, b, h) do { _Pragma("unroll") for (int n = 0; n < 2; ++n) _Pragma("unroll") for (int k = 0; k < 2; ++k) dst[n][k] = *(const LAS bf16x8*)(lds + PG8_SB(b, h) + boff + n * 2048 + k * 1024); } while (0)
#define PG8_MMA(ai, bj, At, Bt) do { __builtin_amdgcn_s_setprio(1); _Pragma("unroll") for (int m = 0; m < 4; ++m) _Pragma("unroll") for (int n = 0; n < 2; ++n) _Pragma("unroll") for (int k = 0; k < 2; ++k) \
        acc[ai][bj][m][n] = __builtin_amdgcn_mfma_f32_16x16x32_bf16(Bt[n][k], At[m][k], acc[ai][bj][m][n], 0, 0, 0); __builtin_amdgcn_s_setprio(0); } while (0)
#define PG8_WAIT_V(n) asm volatile("s_waitcnt vmcnt(" #n ")" ::: "memory")
#define PG8_WAIT_L(n) asm volatile("s_waitcnt lgkmcnt(" #n ")" ::: "memory")
#define PG8_BAR __builtin_amdgcn_s_barrier()
#define PG8_SCHED __builtin_amdgcn_sched_barrier(0)
    Unit cur, nxt; int ui = 0;
    if (!S.next(0, cur)) return;
    f32x4 acc[2][2][4][2];
#pragma unroll
    for (int a = 0; a < 2; ++a)
#pragma unroll
        for (int b = 0; b < 2; ++b)
#pragma unroll
            for (int m = 0; m < 4; ++m)
#pragma unroll
                for (int n = 0; n < 2; ++n) acc[a][b][m][n] = (f32x4){0.f, 0.f, 0.f, 0.f};
    bf16x8 At[4][2], B0[2][2], B1[2][2];
    unsigned ga[2][2], gn[2][2];
    S.a_offs(cur, ga, Rr, Cc);
    const char* cA = cur.A; const char* cB = cur.B;
    PG8_STAGE(PG8_SB(0, 0), cB, voffB); PG8_STAGE(PG8_SB(0, 1), cB + hstep, voffB); PG8_STAGE(PG8_SA(0, 0), cA, ga[0]); PG8_STAGE(PG8_SA(0, 1), cA, ga[1]);
    if (wr == 1) PG8_BAR;
    PG8_WAIT_V(2); PG8_BAR;
    PG8_STAGE(PG8_SB(1, 0), cB + kstep, voffB); PG8_STAGE(PG8_SA(1, 0), cA + kstep, ga[0]); PG8_STAGE(PG8_SB(1, 1), cB + hstep + kstep, voffB);
    PG8_WAIT_V(6); PG8_BAR;
    for (;;) {
        const bool has_next = S.next(ui + 1, nxt);
        const char* nA = has_next ? nxt.A : cA; const char* nB = has_next ? nxt.B : cB;
#pragma unroll
        for (int h = 0; h < 2; ++h)
#pragma unroll
            for (int i = 0; i < 2; ++i) gn[h][i] = ga[h][i];
        for (int t = 0; t < nt; t += 2) {
            const bool last = (t == nt - 2);
            if (Sched::GATHER && last && has_next) S.a_offs(nxt, gn, Rr, Cc);
            const char* a1 = cA + (size_t)(t + 1) * kstep;
            const char* a2 = last ? nA : cA + (size_t)(t + 2) * kstep; const char* b2 = last ? nB : cB + (size_t)(t + 2) * kstep;
            const char* a3 = a2 + kstep; const char* b3 = b2 + kstep;
            unsigned g2[2][2];
#pragma unroll
            for (int h = 0; h < 2; ++h)
#pragma unroll
                for (int i = 0; i < 2; ++i) g2[h][i] = last ? gn[h][i] : ga[h][i];
            PG8_LDB(B0, 0, 0); PG8_LDB(B1, 0, 1); PG8_SCHED; PG8_LDA(At, 0, 0); PG8_STAGE(PG8_SA(1, 1), a1, ga[1]);
            PG8_WAIT_V(8); PG8_WAIT_L(0); PG8_BAR; PG8_MMA(0, 0, At, B0); PG8_MMA(0, 1, At, B1); PG8_BAR; PG8_SCHED;
            PG8_LDA(At, 0, 1); PG8_STAGE(PG8_SB(0, 0), b2, voffB); PG8_STAGE(PG8_SB(0, 1), b2 + hstep, voffB); PG8_STAGE(PG8_SA(0, 0), a2, g2[0]);
            PG8_WAIT_V(8); PG8_WAIT_L(0); PG8_BAR; PG8_MMA(1, 0, At, B0); PG8_MMA(1, 1, At, B1); PG8_BAR; PG8_SCHED;
            PG8_LDB(B0, 1, 0); PG8_LDB(B1, 1, 1); PG8_SCHED; PG8_LDA(At, 1, 0); PG8_STAGE(PG8_SA(0, 1), a2, g2[1]);
            PG8_WAIT_V(8); PG8_WAIT_L(0); PG8_BAR; PG8_MMA(0, 0, At, B0); PG8_MMA(0, 1, At, B1); PG8_BAR; PG8_SCHED;
            PG8_LDA(At, 1, 1); PG8_STAGE(PG8_SB(1, 0), b3, voffB); PG8_STAGE(PG8_SB(1, 1), b3 + hstep, voffB); PG8_STAGE(PG8_SA(1, 0), a3, g2[0]);
            PG8_WAIT_V(8); PG8_WAIT_L(0); PG8_BAR; PG8_MMA(1, 0, At, B0); PG8_MMA(1, 1, At, B1); PG8_BAR; PG8_SCHED;
        }
        if constexpr (ALIGN_EPI) { if (wr == 0) PG8_BAR; }
        E(acc, cur, wr, wc, fr, fq);
        if (!has_next) break;
#pragma unroll
        for (int a = 0; a < 2; ++a)
#pragma unroll
            for (int b = 0; b < 2; ++b)
#pragma unroll
                for (int m = 0; m < 4; ++m)
#pragma unroll
                    for (int n = 0; n < 2; ++n) acc[a][b][m][n] = (f32x4){0.f, 0.f, 0.f, 0.f};
        cur = nxt; cA = nA; cB = nB; ++ui;
#pragma unroll
        for (int h = 0; h < 2; ++h)
#pragma unroll
            for (int i = 0; i < 2; ++i) ga[h][i] = gn[h][i];
        if constexpr (ALIGN_EPI) { if (wr == 1) PG8_BAR; }
    }
    PG8_WAIT_V(0);
    if constexpr (!ALIGN_EPI) { if (wr == 0) PG8_BAR; }
    PG8_BAR;
#undef PG8_SA
#undef PG8_SB
#undef PG8_STAGE
#undef PG8_LDA
#undef PG8_LDB
#undef PG8_MMA
#undef PG8_WAIT_V
#undef PG8_WAIT_L
#undef PG8_BAR
#undef PG8_SCHED
}


struct EpiZ {
    static constexpr bool PERM = true;
    bf16_t* O; const float* bias;
    __device__ __forceinline__ void operator()(const f32x4 (&acc)[2][2][4][2], const Unit& u, int wr, int wc, int fr, int fq) const {
        const int row0 = u.r0 + wr * 64 + fr, col0 = u.c0 + wc * 32 + 8 * fq;
        const int mode = (u.c0 < ZC_U) ? 0 : (u.c0 < ZC_GA ? 1 : 2);
        f32x4 bv[2][2];
#pragma unroll
        for (int bj = 0; bj < 2; ++bj)
#pragma unroll
            for (int n = 0; n < 2; ++n) bv[bj][n] = *(const f32x4*)(bias + col0 + bj * HALF + 4 * n);
#pragma unroll
        for (int ai = 0; ai < 2; ++ai)
#pragma unroll
            for (int m = 0; m < 4; ++m) { bf16_t* rowp = O + (size_t)(row0 + ai * HALF + m * 16) * NZ + col0;
#pragma unroll
                for (int bj = 0; bj < 2; ++bj) { f32x4 v0 = acc[ai][bj][m][0] + bv[bj][0], v1 = acc[ai][bj][m][1] + bv[bj][1];
                    if (mode == 1) { f32x2 a = gelu_pk((f32x2){v0[0], v0[1]}), b = gelu_pk((f32x2){v0[2], v0[3]}), c = gelu_pk((f32x2){v1[0], v1[1]}), d = gelu_pk((f32x2){v1[2], v1[3]});
                        v0 = (f32x4){a.x, a.y, b.x, b.y}; v1 = (f32x4){c.x, c.y, d.x, d.y}; }
                    else if (mode == 2) {
#pragma unroll
                        for (int j = 0; j < 4; ++j) { v0[j] = sigmoidf_(v0[j]); v1[j] = sigmoidf_(v1[j]); } }
                    u32x4 w; w.x = cvt_pk_bf16(v0[0], v0[1]); w.y = cvt_pk_bf16(v0[2], v0[3]); w.z = cvt_pk_bf16(v1[0], v1[1]); w.w = cvt_pk_bf16(v1[2], v1[3]);
                    *(u32x4*)(rowp + bj * HALF) = w; } }
    }
};
struct EpiRes {
    static constexpr bool PERM = false;
    float* C; const float* base;
    __device__ __forceinline__ void operator()(const f32x4 (&acc)[2][2][4][2], const Unit& u, int wr, int wc, int fr, int fq) const {
        const int row0 = u.r0 + wr * 64 + fr, col0 = u.c0 + wc * 32 + 4 * fq;
#pragma unroll
        for (int ai = 0; ai < 2; ++ai)
#pragma unroll
            for (int m = 0; m < 4; ++m) { const size_t ro = (size_t)(row0 + ai * HALF + m * 16) * D + col0;
#pragma unroll
                for (int bj = 0; bj < 2; ++bj)
#pragma unroll
                    for (int n = 0; n < 2; ++n) *(f32x4*)(C + ro + bj * HALF + n * 16) = acc[ai][bj][m][n] + *(const f32x4*)(base + ro + bj * HALF + n * 16); }
    }
};
struct EpiSwiglu {
    static constexpr bool PERM = true;
    bf16_t* O; const float* bias;
    __device__ __forceinline__ void operator()(const f32x4 (&acc)[2][2][4][2], const Unit& u, int wr, int wc, int fr, int fq) const {
        const int row0 = u.r0 + wr * 64 + fr, fl = wc * 32 + 8 * fq;
        const float* bp = bias + (size_t)u.e * 2048 + u.c0 + fl;
        f32x4 bg[2], bu[2];
#pragma unroll
        for (int n = 0; n < 2; ++n) { bg[n] = *(const f32x4*)(bp + 4 * n); bu[n] = *(const f32x4*)(bp + HALF + 4 * n); }
        const int f0 = (u.c0 >> 1) + fl;
#pragma unroll
        for (int ai = 0; ai < 2; ++ai)
#pragma unroll
            for (int m = 0; m < 4; ++m) { bf16_t* rowp = O + (size_t)(row0 + ai * HALF + m * 16) * FF + f0;
                float a[8];
#pragma unroll
                for (int n = 0; n < 2; ++n)
#pragma unroll
                    for (int j = 0; j < 4; ++j) { float g = acc[ai][0][m][n][j] + bg[n][j], up = acc[ai][1][m][n][j] + bu[n][j];
                        g = fminf(g, 7.0f); up = fminf(fmaxf(up, -7.0f), 7.0f);
                        a[n * 4 + j] = g * sigmoidf_(1.702f * g) * (up + 1.0f); }
                u32x4 w; w.x = cvt_pk_bf16(a[0], a[1]); w.y = cvt_pk_bf16(a[2], a[3]); w.z = cvt_pk_bf16(a[4], a[5]); w.w = cvt_pk_bf16(a[6], a[7]);
                *(u32x4*)rowp = w; }
    }
};
struct EpiDown {
    static constexpr bool PERM = true;
    bf16_t* O; const float* bias;
    __device__ __forceinline__ void operator()(const f32x4 (&acc)[2][2][4][2], const Unit& u, int wr, int wc, int fr, int fq) const {
        const int row0 = u.r0 + wr * 64 + fr, col0 = u.c0 + wc * 32 + 8 * fq;
        const float* bp = bias + (size_t)u.e * D + col0;
        f32x4 bv[2][2];
#pragma unroll
        for (int bj = 0; bj < 2; ++bj)
#pragma unroll
            for (int n = 0; n < 2; ++n) bv[bj][n] = *(const f32x4*)(bp + bj * HALF + 4 * n);
#pragma unroll
        for (int ai = 0; ai < 2; ++ai)
#pragma unroll
            for (int m = 0; m < 4; ++m) { bf16_t* rowp = O + (size_t)(row0 + ai * HALF + m * 16) * D + col0;
#pragma unroll
                for (int bj = 0; bj < 2; ++bj) { const f32x4 v0 = acc[ai][bj][m][0] + bv[bj][0], v1 = acc[ai][bj][m][1] + bv[bj][1];
                    u32x4 w; w.x = cvt_pk_bf16(v0[0], v0[1]); w.y = cvt_pk_bf16(v0[2], v0[3]); w.z = cvt_pk_bf16(v1[0], v1[1]); w.w = cvt_pk_bf16(v1[2], v1[3]);
                    *(u32x4*)(rowp + bj * HALF) = w; } }
    }
};
}

#define XB_TMO      128
#define XB_XCNT(j)  (256  + 64 * (j))
#define XB_XSUB(j)  (1280 + 64 * (j))
#define XB_XGEN(j)  (2304 + 64 * (j))
#define XB_TOP      3328
#define XB_TOPGEN   3392
#define XCD_BAR_WORDS 3456
#define XB_SPIN_CAP (1u << 18)
__device__ __forceinline__ unsigned xb_ld(unsigned* p)              { return __hip_atomic_load(p, __ATOMIC_RELAXED, __HIP_MEMORY_SCOPE_AGENT); }
__device__ __forceinline__ unsigned xb_add(unsigned* p, unsigned v) { return __hip_atomic_fetch_add(p, v, __ATOMIC_RELAXED, __HIP_MEMORY_SCOPE_AGENT); }
__device__ __forceinline__ unsigned xb_xcc_id() { return (unsigned)__builtin_amdgcn_s_getreg((3 << 11) | 20) & 0xFu; }
#define XB_SPIN(cond, bar) do { unsigned _sp = 0; while (cond) { __builtin_amdgcn_s_sleep(1); \
    if ((++_sp & 255u) == 0u) { if (xb_ld(&(bar)[XB_TMO])) break; if (_sp > XB_SPIN_CAP) { atomicAdd(&(bar)[XB_TMO], 1u); break; } } } } while (0)
struct XcdBarrier { unsigned* bar; unsigned x; volatile LAS unsigned* st; };
__device__ __forceinline__ XcdBarrier xcd_barrier_post(unsigned* bar, volatile LAS unsigned* st) {
    XcdBarrier b; b.bar = bar; b.x = xb_xcc_id(); b.st = st;
    if (threadIdx.x == 0) (void)xb_add(&bar[XB_XCNT(b.x)], 1u);
    return b;
}
__device__ __forceinline__ void xcd_barrier_complete(unsigned* bar, unsigned x, unsigned& nloc, unsigned& nx) {
    const unsigned G = gridDim.x * gridDim.y * gridDim.z;
    unsigned sum, cnt, mine, sp = 0u;
    for (;;) {
        sum = 0u; cnt = 0u; mine = 0u;
#pragma unroll
        for (unsigned j = 0; j < 16; ++j) { const unsigned c = xb_ld(&bar[XB_XCNT(j)]); sum += c; cnt += (c > 0u) ? 1u : 0u; mine = (j == x) ? c : mine; }
        if (sum == G) break;
        __builtin_amdgcn_s_sleep(1);
        if ((++sp & 255u) == 0u) { if (xb_ld(&bar[XB_TMO])) break; if (sp > XB_SPIN_CAP) { atomicAdd(&bar[XB_TMO], 1u); break; } }
    }
    nloc = mine > 0u ? mine : 1u; nx = cnt > 0u ? cnt : 1u;
}
__device__ __forceinline__ void xcd_barrier(const XcdBarrier& b) {
    asm volatile("s_waitcnt vmcnt(0)" ::: "memory");
    __syncthreads();
    if (threadIdx.x == 0) {
        unsigned* bar = b.bar;
        __builtin_amdgcn_s_waitcnt(0);
        unsigned nloc = b.st[0], nx = b.st[1];
        if (nloc == 0u) { xcd_barrier_complete(bar, b.x, nloc, nx); b.st[0] = nloc; b.st[1] = nx; }
        const unsigned old = xb_add(&bar[XB_XSUB(b.x)], 1u);
        const unsigned gen = old / nloc;
        if (old + 1u == (gen + 1u) * nloc) {
            __builtin_amdgcn_fence(__ATOMIC_RELEASE, "agent");
            asm volatile("s_waitcnt vmcnt(0)" ::: "memory");
            const unsigned og = xb_add(&bar[XB_TOP], 1u);
            const unsigned tg = og / nx;
            if (og + 1u == (tg + 1u) * nx) xb_add(&bar[XB_TOPGEN], 1u);
            else XB_SPIN(xb_ld(&bar[XB_TOPGEN]) == tg, bar);
            __builtin_amdgcn_fence(__ATOMIC_ACQUIRE, "agent");
            xb_add(&bar[XB_XGEN(b.x)], 1u);
            asm volatile("s_waitcnt vmcnt(0)" ::: "memory");
        } else {
            XB_SPIN(xb_ld(&bar[XB_XGEN(b.x)]) == gen, bar);
            __builtin_amdgcn_fence(__ATOMIC_ACQUIRE, "agent");
            asm volatile("s_waitcnt vmcnt(0)" ::: "memory");
        }
    }
    __syncthreads();
}

struct Args {
    const float* in[28]; float* out; unsigned char* ws; int ph_lo, ph_hi;
};
struct Frame {
    LAS unsigned char* lds; volatile LAS unsigned* MISC; unsigned* ctl;
    int tid, lane, wave, G, bid;
};
enum { I_X = 0, I_N1G, I_WIN, I_BGATE, I_TMIX, I_WDU, I_W0, I_AUP, I_A0, I_GUP, I_KK, I_KA, I_RK, I_GNW, I_GNB, I_LNVG, I_LNVB, I_WSP, I_BSP, I_WOUT, I_N2G, I_WR, I_BR, I_WGU, I_BGU, I_WD, I_BDN, I_NFG };

template <class RowMap>
__device__ __forceinline__ void p0_transpose_item(const float* W, int K, int N, bf16_t* WT, const RowMap& rm, LAS float* scr, int item, int lane) {
    const int nblk = N / 32, kb = item / nblk, nb = item % nblk, k0 = 64 * kb, n0 = 32 * nb;
#pragma unroll 8
    for (int i = 0; i < 32; ++i) { const int kk = 2 * i + (lane >> 5); scr[kk * 33 + (lane & 31)] = W[(size_t)(k0 + kk) * N + n0 + (lane & 31)]; }
    LDS_WAIT(); asm volatile("" ::: "memory");
    const int c = lane & 7;
#pragma unroll
    for (int j = 0; j < 4; ++j) { const int n = (lane >> 3) + 8 * j; const LAS float* s = scr + (8 * c) * 33 + n;
        u32x4 o; o.x = cvt_pk_bf16(s[0 * 33], s[1 * 33]); o.y = cvt_pk_bf16(s[2 * 33], s[3 * 33]); o.z = cvt_pk_bf16(s[4 * 33], s[5 * 33]); o.w = cvt_pk_bf16(s[6 * 33], s[7 * 33]);
        *(u32x4*)(WT + (size_t)rm(n0 + n) * K + k0 + 8 * c) = o; }
    LDS_WAIT(); asm volatile("" ::: "memory");
}
struct RmId { __device__ __forceinline__ int operator()(int n) const { return n; } };
struct RmIn { __device__ __forceinline__ int operator()(int n) const { return n < 3360 ? n : n + 224; } };
struct RmGu { __device__ __forceinline__ int operator()(int n) const { const int f = n >> 1, up = n & 1; return (f >> 7) * 256 + up * 128 + (f & 127); } };

__device__ __forceinline__ void p0_prologue(Frame& F, const Args& a) {
    unsigned char* ws = a.ws;
    bf16_t* Bin = (bf16_t*)(ws + WS_BIN); bf16_t* Bout = (bf16_t*)(ws + WS_BOUT); bf16_t* Bgu = (bf16_t*)(ws + WS_BGU); bf16_t* Bd = (bf16_t*)(ws + WS_BD);
    LAS float* scr = (LAS float*)(F.lds + RING_OFF + F.wave * 16384);
    const int gw = F.bid * NWAVES + F.wave, NGW = F.G * NWAVES;
    constexpr int I_IN = (D / 64) * (7456 / 32), I_OUT = (D / 64) * (D / 32), I_GU1 = (D / 64) * (2048 / 32), I_D1 = (FF / 64) * (D / 32);
    constexpr int NITEMS = I_IN + I_OUT + NE * I_GU1 + NE * I_D1;
    for (int it = gw; it < NITEMS; it += NGW) {
        int r = it;
        if (r < I_IN) { p0_transpose_item(a.in[I_WIN], D, 7456, Bin, RmIn(), scr, r, F.lane); continue; } r -= I_IN;
        if (r < I_OUT) { p0_transpose_item(a.in[I_WOUT], D, D, Bout, RmId(), scr, r, F.lane); continue; } r -= I_OUT;
        if (r < NE * I_GU1) { const int e = r / I_GU1; p0_transpose_item(a.in[I_WGU] + (size_t)e * D * 2048, D, 2048, Bgu + (size_t)e * 2048 * D, RmGu(), scr, r % I_GU1, F.lane); continue; } r -= NE * I_GU1;
        { const int e = r / I_D1; p0_transpose_item(a.in[I_WD] + (size_t)e * FF * D, FF, D, Bd + (size_t)e * D * FF, RmId(), scr, r % I_D1, F.lane); }
    }
    const int gt = F.bid * (NWAVES * 64) + F.tid, NGT = F.G * NWAVES * 64;
    {
        u32x4* p = (u32x4*)(Bin + (size_t)3360 * D);
        for (int i = gt; i < 224 * 128; i += NGT) p[i] = (u32x4){0u, 0u, 0u, 0u};
    }
    {   float* bz = (float*)(ws + WS_MISC + MO_BIASZ);
        for (int i = gt; i < NZ; i += NGT) bz[i] = (i >= ZC_GA) ? a.in[I_BGATE][i - ZC_GA] : 0.f;
    }
    {   float* bg = (float*)(ws + WS_MISC + MO_BGU);
        for (int i = gt; i < NE * 2048; i += NGT) { const int e = i >> 11, n = i & 2047; bg[(size_t)e * 2048 + RmGu()(n)] = a.in[I_BGU][i]; }
    }
    {   bf16_t* wh = (bf16_t*)(ws + WS_MISC + MO_WRT); bf16_t* wl = wh + NE * D;
        for (int i = gt; i < NE * D; i += NGT) { const int e = i >> 10, k = i & 1023; const float w = a.in[I_WR][(size_t)k * NE + e];
            const unsigned h = cvt_pk_bf16(w, 0.f) & 0xffffu; const float rlo = w - bf_lo(h); wh[i] = (bf16_t)h; wl[i] = (bf16_t)(cvt_pk_bf16(rlo, 0.f) & 0xffffu); }
    }
    {   bf16_t* lt = (bf16_t*)(ws + WS_MISC + MO_LT);
        for (int i = gt; i < D * 288; i += NGT) { const int n = i / 288, k = i - n * 288;
            const float w = (k < 64) ? a.in[I_WDU][(size_t)k * D + n] : (k < 128 ? a.in[I_AUP][(size_t)(k - 64) * D + n] : a.in[I_GUP][(size_t)(k - 128) * D + n]);
            lt[i] = (bf16_t)(cvt_pk_bf16(w, 0.f) & 0xffffu); }
    }
    const float* x = a.in[I_X]; const float* g1 = a.in[I_N1G]; bf16_t* Hh = (bf16_t*)(ws + WS_H);
    f32x4 gv[4];
#pragma unroll
    for (int j = 0; j < 4; ++j) gv[j] = *((const f32x4*)g1 + F.lane + 64 * j);
    for (int m = gw; m < T; m += NGW) {
        const f32x4* xr = (const f32x4*)(x + (size_t)m * D) + F.lane;
        f32x4 v[4]; float s = 0.f;
#pragma unroll
        for (int j = 0; j < 4; ++j) { v[j] = xr[64 * j]; s += (v[j].x * v[j].x + v[j].y * v[j].y) + (v[j].z * v[j].z + v[j].w * v[j].w); }
        const float rstd = __builtin_amdgcn_rsqf(wave_sum(s) * (1.f / D) + RMS_EPS);
        u32x2* o8 = (u32x2*)(Hh + (size_t)m * D) + F.lane;
#pragma unroll
        for (int j = 0; j < 4; ++j) { const f32x4 y = v[j] * rstd * gv[j]; o8[64 * j] = (u32x2){cvt_pk_bf16(y.x, y.y), cvt_pk_bf16(y.z, y.w)}; }
    }
}

constexpr int TC = 32;
constexpr int SV_STRIDE = (TC + 1) * 256;
constexpr int SB_KK = 0, SB_W = SV_STRIDE, SB_NB = 2 * SV_STRIDE, SB_KP = 3 * SV_STRIDE, SB_R = 4 * SV_STRIDE, SB_V = 5 * SV_STRIDE;
constexpr int SB_Y = 6 * SV_STRIDE;
constexpr int SB_ARAW = SB_Y + TC * 256;
constexpr int SB_G = SB_ARAW + TC * 256;
constexpr int RL_STRIDE = 592;
constexpr int SB_RAWL = SB_G + TC * 256;
constexpr int SB_RAWRKV = SB_RAWL + (TC + 1) * RL_STRIDE;
constexpr int SB_RAWGA = SB_RAWRKV + (TC + 1) * 384;
constexpr int SB_AMAT = SB_RAWGA + TC * 128;
constexpr int SB_END = SB_AMAT + TC * RL_STRIDE;
constexpr int SB_TML = LDSCTL_OFF + 2048;
static_assert(SB_END <= RING_BYTES && SB_TML + 1152 <= LDS_BYTES, "scan LDS map");
constexpr int NP_L = (TC + 1) * 36, NP_RKV = (TC + 1) * 24, NP_GA = TC * 8, NP_ALL = NP_L + NP_RKV + NP_GA;
constexpr int NPF = (NP_ALL + 511) / 512;

__device__ __forceinline__ f32x4 ld_bf4(const bf16_t* p) { const u32x2 v = *(const u32x2*)p; return (f32x4){bf_lo(v.x), bf_hi(v.x), bf_lo(v.y), bf_hi(v.y)}; }
__device__ __forceinline__ f32x4 lds_bf4(const LAS unsigned char* p) { const u32x2 v = *(const LAS u32x2*)p; return (f32x4){bf_lo(v.x), bf_hi(v.x), bf_lo(v.y), bf_hi(v.y)}; }
__device__ __forceinline__ void ld_bf8(const bf16_t* p, float (&o)[8]) { const u32x4 v = *(const u32x4*)p;
    o[0] = bf_lo(v.x); o[1] = bf_hi(v.x); o[2] = bf_lo(v.y); o[3] = bf_hi(v.y); o[4] = bf_lo(v.z); o[5] = bf_hi(v.z); o[6] = bf_lo(v.w); o[7] = bf_hi(v.w); }
__device__ __forceinline__ void un8(const u32x4 v, float (&o)[8]) {
    o[0] = bf_lo(v.x); o[1] = bf_hi(v.x); o[2] = bf_lo(v.y); o[3] = bf_hi(v.y); o[4] = bf_lo(v.z); o[5] = bf_hi(v.z); o[6] = bf_lo(v.w); o[7] = bf_hi(v.w); }
__device__ __forceinline__ bf16x8 pack8(const float (&o)[8]) { u32x4 w; w.x = cvt_pk_bf16(o[0], o[1]); w.y = cvt_pk_bf16(o[2], o[3]); w.z = cvt_pk_bf16(o[4], o[5]); w.w = cvt_pk_bf16(o[6], o[7]); return __builtin_bit_cast(bf16x8, w); }

__device__ __forceinline__ void a_mul(float& d, float a, float b) { asm volatile("v_mul_f32 %0, %1, %2" : "=v"(d) : "v"(a), "v"(b)); }
__device__ __forceinline__ void a_fma(float& d, float a, float b, float c) { asm volatile("v_fma_f32 %0, %1, %2, %3" : "=v"(d) : "v"(a), "v"(b), "v"(c)); }
__device__ __forceinline__ void a_fmac(float& d, float a, float b) { asm volatile("v_fmac_f32 %0, %1, %2" : "+v"(d) : "v"(a), "v"(b)); }
__device__ __forceinline__ void a_x1(float& d) { asm volatile("v_add_f32_dpp %0, %0, %0 quad_perm:[1,0,3,2] row_mask:0xf bank_mask:0xf bound_ctrl:1" : "+v"(d)); }
__device__ __forceinline__ void a_x2(float& d) { asm volatile("v_add_f32_dpp %0, %0, %0 quad_perm:[2,3,0,1] row_mask:0xf bank_mask:0xf bound_ctrl:1" : "+v"(d)); }
__device__ __forceinline__ void a_x4(float& d) { asm volatile("v_add_f32_dpp %0, %0, %0 row_half_mirror row_mask:0xf bank_mask:0xf bound_ctrl:1" : "+v"(d)); }
__device__ __forceinline__ void a_x8(float& d) { asm volatile("v_add_f32_dpp %0, %0, %0 row_mirror row_mask:0xf bank_mask:0xf bound_ctrl:1" : "+v"(d)); }

struct ScanVec { f32x4 w, nb, kp, r, kkn; f32x2 v; };
template <int TT> __device__ __forceinline__ ScanVec scan_load(const LAS unsigned char* lb, const LAS unsigned char* vb) {
    ScanVec x;
    x.w = *(const LAS f32x4*)(lb + SB_W + TT * 256); x.nb = *(const LAS f32x4*)(lb + SB_NB + TT * 256); x.kp = *(const LAS f32x4*)(lb + SB_KP + TT * 256);
    x.r = *(const LAS f32x4*)(lb + SB_R + TT * 256); x.kkn = *(const LAS f32x4*)(lb + SB_KK + (TT + 1) * 256); x.v = *(const LAS f32x2*)(vb + SB_V + TT * 256);
    return x;
}
template <int TT> __device__ __forceinline__ void scan_steps(float (&s)[2][4], float& sa0, float& sa1, const ScanVec cur, const LAS unsigned char* lb, const LAS unsigned char* vb, unsigned yaddr, unsigned long long ymask) {
    ScanVec nx = cur;
    if constexpr (TT + 1 < TC) nx = scan_load<TT + 1>(lb, vb);
    float t[2][4];
#pragma unroll
    for (int j = 0; j < 4; ++j) { a_mul(t[0][j], cur.v[0], cur.kp[j]); a_mul(t[1][j], cur.v[1], cur.kp[j]); }
#pragma unroll
    for (int j = 0; j < 4; ++j) { a_fmac(t[0][j], sa0, cur.nb[j]); a_fmac(t[1][j], sa1, cur.nb[j]); }
#pragma unroll
    for (int j = 0; j < 4; ++j) { a_fma(s[0][j], s[0][j], cur.w[j], t[0][j]); a_fma(s[1][j], s[1][j], cur.w[j], t[1][j]); }
    float y0, y1, n0, n1;
    a_mul(y0, s[0][0], cur.r[0]); a_mul(y1, s[1][0], cur.r[0]); a_mul(n0, s[0][0], cur.kkn[0]); a_mul(n1, s[1][0], cur.kkn[0]);
#pragma unroll
    for (int j = 1; j < 4; ++j) { a_fmac(y0, s[0][j], cur.r[j]); a_fmac(y1, s[1][j], cur.r[j]); a_fmac(n0, s[0][j], cur.kkn[j]); a_fmac(n1, s[1][j], cur.kkn[j]); }
    a_x1(y0); a_x1(y1); a_x1(n0); a_x1(n1);
    a_x2(y0); a_x2(y1); a_x2(n0); a_x2(n1);
    a_x4(y0); a_x4(y1); a_x4(n0); a_x4(n1);
    a_x8(y0); a_x8(y1); a_x8(n0); a_x8(n1);
    asm volatile("s_mov_b64 exec, %3\n\tds_write_b32 %0, %1 offset:%4\n\tds_write_b32 %0, %2 offset:%5\n\ts_mov_b64 exec, -1"
                 :: "v"(yaddr), "v"(y0), "v"(y1), "s"(ymask), "n"(SB_Y + TT * 256), "n"(SB_Y + TT * 256 + 4));
    sa0 = n0; sa1 = n1;
    if constexpr (TT + 1 < TC) scan_steps<TT + 1>(s, sa0, sa1, nx, lb, vb, yaddr, ymask);
}

__device__ __forceinline__ void p2_scan(Frame& F, const Args& a, size_t mo_off = WS_M) {
    const unsigned char* Zb = a.ws + WS_Z; bf16_t* Mo = (bf16_t*)(a.ws + mo_off);
    LAS unsigned char* L = F.lds + RING_OFF;
    LAS float* TML = (LAS float*)(F.lds + SB_TML);
    const int lane = F.lane, w = F.wave, tid = F.tid;
    const float* tmix = a.in[I_TMIX];
    for (int unit = F.bid; unit < NB_ * NH; unit += F.G) {
        const int b = unit / NH, h = unit % NH;
        const size_t trow0 = (size_t)b * SEQ;
        if (tid < 288) TML[tid] = tmix[TM_DL + tid];
        const int mb = w >> 2, nb = w & 3, fn = lane & 15, kg = lane >> 4;
        bf16x8 Bw[2], Ba[2], Bg[5];
        {   const bf16_t* lp = (const bf16_t*)(a.ws + WS_MISC + MO_LT) + (size_t)(h * HD + nb * 16 + fn) * 288 + 8 * kg;
#pragma unroll
            for (int sx = 0; sx < 2; ++sx) { Bw[sx] = *(const bf16x8*)(lp + 32 * sx); Ba[sx] = *(const bf16x8*)(lp + 64 + 32 * sx); }
#pragma unroll
            for (int sx = 0; sx < 5; ++sx) Bg[sx] = *(const bf16x8*)(lp + 128 + 32 * sx);
        }
        const int tl = tid >> 4, q = tid & 15, col4 = h * HD + 4 * q;
        const f32x4 tm_r = *(const f32x4*)(tmix + TM_R + col4), tm_k = *(const f32x4*)(tmix + TM_K + col4), tm_v = *(const f32x4*)(tmix + TM_V + col4);
        const f32x4 c_w0 = *(const f32x4*)(a.in[I_W0] + col4), c_a0 = *(const f32x4*)(a.in[I_A0] + col4), c_kk = *(const f32x4*)(a.in[I_KK] + col4), c_ka = *(const f32x4*)(a.in[I_KA] + col4);
        const f32x4 c_rk = *(const f32x4*)(a.in[I_RK] + col4), c_gw = *(const f32x4*)(a.in[I_GNW] + col4), c_gb = *(const f32x4*)(a.in[I_GNB] + col4);
        int pg[NPF], pl[NPF]; bool prow0[NPF];
#pragma unroll
        for (int k = 0; k < NPF; ++k) { const int pid = tid + 512 * k; int go = -1, lo = 0; bool r0 = false;
            if (pid < NP_L) { const int row = pid / 36, pc = pid % 36; go = row * (NZ * 2) + ZC_L * 2 + pc * 16; lo = SB_RAWL + row * RL_STRIDE + pc * 16; r0 = (row == 0); }
            else if (pid < NP_L + NP_RKV) { const int j = pid - NP_L, row = j / 24, pc = j % 24, arr = pc >> 3, c8 = pc & 7; go = row * (NZ * 2) + (arr * 1024 + h * HD) * 2 + c8 * 16; lo = SB_RAWRKV + row * 384 + arr * 128 + c8 * 16; r0 = (row == 0); }
            else if (pid < NP_ALL) { const int j = pid - NP_L - NP_RKV, row = j >> 3, c8 = j & 7; go = (row + 1) * (NZ * 2) + (ZC_GA + h * HD) * 2 + c8 * 16; lo = SB_RAWGA + row * 128 + c8 * 16; }
            pg[k] = go; pl[k] = lo; prow0[k] = r0; }
        u32x4 P[NPF];
#define P2_ISSUE(chn) do { const unsigned char* cb_ = Zb + ((long)trow0 + (long)(chn) * TC - 1) * (long)(NZ * 2); \
        _Pragma("unroll") for (int k = 0; k < NPF; ++k) { P[k] = (u32x4){0u, 0u, 0u, 0u}; if (pg[k] >= 0 && !((chn) == 0 && prow0[k])) P[k] = *(const u32x4*)(cb_ + pg[k]); } } while (0)
        const int jg = lane & 15, i0 = 8 * w + 2 * (lane >> 4);
        const LAS unsigned char* lb = L + 16 * jg; const LAS unsigned char* vb = L + 4 * i0;
        const unsigned yaddr = (unsigned)(size_t)(L + 4 * i0);
        const unsigned long long ymask = __ballot(jg == 0);
        float s[2][4];
#pragma unroll
        for (int j = 0; j < 4; ++j) { s[0][j] = 0.f; s[1][j] = 0.f; }
        P2_ISSUE(0);
        __syncthreads();
        for (int ch = -1; ch < SEQ / TC; ++ch) {
            const int t0 = ch * TC;
            if (ch >= 0) {
                {   const f32x4 kk0 = *(const LAS f32x4*)(lb + SB_KK);
                    float sa0 = (s[0][0] * kk0[0] + s[0][1] * kk0[1]) + (s[0][2] * kk0[2] + s[0][3] * kk0[3]);
                    float sa1 = (s[1][0] * kk0[0] + s[1][1] * kk0[1]) + (s[1][2] * kk0[2] + s[1][3] * kk0[3]);
                    sa0 = allsum16(sa0); sa1 = allsum16(sa1);
                    const ScanVec c0 = scan_load<0>(lb, vb);
                    scan_steps<0>(s, sa0, sa1, c0, lb, vb, yaddr, ymask);
                }
                LDS_WAIT();
                __syncthreads();
                {   const int t = t0 + tl; const int o = tl * 256 + 16 * q;
                    const f32x4 y = *(const LAS f32x4*)(L + SB_Y + o), rv = *(const LAS f32x4*)(L + SB_R + o), kpv = *(const LAS f32x4*)(L + SB_KP + o), vv = *(const LAS f32x4*)(L + SB_V + o), gv = *(const LAS f32x4*)(L + SB_G + o);
                    const float mean = allsum16((y[0] + y[1]) + (y[2] + y[3])) * (1.0f / 64.0f);
                    const f32x4 dv = y - mean;
                    const float var = allsum16((dv[0] * dv[0] + dv[1] * dv[1]) + (dv[2] * dv[2] + dv[3] * dv[3])) * (1.0f / 64.0f);
                    const float rstd = __builtin_amdgcn_rsqf(var + GN_EPS);
                    const float bonus = allsum16((rv[0] * kpv[0] * c_rk[0] + rv[1] * kpv[1] * c_rk[1]) + (rv[2] * kpv[2] * c_rk[2] + rv[3] * kpv[3] * c_rk[3]));
                    const f32x4 ga = lds_bf4(L + SB_RAWGA + tl * 128 + 8 * q);
                    f32x4 ov;
#pragma unroll
                    for (int j = 0; j < 4; ++j) ov[j] = ((dv[j] * rstd * c_gw[j] + c_gb[j]) + bonus * vv[j]) * gv[j] * ga[j];
                    *(u32x2*)(Mo + (trow0 + t) * D + col4) = (u32x2){cvt_pk_bf16(ov[0], ov[1]), cvt_pk_bf16(ov[2], ov[3])};
                }
                __syncthreads();
            }
            if (ch + 1 < SEQ / TC) {
#pragma unroll
                for (int k = 0; k < NPF; ++k) if (pg[k] >= 0) *(LAS u32x4*)(L + pl[k]) = P[k];
                if (ch + 2 < SEQ / TC) P2_ISSUE(ch + 2);
                __syncthreads();
#pragma unroll
                for (int k = 0; k < 3; ++k) { const int id = tid + 512 * k;
                    if (id < TC * 36) { const int p = id >> 5, r = id & 31;
                        float c[8], pv[8], m8[8];
                        un8(*(const LAS u32x4*)(L + SB_RAWL + (r + 1) * RL_STRIDE + p * 16), c); un8(*(const LAS u32x4*)(L + SB_RAWL + r * RL_STRIDE + p * 16), pv);
                        const f32x4 ta = *(const LAS f32x4*)(TML + 8 * p), tb = *(const LAS f32x4*)(TML + 8 * p + 4);
#pragma unroll
                        for (int j = 0; j < 8; ++j) { const float tmj = (j < 4) ? ta[j] : tb[j - 4]; m8[j] = c[j] + (pv[j] - c[j]) * tmj; }
                        if (p < 8) {
#pragma unroll
                            for (int j = 0; j < 8; ++j) m8[j] = 1.0f - 2.0f * __builtin_amdgcn_rcpf(1.0f + __expf(2.0f * m8[j])); }
                        else if (p >= 16) {
#pragma unroll
                            for (int j = 0; j < 8; ++j) m8[j] = sigmoidf_(m8[j]); }
                        *(LAS bf16x8*)(L + SB_AMAT + r * RL_STRIDE + p * 16) = pack8(m8); }
                }
                __syncthreads();
                {   f32x4 aw = (f32x4){0.f, 0.f, 0.f, 0.f}, aa = aw, ag = aw;
                    const LAS unsigned char* ap = L + SB_AMAT + (16 * mb + fn) * RL_STRIDE + kg * 16;
#pragma unroll
                    for (int sx = 0; sx < 9; ++sx) { const bf16x8 af = *(const LAS bf16x8*)(ap + sx * 64);
                        if (sx < 2) aw = __builtin_amdgcn_mfma_f32_16x16x32_bf16(Bw[sx], af, aw, 0, 0, 0);
                        else if (sx < 4) aa = __builtin_amdgcn_mfma_f32_16x16x32_bf16(Ba[sx - 2], af, aa, 0, 0, 0);
                        else ag = __builtin_amdgcn_mfma_f32_16x16x32_bf16(Bg[sx - 4], af, ag, 0, 0, 0); }
                    const int o = (16 * mb + fn) * 256 + (nb * 16 + 4 * kg) * 4;
                    *(LAS f32x4*)(L + SB_W + o) = aw; *(LAS f32x4*)(L + SB_ARAW + o) = aa; *(LAS f32x4*)(L + SB_G + o) = ag;
                }
                __syncthreads();
                {   const LAS unsigned char* rc = L + SB_RAWRKV + (tl + 1) * 384 + 8 * q; const LAS unsigned char* rp_ = rc - 384;
                    f32x4 r = lds_bf4(rc), k = lds_bf4(rc + 128), v = lds_bf4(rc + 256);
                    const f32x4 rp = lds_bf4(rp_), kp_ = lds_bf4(rp_ + 128), vp = lds_bf4(rp_ + 256);
                    r = r + (rp - r) * tm_r; k = k + (kp_ - k) * tm_k; v = v + (vp - v) * tm_v;
                    const int o = tl * 256 + 16 * q;
                    const f32x4 wraw = *(const LAS f32x4*)(L + SB_W + o) + c_w0, araw = *(const LAS f32x4*)(L + SB_ARAW + o) + c_a0;
                    f32x4 dec, av, kk, kpv, nbv; float ss = 0.f;
#pragma unroll
                    for (int j = 0; j < 4; ++j) {
                        const float xw = -wraw[j]; const float sp = fmaxf(xw, 0.f) + __logf(1.0f + __expf(-fabsf(xw)));
                        const float wlog = -sp - 0.5f; dec[j] = __expf(-__expf(wlog));
                        av[j] = sigmoidf_(araw[j]);
                        kk[j] = k[j] * c_kk[j]; ss += kk[j] * kk[j];
                        kpv[j] = k[j] * (1.0f + (av[j] - 1.0f) * c_ka[j]);
                    }
                    ss = allsum16(ss);
                    const float inv = __builtin_amdgcn_rcpf(fmaxf(__builtin_amdgcn_sqrtf(ss), 1e-12f));
#pragma unroll
                    for (int j = 0; j < 4; ++j) { kk[j] *= inv; nbv[j] = -kk[j] * av[j]; }
                    *(LAS f32x4*)(L + SB_KK + o) = kk; *(LAS f32x4*)(L + SB_W + o) = dec; *(LAS f32x4*)(L + SB_NB + o) = nbv;
                    *(LAS f32x4*)(L + SB_KP + o) = kpv; *(LAS f32x4*)(L + SB_R + o) = r; *(LAS f32x4*)(L + SB_V + o) = v;
                }
                __syncthreads();
            }
        }
#undef P2_ISSUE
    }
}

constexpr int VT_STRIDE = 272;
__device__ __forceinline__ void p3_gmlp(Frame& F, const Args& a) {
    const bf16_t* Z = (const bf16_t*)(a.ws + WS_Z); const bf16_t* Mo = (const bf16_t*)(a.ws + WS_M); bf16_t* M2 = (bf16_t*)(a.ws + WS_M2);
    LAS unsigned char* VT = F.lds + RING_OFF;
    LAS f32x2* ST = (LAS f32x2*)(F.lds + RING_OFF + 128 * VT_STRIDE);
    const int lane = F.lane, w = F.wave, tid = F.tid;
    const float* lng = a.in[I_LNVG]; const float* lnb = a.in[I_LNVB]; const float* wsp = a.in[I_WSP]; const float* bsp = a.in[I_BSP];
    for (int unit = F.bid; unit < NB_ * (SEQ / 128); unit += F.G) {
        const size_t t0 = (size_t)unit * 128;
        for (int rr = 0; rr < 16; ++rr) { const int j = 16 * w + rr;
            const bf16_t* p = Z + (t0 + j) * NZ + ZC_VG + 16 * lane; float c0[8], c1[8]; ld_bf8(p, c0); ld_bf8(p + 8, c1);
            float s = 0.f, s2 = 0.f;
#pragma unroll
            for (int i = 0; i < 8; ++i) { s += c0[i] + c1[i]; s2 += c0[i] * c0[i] + c1[i] * c1[i]; }
            s = wave_sum(s); s2 = wave_sum(s2);
            const float mean = s * (1.0f / 1024.0f), var = fmaxf(s2 * (1.0f / 1024.0f) - mean * mean, 0.f);
            if (lane == 0) ST[j] = (f32x2){mean, __builtin_amdgcn_rsqf(var + LN_EPS)};
        }
        __syncthreads();
        for (int g = 0; g < 8; ++g) {
            {   const int j = tid & 127; const f32x2 st = ST[j];
#pragma unroll
                for (int it = 0; it < 4; ++it) { const int dch = (tid >> 7) + 4 * it;
                    float c[8]; ld_bf8(Z + (t0 + j) * NZ + ZC_VG + g * 128 + dch * 8, c);
                    const f32x4 g0 = *(const f32x4*)(lng + g * 128 + dch * 8), g1 = *(const f32x4*)(lng + g * 128 + dch * 8 + 4);
                    const f32x4 b0 = *(const f32x4*)(lnb + g * 128 + dch * 8), b1 = *(const f32x4*)(lnb + g * 128 + dch * 8 + 4);
#pragma unroll
                    for (int i = 0; i < 8; ++i) { const float gg = (i < 4) ? g0[i] : g1[i - 4], bb = (i < 4) ? b0[i] : b1[i - 4];
                        const float vn = (c[i] - st.x) * st.y * gg + bb;
                        *(LAS bf16_t*)(VT + (dch * 8 + i) * VT_STRIDE + j * 2) = (bf16_t)(cvt_pk_bf16(vn, 0.f) & 0xffffu); }
                }
            }
            __syncthreads();
            {   const int fi = lane & 15, kg = lane >> 4, i = 16 * w + fi;
                f32x4 acc[8];
#pragma unroll
                for (int n = 0; n < 8; ++n) acc[n] = (f32x4){0.f, 0.f, 0.f, 0.f};
                const float* wrow = wsp + ((size_t)g * 128 + i) * 128;
#pragma unroll
                for (int s = 0; s < 4; ++s) {
                    if (32 * s <= 16 * w + 15) {
                        const int jb = 32 * s + 8 * kg;
                        const f32x4 w0 = *(const f32x4*)(wrow + jb), w1 = *(const f32x4*)(wrow + jb + 4);
                        float m8[8];
#pragma unroll
                        for (int jj = 0; jj < 8; ++jj) { const float v = (jj < 4) ? w0[jj] : w1[jj - 4]; m8[jj] = (jb + jj <= i) ? v : 0.f; }
                        const bf16x8 wf = pack8(m8);
#pragma unroll
                        for (int n = 0; n < 8; ++n) { const bf16x8 vf = *(const LAS bf16x8*)(VT + (16 * n + fi) * VT_STRIDE + jb * 2);
                            acc[n] = __builtin_amdgcn_mfma_f32_16x16x32_bf16(vf, wf, acc[n], 0, 0, 0); }
                    }
                }
                const float bs = bsp[g * 128 + i];
                const size_t trow = t0 + i;
#pragma unroll
                for (int n = 0; n < 8; ++n) { const int dcol = g * 128 + 16 * n + 4 * kg;
                    const f32x4 uu = ld_bf4(Z + trow * NZ + ZC_U + dcol), gb = ld_bf4(Z + trow * NZ + ZC_GB + dcol), mm = ld_bf4(Mo + trow * D + dcol);
                    f32x4 o;
#pragma unroll
                    for (int r = 0; r < 4; ++r) o[r] = mm[r] + uu[r] * (acc[n][r] + bs) * gb[r];
                    *(u32x2*)(M2 + trow * D + dcol) = (u32x2){cvt_pk_bf16(o[0], o[1]), cvt_pk_bf16(o[2], o[3])}; }
            }
            __syncthreads();
        }
    }
}

__device__ __forceinline__ void p5_router(Frame& F, const Args& a) {
    const float* X2 = a.out; bf16_t* Hh = (bf16_t*)(a.ws + WS_H2);
    const bf16_t* Wh = (const bf16_t*)(a.ws + WS_MISC + MO_WRT); const bf16_t* Wl = Wh + NE * D;
    int* tok_of = (int*)(a.ws + WS_TOK); int* asg = (int*)(a.ws + WS_MISC + MO_ASG); float* gate = (float*)(a.ws + WS_MISC + MO_GATE);
    const float* g2 = a.in[I_N2G]; const float* br = a.in[I_BR];
    LAS float* LG = (LAS float*)(F.lds + RING_OFF) + F.wave * 512;
    LAS unsigned* LCNT = (LAS unsigned*)(F.lds + RING_OFF + 32768);
    LAS unsigned* LBASE = LCNT + 32;
    const int lane = F.lane, w = F.wave, tid = F.tid, fm = lane & 15, kg = lane >> 4;
    for (int blk = F.bid; blk < T / 128; blk += F.G) {
        if (tid < 32) LCNT[tid] = 0u;
        __syncthreads();
        const int tb = blk * 128 + 16 * w;
        const float* xr = X2 + (size_t)(tb + fm) * D + 8 * kg;
        float ss = 0.f;
        for (int s = 0; s < 32; ++s) { const f32x4 x0 = *(const f32x4*)(xr + 32 * s), x1 = *(const f32x4*)(xr + 32 * s + 4);
            ss += (x0.x * x0.x + x0.y * x0.y) + (x0.z * x0.z + x0.w * x0.w) + (x1.x * x1.x + x1.y * x1.y) + (x1.z * x1.z + x1.w * x1.w); }
        ss += __shfl_xor(ss, 16); ss += __shfl_xor(ss, 32);
        const float rstd = __builtin_amdgcn_rsqf(ss * (1.0f / D) + RMS_EPS);
        f32x4 acc[2]; acc[0] = (f32x4){0.f, 0.f, 0.f, 0.f}; acc[1] = acc[0];
        bf16_t* hrow = Hh + (size_t)(tb + fm) * D + 8 * kg;
        for (int s = 0; s < 32; ++s) {
            const f32x4 x0 = *(const f32x4*)(xr + 32 * s), x1 = *(const f32x4*)(xr + 32 * s + 4);
            const f32x4 ga = *(const f32x4*)(g2 + 32 * s + 8 * kg), gb = *(const f32x4*)(g2 + 32 * s + 8 * kg + 4);
            float hv[8], lo[8];
#pragma unroll
            for (int j = 0; j < 4; ++j) { hv[j] = x0[j] * rstd * ga[j]; hv[4 + j] = x1[j] * rstd * gb[j]; }
            u32x4 hp; hp.x = cvt_pk_bf16(hv[0], hv[1]); hp.y = cvt_pk_bf16(hv[2], hv[3]); hp.z = cvt_pk_bf16(hv[4], hv[5]); hp.w = cvt_pk_bf16(hv[6], hv[7]);
            *(u32x4*)(hrow + 32 * s) = hp;
            lo[0] = hv[0] - bf_lo(hp.x); lo[1] = hv[1] - bf_hi(hp.x); lo[2] = hv[2] - bf_lo(hp.y); lo[3] = hv[3] - bf_hi(hp.y);
            lo[4] = hv[4] - bf_lo(hp.z); lo[5] = hv[5] - bf_hi(hp.z); lo[6] = hv[6] - bf_lo(hp.w); lo[7] = hv[7] - bf_hi(hp.w);
            const bf16x8 ah = __builtin_bit_cast(bf16x8, hp), al = pack8(lo);
#pragma unroll
            for (int n = 0; n < 2; ++n) { const size_t wo = (size_t)(16 * n + fm) * D + 32 * s + 8 * kg;
                const bf16x8 bh = *(const bf16x8*)(Wh + wo), bl = *(const bf16x8*)(Wl + wo);
                acc[n] = __builtin_amdgcn_mfma_f32_16x16x32_bf16(bh, ah, acc[n], 0, 0, 0);
                acc[n] = __builtin_amdgcn_mfma_f32_16x16x32_bf16(bh, al, acc[n], 0, 0, 0);
                acc[n] = __builtin_amdgcn_mfma_f32_16x16x32_bf16(bl, ah, acc[n], 0, 0, 0); }
        }
#pragma unroll
        for (int n = 0; n < 2; ++n) { const f32x4 bb = *(const f32x4*)(br + 16 * n + 4 * kg); *(LAS f32x4*)(LG + fm * 32 + 16 * n + 4 * kg) = acc[n] + bb; }
        LDS_WAIT(); asm volatile("" ::: "memory");
        int se[4] = {0, 0, 0, 0}; unsigned sr[4] = {0u, 0u, 0u, 0u}; float sg[4] = {0.f, 0.f, 0.f, 0.f};
        if (lane < 16) {
            float lv[32];
#pragma unroll
            for (int e4 = 0; e4 < 8; ++e4) { const f32x4 v = *(LAS f32x4*)(LG + lane * 32 + 4 * e4); lv[4 * e4] = v.x; lv[4 * e4 + 1] = v.y; lv[4 * e4 + 2] = v.z; lv[4 * e4 + 3] = v.w; }
            float tv[4];
#pragma unroll
            for (int k = 0; k < 4; ++k) { float best = -3.0e38f; int bi = 0;
#pragma unroll
                for (int e = 0; e < 32; ++e) { const bool taken = (k > 0 && se[0] == e) || (k > 1 && se[1] == e) || (k > 2 && se[2] == e); if (!taken && lv[e] > best) { best = lv[e]; bi = e; } }
                se[k] = bi; tv[k] = best; }
            const float e1 = __expf(tv[1] - tv[0]), e2 = __expf(tv[2] - tv[0]), e3 = __expf(tv[3] - tv[0]); const float inv = 1.0f / (1.0f + e1 + e2 + e3);
            sg[0] = inv; sg[1] = e1 * inv; sg[2] = e2 * inv; sg[3] = e3 * inv;
#pragma unroll
            for (int k = 0; k < 4; ++k) sr[k] = atomicAdd((unsigned*)(LCNT + se[k]), 1u);
        }
        __syncthreads();
        if (tid < 32) LBASE[tid] = atomicAdd(F.ctl + CW_CNT + 64 * tid, (unsigned)LCNT[tid]);
        __syncthreads();
        if (lane < 16) { const int tok = tb + lane;
#pragma unroll
            for (int k = 0; k < 4; ++k) { const int pos = (int)(LBASE[se[k]] + sr[k]);
                tok_of[(size_t)se[k] * T + pos] = tok; asg[(size_t)tok * 8 + 2 * k] = se[k]; asg[(size_t)tok * 8 + 2 * k + 1] = pos; gate[(size_t)tok * 4 + k] = sg[k]; }
        }
        __syncthreads();
    }
}

__device__ __forceinline__ void moe_tables(Frame& F) {
    LAS int* cnt = (LAS int*)(F.lds + SCHED_OFF); LAS int* mts = cnt + 32;
    if (F.tid == 0) { int acc = 0;
        for (int e = 0; e < NE; ++e) { const int c = (int)__hip_atomic_load(F.ctl + CW_CNT + 64 * e, RLX_AGENT); cnt[e] = c; mts[e] = acc; acc += (c + 255) >> 8; }
        mts[NE] = acc; }
    __syncthreads();
}
template <int NTN, bool GATH>
struct MoeOrder {
    static constexpr bool GATHER = GATH;
    LAS const int* cnt; LAS const int* mts; const char* A; const char* B; const int* tok_of; int G, c, Mtiles;
    __device__ void init(Frame& F, const void* A_, const void* B_, const int* tok) { cnt = (LAS const int*)(F.lds + SCHED_OFF); mts = cnt + 32; A = (const char*)A_; B = (const char*)B_; tok_of = tok; G = F.G; c = F.bid; Mtiles = mts[NE]; }
    __device__ bool next(int i, pg8::Unit& u) const {
        constexpr int MPS = 32 / NTN;
        int mt, nt_;
        if ((G & 7) == 0) { const int s = i * 8 + (c & 7), j = (c >> 3) + 0; const int per = G >> 3;
            if (per == 32) { mt = s * MPS + (j % MPS); nt_ = j / MPS; }
            else { const int L = i * G + c; mt = L / NTN; nt_ = L % NTN; } }
        else { const int L = i * G + c; mt = L / NTN; nt_ = L % NTN; }
        if (mt >= Mtiles) return false;
        int e = 0;
        for (int k = 1; k < NE; ++k) e += (mts[k] <= mt) ? 1 : 0;
        const int mloc = mt - mts[e];
        u.e = e; u.r0 = mt * 256; u.c0 = nt_ * 256; u.aux = mloc;
        u.B = B + ((size_t)e * NTN + nt_) * (256 * pg8::KK * 2);
        u.A = GATH ? A : A + (size_t)mt * (256 * pg8::KK * 2);
        return true;
    }
    __device__ __forceinline__ void a_offs(const pg8::Unit& u, unsigned (&ga)[2][2], const int (&R)[2], const int (&C)[2]) const {
        if constexpr (GATH) {
            const int n = cnt[u.e]; const int* tp = tok_of + (size_t)u.e * T + u.aux * 256;
            int tk[2][2];
#pragma unroll
            for (int h = 0; h < 2; ++h)
#pragma unroll
                for (int i = 0; i < 2; ++i) { const int rr = h * 128 + R[i]; tk[h][i] = (u.aux * 256 + rr < n) ? tp[rr] : 0; }
            VM_WAIT();
#pragma unroll
            for (int h = 0; h < 2; ++h)
#pragma unroll
                for (int i = 0; i < 2; ++i) ga[h][i] = (unsigned)(tk[h][i] * pg8::KK + C[i]) * 2u;
        } else {
#pragma unroll
            for (int h = 0; h < 2; ++h)
#pragma unroll
                for (int i = 0; i < 2; ++i) ga[h][i] = (unsigned)((h * 128 + R[i]) * pg8::KK + C[i]) * 2u;
        }
    }
};

__device__ __forceinline__ void p8_final(Frame& F, const Args& a) {
    LAS const int* mts = (LAS const int*)(F.lds + SCHED_OFF) + 32;
    const bf16_t* YS = (const bf16_t*)(a.ws + WS_YS); const int* asg = (const int*)(a.ws + WS_MISC + MO_ASG); const float* gate = (const float*)(a.ws + WS_MISC + MO_GATE);
    float* out = a.out; const float* gf = a.in[I_NFG];
    const int gw = F.bid * NWAVES + F.wave, NGW = F.G * NWAVES;
    f32x4 gv[4];
#pragma unroll
    for (int j = 0; j < 4; ++j) gv[j] = *((const f32x4*)gf + F.lane + 64 * j);
    for (int m = gw; m < T; m += NGW) {
        f32x4* xr = (f32x4*)(out + (size_t)m * D) + F.lane;
        f32x4 v[4];
#pragma unroll
        for (int j = 0; j < 4; ++j) v[j] = xr[64 * j];
#pragma unroll
        for (int k = 0; k < 4; ++k) { const int e = asg[(size_t)m * 8 + 2 * k], pos = asg[(size_t)m * 8 + 2 * k + 1]; const float gk = gate[(size_t)m * 4 + k];
            const bf16_t* yr = YS + ((size_t)mts[e] * 256 + pos) * D + 4 * F.lane;
#pragma unroll
            for (int j = 0; j < 4; ++j) v[j] += gk * ld_bf4(yr + 256 * j); }
        float s = 0.f;
#pragma unroll
        for (int j = 0; j < 4; ++j) s += (v[j].x * v[j].x + v[j].y * v[j].y) + (v[j].z * v[j].z + v[j].w * v[j].w);
        const float rstd = __builtin_amdgcn_rsqf(wave_sum(s) * (1.f / D) + RMS_EPS);
#pragma unroll
        for (int j = 0; j < 4; ++j) xr[64 * j] = v[j] * rstd * gv[j];
    }
}

constexpr int N_PHASES = 9;
__global__ void __launch_bounds__(NWAVES * 64, 2) mk_fwd(Args args) {
    extern __shared__ __attribute__((aligned(16))) unsigned char lds[];
    Frame F;
    F.lds = (LAS unsigned char*)lds;
    F.MISC = (volatile LAS unsigned*)(F.lds + MISC_OFF);
    F.tid = threadIdx.x; F.lane = F.tid & 63; F.wave = __builtin_amdgcn_readfirstlane(F.tid >> 6);
    F.G = gridDim.x; F.bid = blockIdx.x;
    F.ctl = (unsigned*)(args.ws + WS_CTL);
    for (int u = F.tid; u < (LDS_BYTES - LDSCTL_OFF) / 4; u += NWAVES * 64) ((LAS unsigned*)(F.lds + LDSCTL_OFF))[u] = 0u;
    __syncthreads();
    const int lo = args.ph_lo, hi = args.ph_hi;
    const bool multi = (hi - lo) > 1;
    XcdBarrier bar; bar.bar = F.ctl + CW_BAR; bar.x = 0; bar.st = nullptr;
    if (multi) bar = xcd_barrier_post(F.ctl + CW_BAR, F.MISC + 8);
#define IN(k) (lo <= (k) && (k) < hi)
#define SEAM(k) do { if (IN(k) && IN((k) + 1)) xcd_barrier(bar); } while (0)
    unsigned char* ws = args.ws;

#define P1_BODY {     \
        pg8::StaticOrder S; S.init(ws + WS_H, ws + WS_BIN, T, NZ, F.G, F.bid); \
        pg8::EpiZ E{(bf16_t*)(ws + WS_Z), (const float*)(ws + WS_MISC + MO_BIASZ)}; \
        pg8::gemm_phase<pg8::EpiZ, pg8::StaticOrder, true>(F.lds + RING_OFF, S, E); }
#define P4_BODY {     \
        pg8::StaticOrder S; S.init(ws + WS_M2, ws + WS_BOUT, T, D, F.G, F.bid); \
        pg8::EpiRes E{args.out, args.in[I_X]}; \
        pg8::gemm_phase<pg8::EpiRes, pg8::StaticOrder, true>(F.lds + RING_OFF, S, E); }
#define P6_BODY {     \
        moe_tables(F); \
        MoeOrder<8, true> S; S.init(F, ws + WS_H2, ws + WS_BGU, (const int*)(ws + WS_TOK)); \
        pg8::EpiSwiglu E{(bf16_t*)(ws + WS_ACT), (const float*)(ws + WS_MISC + MO_BGU)}; \
        pg8::gemm_phase<pg8::EpiSwiglu, MoeOrder<8, true>, true>(F.lds + RING_OFF, S, E); }
#define P7_BODY {     \
        moe_tables(F); \
        MoeOrder<4, false> S; S.init(F, ws + WS_ACT, ws + WS_BD, nullptr); \
        pg8::EpiDown E{(bf16_t*)(ws + WS_YS), args.in[I_BDN]}; \
        pg8::gemm_phase<pg8::EpiDown, MoeOrder<4, false>, true>(F.lds + RING_OFF, S, E); }
    if (IN(0)) { p0_prologue(F, args); if (PROBE_REP == 0) p0_prologue(F, args); SEAM(0); }
    if (IN(1)) { P1_BODY if (PROBE_REP == 1) P1_BODY SEAM(1); }
    if (IN(2)) { p2_scan(F, args); if (PROBE_REP == 2) p2_scan(F, args); SEAM(2); }
    if (IN(3)) { p3_gmlp(F, args); SEAM(3); }
    if (PROBE_REP == 23) { p2_scan(F, args); xcd_barrier(bar); p3_gmlp(F, args); xcd_barrier(bar); }
    if (IN(4)) { P4_BODY if (PROBE_REP == 4) P4_BODY SEAM(4); }
    if (IN(5)) { p5_router(F, args); SEAM(5); }
    if (IN(6)) { P6_BODY if (PROBE_REP == 6) P6_BODY SEAM(6); }
    if (IN(7)) { P7_BODY if (PROBE_REP == 7) P7_BODY SEAM(7); }
    if (IN(8)) { moe_tables(F); p8_final(F, args); }
#undef IN
#undef SEAM
}

extern "C" void kernel_launch(void* const* d_in, const int* in_sizes, int n_in, void* d_out, int out_size, void* d_ws, size_t ws_size, hipStream_t stream) {
    static int grid = 0;
    if (grid == 0) {
        if (n_in != 28 || out_size != T * D || ws_size < WS_END) { fprintf(stderr, "kernel_launch: unexpected problem (n_in %d, out %d, ws %zu); nothing launched\n", n_in, out_size, ws_size); grid = -1; return; }
        int dev = 0, cus = 0, per_cu = 0;
        if (hipGetDevice(&dev) != hipSuccess || hipDeviceGetAttribute(&cus, hipDeviceAttributeMultiprocessorCount, dev) != hipSuccess) { grid = -1; return; }
        if (hipFuncSetAttribute((const void*)mk_fwd, hipFuncAttributeMaxDynamicSharedMemorySize, LDS_BYTES) != hipSuccess) { fprintf(stderr, "kernel_launch: hipFuncSetAttribute failed\n"); grid = -1; return; }
        if (hipOccupancyMaxActiveBlocksPerMultiprocessor(&per_cu, (const void*)mk_fwd, NWAVES * 64, LDS_BYTES) != hipSuccess || per_cu < 1)
            fprintf(stderr, "kernel_launch: note: occupancy query reports %d workgroups per CU\n", per_cu);
        (void)hipGetLastError();
        grid = cus;
    }
    if (grid < 0) return;
    if (hipMemsetAsync((char*)d_ws + WS_CTL, 0, CTL_ZERO_BYTES, stream) != hipSuccess) return;
    Args a{};
    for (int i = 0; i < 28; ++i) a.in[i] = (const float*)d_in[i];
    a.out = (float*)d_out; a.ws = (unsigned char*)d_ws;
    if (MK_N_LAUNCHES == 1) { a.ph_lo = 0; a.ph_hi = N_PHASES; hipLaunchKernelGGL(mk_fwd, dim3(grid), dim3(NWAVES * 64), LDS_BYTES, stream, a); }
    else for (int p = 0; p < N_PHASES; ++p) { a.ph_lo = p; a.ph_hi = p + 1; hipLaunchKernelGGL(mk_fwd, dim3(grid), dim3(NWAVES * 64), LDS_BYTES, stream, a); }
}
```

```cpp
#include <hip/hip_runtime.h>
#include <cstdio>
#include <cstdint>

#ifndef MK_N_LAUNCHES
#define MK_N_LAUNCHES 1
#endif

#ifndef P1_WGM
#define P1_WGM 4
#endif
#ifndef SCAN_PREFETCH
#define SCAN_PREFETCH 0
#endif
#ifndef PROBE_REP
#define PROBE_REP -1
#endif
#define GAS __attribute__((address_space(1)))
#define LAS __attribute__((address_space(3)))
typedef unsigned short bf16_t;
typedef short bf16x8 __attribute__((ext_vector_type(8)));
typedef float f32x4 __attribute__((ext_vector_type(4)));
typedef float f32x2 __attribute__((ext_vector_type(2)));
typedef unsigned u32x4 __attribute__((ext_vector_type(4)));
typedef unsigned u32x2 __attribute__((ext_vector_type(2)));

constexpr int NB_ = 16, SEQ = 2048, D = 1024, T = NB_ * SEQ;
constexpr int NH = 16, HD = 64;
constexpr int NZ = 7680;
constexpr int ZC_R = 0, ZC_K = 1024, ZC_V = 2048, ZC_L = 3072, ZC_U = 3584, ZC_VG = 4608, ZC_GA = 5632, ZC_GB = 6656;
constexpr int NZ2 = 3584, Z2_L = 0, Z2_U = 512, Z2_VG = 1536, Z2_GB = 2560;
constexpr int TM_R = 0, TM_K = 1024, TM_V = 2048, TM_DL = 3072, TM_AL = 3136, TM_GL = 3200;
constexpr int NE = 32, TOPK = 4, FF = 1024;
constexpr int NSLOT_MAX = T * TOPK + NE * 256;
constexpr float RMS_EPS = 1e-5f, GN_EPS = 64e-5f, LN_EPS = 1e-5f;

constexpr size_t MiB = 1u << 20;
constexpr size_t WS_CTL = 0, CTL_ZERO_BYTES = 1 * MiB;
constexpr size_t WS_BIN = 2 * MiB;
constexpr size_t WS_BOUT = 18 * MiB;
constexpr size_t WS_BGU = 20 * MiB;
constexpr size_t WS_BD = 148 * MiB;
constexpr size_t WS_MISC = 212 * MiB;
constexpr size_t WS_TOK = 216 * MiB;
constexpr size_t WS_H = 220 * MiB;
constexpr size_t WS_HM = 284 * MiB;
constexpr size_t WS_Z = 540 * MiB;
constexpr size_t WS_M = 764 * MiB;
constexpr size_t WS_M2 = 828 * MiB;
constexpr size_t WS_H2 = 892 * MiB;
constexpr size_t WS_AL = 956 * MiB;
constexpr size_t WS_END = 976 * MiB;
constexpr size_t WS_ACT = WS_HM;
constexpr size_t WS_YS = WS_HM + 272 * MiB;
static_assert((size_t)NSLOT_MAX * FF * 2 == 272 * MiB && WS_YS + 272 * MiB == WS_M2, "ws map");
constexpr size_t MO_BIASZ = 0;
constexpr size_t MO_BGU = 64 * 1024;
constexpr size_t MO_WRT = 512 * 1024;
constexpr size_t MO_ASG = 1 * MiB;
constexpr size_t MO_GATE = 2 * MiB;
constexpr size_t MO_LT = 3 * MiB;
constexpr int CW_TMO = 0, CW_CODE = 1;
constexpr int CW_BAR = 4096;
constexpr int CW_CNT = 8192;

constexpr int RING_OFF = 0, RING_BYTES = 131072;
constexpr int LDSCTL_OFF = 159232, MISC_OFF = LDSCTL_OFF + 320;
constexpr int SCHED_OFF = LDSCTL_OFF + 1024;
constexpr int LDS_BYTES = 163840;
constexpr int EPI_T_OFF = RING_OFF + RING_BYTES, EPI_T_WAVE = 2304;
static_assert(EPI_T_OFF + 8 * EPI_T_WAVE <= LDSCTL_OFF, "LDS");
constexpr int NWAVES = 8;

#define RLX_AGENT __ATOMIC_RELAXED, __HIP_MEMORY_SCOPE_AGENT
#define LDS_WAIT() asm volatile("s_waitcnt lgkmcnt(0)" ::: "memory")
#define VM_WAIT() asm volatile("s_waitcnt vmcnt(0)" ::: "memory")
typedef __bf16 bf16x2_t __attribute__((ext_vector_type(2)));
typedef short s16x4 __attribute__((ext_vector_type(4)));
__device__ __forceinline__ unsigned cvt_pk_bf16(float lo, float hi) { bf16x2_t v; v.x = (__bf16)lo; v.y = (__bf16)hi; return __builtin_bit_cast(unsigned, v); }
__device__ __forceinline__ float bf_lo(unsigned u) { return __builtin_bit_cast(float, u << 16); }
__device__ __forceinline__ float bf_hi(unsigned u) { return __builtin_bit_cast(float, u & 0xffff0000u); }
__device__ __forceinline__ float bf2f(bf16_t b) { return __builtin_bit_cast(float, ((unsigned)b) << 16); }
template <int CTRL> __device__ __forceinline__ float dpp(float x) { return __builtin_bit_cast(float, __builtin_amdgcn_mov_dpp(__builtin_bit_cast(int, x), CTRL, 0xf, 0xf, true)); }
__device__ __forceinline__ float allsum16(float x) {
    x += dpp<0xB1>(x); x += dpp<0x4E>(x); x += dpp<0x141>(x); x += dpp<0x140>(x); return x;
}
__device__ __forceinline__ float wave_sum(float v) {
#pragma unroll
    for (int o = 1; o < 64; o <<= 1) v += __shfl_xor(v, o);
    return v;
}
__device__ __forceinline__ float sigmoidf_(float x) { return __builtin_amdgcn_rcpf(1.0f + __expf(-x)); }
__device__ __forceinline__ f32x2 gelu_pk(f32x2 v) {
    const f32x2 av = __builtin_elementwise_abs(v), d = av * 0.2316418882f + 1.0f;
    f32x2 t; t.x = __builtin_amdgcn_rcpf(d.x); t.y = __builtin_amdgcn_rcpf(d.y);
    f32x2 q = t * 0.5307027145f + (-0.7265760135f); q = q * t + 0.7107068705f; q = q * t + (-0.142248368f); q = q * t + 0.127414796f; q = q * t;
    const f32x2 s = (v * v) * (-0.72134752044f);
    f32x2 e; e.x = __builtin_amdgcn_exp2f(s.x); e.y = __builtin_amdgcn_exp2f(s.y);
    const f32x2 m = v * (q * e), r = v - m;
    f32x2 o; o.x = v.x < 0.f ? m.x : r.x; o.y = v.y < 0.f ? m.y : r.y; return o;
}

namespace pg8 {
constexpr int BM = 256, BK = 64, HALF = 128, HTB = HALF * BK * 2, STAGE_BYTES = 8 * HTB, NXCD = 8, WGM = 8;
constexpr int KK = 1024;
__host__ __device__ __forceinline__ int lds_byte(int r, int c) { const int st = (r >> 4) * 2 + (c >> 5), rr = r & 15, cc = c & 31, ob = rr * 64 + cc * 2; return st * 1024 + (ob ^ (((ob >> 9) & 1) << 5)); }
__host__ __device__ __forceinline__ void stage_rc(int b, int& R, int& C) { const int st = b / 1024, sb = b % 1024, swz = sb ^ (((sb >> 9) & 1) << 5); R = (st >> 1) * 16 + swz / 64; C = (st & 1) * 32 + (swz % 64) / 2; }
__host__ __device__ __forceinline__ int perm32(int rho) { const int n = rho >> 4, i = rho & 15; return 8 * (i >> 2) + 4 * n + (i & 3); }

struct Unit { const char* A; const char* B; int r0, c0, e, aux; };

struct StaticOrder {
    const char* A; const char* B; int nM, nN, nwg, G, c, wgm = WGM;
    static constexpr bool GATHER = false;
    __device__ void init(const void* A_, const void* B_, int M, int N, int G_, int c_) { A = (const char*)A_; B = (const char*)B_; nM = M / BM; nN = N / BM; nwg = nM * nN; G = G_; c = c_; }
    __device__ bool next(int i, Unit& u) const {
        const long L = (long)i * G + c; if (L >= nwg) return false;
        int wgid = (int)L; { const int q = nwg / NXCD, r = nwg % NXCD, xcd = wgid % NXCD, off = wgid / NXCD; wgid = (xcd < r ? xcd * (q + 1) : r * (q + 1) + (xcd - r) * q) + off; }
        const int nig = wgm * nN, gid = wgid / nig, fm = gid * wgm, gsz = (nM - fm) < wgm ? (nM - fm) : wgm;
        const int pm = fm + ((wgid % nig) % gsz), pn = (wgid % nig) / gsz;
        u.A = A + (size_t)pm * (BM * KK * 2); u.B = B + (size_t)pn * (BM * KK * 2); u.r0 = pm * BM; u.c0 = pn * BM; u.e = 0; u.aux = 0; return true;
    }
    __device__ __forceinline__ void a_offs(const Unit&, unsigned (&ga)[2][2], const int (&R)[2], const int (&C)[2]) const {
#pragma unroll
        for (int h = 0; h < 2; ++h)
#pragma unroll
            for (int i = 0; i < 2; ++i) ga[h][i] = (unsigned)((h * HALF + R[i]) * KK + C[i]) * 2u;
    }
};

template <class Epi, class Sched, bool ALIGN_EPI = false>
__device__ __forceinline__ void gemm_phase(LAS unsigned char* lds, const Sched& S, const Epi& E) {
    const int tid = threadIdx.x, wid = __builtin_amdgcn_readfirstlane(tid >> 6), lane = tid & 63, wr = wid >> 2, wc = wid & 3, fr = lane & 15, fq = lane >> 4;
    constexpr int K = KK, nt = K / BK;
    unsigned voffB[2]; int Rr[2], Cc[2];
#pragma unroll
    for (int i = 0; i < 2; ++i) { int R, C; stage_rc(tid * 16 + i * 8192, R, C); const int Rb = Epi::PERM == 2 ? (64 * (R >> 5) + perm32(R & 31)) : (Epi::PERM == 1 ? ((R & ~31) + perm32(R & 31)) : R);
        Rr[i] = R; Cc[i] = C; voffB[i] = (unsigned)(Rb * K + C) * 2u; }
    const size_t kstep = (size_t)(BK * 2);
    const size_t hstep = (size_t)(Epi::PERM == 2 ? 32 : HALF) * K * 2;
    const unsigned ldsw = (unsigned)wid * 1024u;
    const int aoff = lds_byte(wr * 64 + fr, fq * 8), boff = lds_byte(wc * 32 + fr, fq * 8);
#define PG8_SA(b, h) (((b) * 2 + (h)) * HTB)
#define PG8_SB(b, h) ((4 + (b) * 2 + (h)) * HTB)
#define PG8_STAGE(bufoff, gbase, voff) do { _Pragma("unroll") for (int _i = 0; _i < 2; ++_i) \
        __builtin_amdgcn_global_load_lds((const unsigned*)((const char*)(gbase) + (voff)[_i]), (LAS unsigned*)(lds + (bufoff) + ldsw + _i * 8192), 16, 0, 0); } while (0)
#define PG8_LDA(dst, b, h) do { _Pragma("unroll") for (int m = 0; m < 4; ++m) _Pragma("unroll") for (int k = 0; k < 2; ++k) dst[m][k] = *(const LAS bf16x8*)(lds + PG8_SA(b, h) + aoff + m * 2048 + k * 1024); } while (0)
#define PG8_LDB(dst, b, h) do { _Pragma("unroll") for (int n = 0; n < 2; ++n) _Pragma("unroll") for (int k = 0; k < 2; ++k) dst[n][k] = *(const LAS bf16x8*)(lds + PG8_SB(b, h) + boff + n * 2048 + k * 1024); } while (0)
#define PG8_MMA(ai, bj, At, Bt) do { __builtin_amdgcn_s_setprio(1); _Pragma("unroll") for (int m = 0; m < 4; ++m) _Pragma("unroll") for (int n = 0; n < 2; ++n) _Pragma("unroll") for (int k = 0; k < 2; ++k) \
        acc[ai][bj][m][n] = __builtin_amdgcn_mfma_f32_16x16x32_bf16(Bt[n][k], At[m][k], acc[ai][bj][m][n], 0, 0, 0); __builtin_amdgcn_s_setprio(0); } while (0)
#define PG8_WAIT_V(n) asm volatile("s_waitcnt vmcnt(" #n ")" ::: "memory")
#define PG8_WAIT_L(n) asm volatile("s_waitcnt lgkmcnt(" #n ")" ::: "memory")
#define PG8_BAR __builtin_amdgcn_s_barrier()
#define PG8_SCHED __builtin_amdgcn_sched_barrier(0)
    Unit cur, nxt; int ui = 0;
    if (!S.next(0, cur)) return;
    f32x4 acc[2][2][4][2];
#pragma unroll
    for (int a = 0; a < 2; ++a)
#pragma unroll
        for (int b = 0; b < 2; ++b)
#pragma unroll
            for (int m = 0; m < 4; ++m)
#pragma unroll
                for (int n = 0; n < 2; ++n) acc[a][b][m][n] = (f32x4){0.f, 0.f, 0.f, 0.f};
    bf16x8 At[4][2], B0[2][2], B1[2][2];
    unsigned ga[2][2], gn[2][2];
    S.a_offs(cur, ga, Rr, Cc);
    const char* cA = cur.A; const char* cB = cur.B;
    PG8_STAGE(PG8_SB(0, 0), cB, voffB); PG8_STAGE(PG8_SB(0, 1), cB + hstep, voffB); PG8_STAGE(PG8_SA(0, 0), cA, ga[0]); PG8_STAGE(PG8_SA(0, 1), cA, ga[1]);
    if (wr == 1) PG8_BAR;
    PG8_WAIT_V(2); PG8_BAR;
    PG8_STAGE(PG8_SB(1, 0), cB + kstep, voffB); PG8_STAGE(PG8_SA(1, 0), cA + kstep, ga[0]); PG8_STAGE(PG8_SB(1, 1), cB + hstep + kstep, voffB);
    PG8_WAIT_V(6); PG8_BAR;
    for (;;) {
        const bool has_next = S.next(ui + 1, nxt);
        const char* nA = has_next ? nxt.A : cA; const char* nB = has_next ? nxt.B : cB;
#pragma unroll
        for (int h = 0; h < 2; ++h)
#pragma unroll
            for (int i = 0; i < 2; ++i) gn[h][i] = ga[h][i];
        for (int t = 0; t < nt; t += 2) {
            const bool last = (t == nt - 2);
            if (Sched::GATHER && last && has_next) S.a_offs(nxt, gn, Rr, Cc);
            const char* a1 = cA + (size_t)(t + 1) * kstep;
            const char* a2 = last ? nA : cA + (size_t)(t + 2) * kstep; const char* b2 = last ? nB : cB + (size_t)(t + 2) * kstep;
            const char* a3 = a2 + kstep; const char* b3 = b2 + kstep;
            unsigned g2[2][2];
#pragma unroll
            for (int h = 0; h < 2; ++h)
#pragma unroll
                for (int i = 0; i < 2; ++i) g2[h][i] = last ? gn[h][i] : ga[h][i];
            PG8_LDB(B0, 0, 0); PG8_LDB(B1, 0, 1); PG8_SCHED; PG8_LDA(At, 0, 0); PG8_STAGE(PG8_SA(1, 1), a1, ga[1]);
            PG8_WAIT_V(8); PG8_WAIT_L(0); PG8_BAR; PG8_MMA(0, 0, At, B0); PG8_MMA(0, 1, At, B1); PG8_BAR; PG8_SCHED;
            PG8_LDA(At, 0, 1); PG8_STAGE(PG8_SB(0, 0), b2, voffB); PG8_STAGE(PG8_SB(0, 1), b2 + hstep, voffB); PG8_STAGE(PG8_SA(0, 0), a2, g2[0]);
            PG8_WAIT_V(8); PG8_WAIT_L(0); PG8_BAR; PG8_MMA(1, 0, At, B0); PG8_MMA(1, 1, At, B1); PG8_BAR; PG8_SCHED;
            PG8_LDB(B0, 1, 0); PG8_LDB(B1, 1, 1); PG8_SCHED; PG8_LDA(At, 1, 0); PG8_STAGE(PG8_SA(0, 1), a2, g2[1]);
            PG8_WAIT_V(8); PG8_WAIT_L(0); PG8_BAR; PG8_MMA(0, 0, At, B0); PG8_MMA(0, 1, At, B1); PG8_BAR; PG8_SCHED;
            PG8_LDA(At, 1, 1); PG8_STAGE(PG8_SB(1, 0), b3, voffB); PG8_STAGE(PG8_SB(1, 1), b3 + hstep, voffB); PG8_STAGE(PG8_SA(1, 0), a3, g2[0]);
            PG8_WAIT_V(8); PG8_WAIT_L(0); PG8_BAR; PG8_MMA(1, 0, At, B0); PG8_MMA(1, 1, At, B1); PG8_BAR; PG8_SCHED;
        }
        if constexpr (ALIGN_EPI) { if (wr == 0) PG8_BAR; }
        { int te_ = threadIdx.x; asm volatile("" : "+v"(te_));
          E(acc, cur, wr, wc, te_ & 15, (te_ >> 4) & 3, lds + EPI_T_OFF + wid * EPI_T_WAVE); }
        if (!has_next) break;
#pragma unroll
        for (int a = 0; a < 2; ++a)
#pragma unroll
            for (int b = 0; b < 2; ++b)
#pragma unroll
                for (int m = 0; m < 4; ++m)
#pragma unroll
                    for (int n = 0; n < 2; ++n) acc[a][b][m][n] = (f32x4){0.f, 0.f, 0.f, 0.f};
        cur = nxt; cA = nA; cB = nB; ++ui;
#pragma unroll
        for (int h = 0; h < 2; ++h)
#pragma unroll
            for (int i = 0; i < 2; ++i) ga[h][i] = gn[h][i];
        if constexpr (ALIGN_EPI) { if (wr == 1) PG8_BAR; }
    }
    PG8_WAIT_V(0);
    if constexpr (!ALIGN_EPI) { if (wr == 0) PG8_BAR; }
    PG8_BAR;
#undef PG8_SA
#undef PG8_SB
#undef PG8_STAGE
#undef PG8_LDA
#undef PG8_LDB
#undef PG8_MMA
#undef PG8_WAIT_V
#undef PG8_WAIT_L
#undef PG8_BAR
#undef PG8_SCHED
}

#define EPI_CBAR() asm volatile("" ::: "memory")

struct EpiZ {
    static constexpr int PERM = 2;
    bf16_t* O; const float* bias; bf16_t* HM;
    __device__ __forceinline__ void operator()(const f32x4 (&acc)[2][2][4][2], const Unit& u, int wr, int wc, int fr, int fq, LAS unsigned char* tl) const {
        const int col0 = u.c0 + wc * 64 + 8 * fq, lane = fr + 16 * fq;
        const int mode = (u.c0 < ZC_U) ? 0 : (u.c0 < ZC_GA ? 1 : 2);
        const bool hm = (u.c0 < ZC_L) || (u.c0 >= ZC_GA && u.c0 < ZC_GB);
        f32x4 bv[2][2];
#pragma unroll
        for (int bj = 0; bj < 2; ++bj)
#pragma unroll
            for (int n = 0; n < 2; ++n) bv[bj][n] = *(const f32x4*)(bias + col0 + bj * 32 + 4 * n);
        LAS unsigned char* wp = tl + fr * 144 + fq * 16; LAS const unsigned char* rp = tl + (lane >> 3) * 144 + (lane & 7) * 16;
        bf16_t* gp; int rs;
        if (hm) { const int xi = (u.c0 < ZC_L) ? (u.c0 >> 10) : 3, h0 = (((u.c0 < ZC_L) ? (u.c0 & 1023) : (u.c0 - ZC_GA)) >> 6) + wc, b = u.r0 >> 11, t = (u.r0 & 2047) + wr * 64 + (lane >> 3);
            gp = HM + ((size_t)((b * NH + h0) * SEQ + t)) * 256 + xi * 64 + (lane & 7) * 8; rs = 256; }
        else { const int c2 = (u.c0 < ZC_GA) ? u.c0 - ZC_L : u.c0 - ZC_GB + Z2_GB; gp = O + (size_t)(u.r0 + wr * 64 + (lane >> 3)) * NZ2 + c2 + wc * 64 + (lane & 7) * 8; rs = NZ2; }
#pragma unroll
        for (int ai = 0; ai < 2; ++ai)
#pragma unroll
            for (int m = 0; m < 4; ++m) {
#pragma unroll
                for (int bj = 0; bj < 2; ++bj) { f32x4 v0 = acc[ai][bj][m][0] + bv[bj][0], v1 = acc[ai][bj][m][1] + bv[bj][1];
                    if (mode == 1) { f32x2 a = gelu_pk((f32x2){v0[0], v0[1]}), b = gelu_pk((f32x2){v0[2], v0[3]}), c = gelu_pk((f32x2){v1[0], v1[1]}), d = gelu_pk((f32x2){v1[2], v1[3]});
                        v0 = (f32x4){a.x, a.y, b.x, b.y}; v1 = (f32x4){c.x, c.y, d.x, d.y}; }
                    else if (mode == 2) {
#pragma unroll
                        for (int j = 0; j < 4; ++j) { v0[j] = sigmoidf_(v0[j]); v1[j] = sigmoidf_(v1[j]); } }
                    u32x4 w; w.x = cvt_pk_bf16(v0[0], v0[1]); w.y = cvt_pk_bf16(v0[2], v0[3]); w.z = cvt_pk_bf16(v1[0], v1[1]); w.w = cvt_pk_bf16(v1[2], v1[3]);
                    *(LAS u32x4*)(wp + bj * 64) = w; }
                EPI_CBAR();
#pragma unroll
                for (int p = 0; p < 2; ++p) { const u32x4 t = *(LAS const u32x4*)(rp + p * 8 * 144); __builtin_nontemporal_store(t, (u32x4*)(gp + (size_t)((ai * HALF + m * 16 + 8 * p) * rs))); }
                EPI_CBAR(); }
    }
};
struct EpiRes {
    static constexpr int PERM = 2;
    bf16_t* C; const float* base;
    __device__ __forceinline__ void operator()(const f32x4 (&acc)[2][2][4][2], const Unit& u, int wr, int wc, int fr, int fq, LAS unsigned char* tl) const {
        const int lane = fr + 16 * fq;
        LAS unsigned char* wp = tl + fr * 144 + fq * 16; LAS const unsigned char* rp = tl + (lane >> 3) * 144 + (lane & 7) * 16;
        const size_t go = (size_t)(u.r0 + wr * 64 + (lane >> 3)) * D + u.c0 + wc * 64 + (lane & 7) * 8;
        f32x4 xa[2][2];
#pragma unroll
        for (int ai = 0; ai < 2; ++ai)
#pragma unroll
            for (int m = 0; m < 4; ++m) {
#pragma unroll
                for (int p = 0; p < 2; ++p) { const size_t o = go + (size_t)(ai * HALF + m * 16 + 8 * p) * D; xa[p][0] = *(const f32x4*)(base + o); xa[p][1] = *(const f32x4*)(base + o + 4); }
#pragma unroll
                for (int bj = 0; bj < 2; ++bj) { const f32x4 v0 = acc[ai][bj][m][0], v1 = acc[ai][bj][m][1];
                    u32x4 w; w.x = cvt_pk_bf16(v0[0], v0[1]); w.y = cvt_pk_bf16(v0[2], v0[3]); w.z = cvt_pk_bf16(v1[0], v1[1]); w.w = cvt_pk_bf16(v1[2], v1[3]);
                    *(LAS u32x4*)(wp + bj * 64) = w; }
                EPI_CBAR();
#pragma unroll
                for (int p = 0; p < 2; ++p) { const u32x4 t = *(LAS const u32x4*)(rp + p * 8 * 144);
                    u32x4 w; w.x = cvt_pk_bf16(xa[p][0][0] + bf_lo(t.x), xa[p][0][1] + bf_hi(t.x)); w.y = cvt_pk_bf16(xa[p][0][2] + bf_lo(t.y), xa[p][0][3] + bf_hi(t.y));
                    w.z = cvt_pk_bf16(xa[p][1][0] + bf_lo(t.z), xa[p][1][1] + bf_hi(t.z)); w.w = cvt_pk_bf16(xa[p][1][2] + bf_lo(t.w), xa[p][1][3] + bf_hi(t.w));
                    __builtin_nontemporal_store(w, (u32x4*)(C + go + (size_t)(ai * HALF + m * 16 + 8 * p) * D)); }
                EPI_CBAR(); }
    }
};
struct EpiSwiglu {
    static constexpr int PERM = 1;
    bf16_t* O; const float* bias;
    __device__ __forceinline__ void operator()(const f32x4 (&acc)[2][2][4][2], const Unit& u, int wr, int wc, int fr, int fq, LAS unsigned char* tl) const {
        const int fl = wc * 32 + 8 * fq, lane = fr + 16 * fq;
        const float* bp = bias + (size_t)u.e * 2048 + u.c0 + fl;
        f32x4 bg[2], bu[2];
#pragma unroll
        for (int n = 0; n < 2; ++n) { bg[n] = *(const f32x4*)(bp + 4 * n); bu[n] = *(const f32x4*)(bp + HALF + 4 * n); }
        LAS unsigned char* wp = tl + fr * 80 + fq * 16; LAS const unsigned char* rp = tl + (lane >> 2) * 80 + (lane & 3) * 16;
        bf16_t* gp = O + (size_t)(u.r0 + wr * 64 + (lane >> 2)) * FF + (u.c0 >> 1) + wc * 32 + (lane & 3) * 8;
#pragma unroll
        for (int ai = 0; ai < 2; ++ai)
#pragma unroll
            for (int m = 0; m < 4; ++m) {
                float a[8];
#pragma unroll
                for (int n = 0; n < 2; ++n)
#pragma unroll
                    for (int j = 0; j < 4; ++j) { float g = acc[ai][0][m][n][j] + bg[n][j], up = acc[ai][1][m][n][j] + bu[n][j];
                        g = fminf(g, 7.0f); up = fminf(fmaxf(up, -7.0f), 7.0f);
                        a[n * 4 + j] = g * sigmoidf_(1.702f * g) * (up + 1.0f); }
                u32x4 w; w.x = cvt_pk_bf16(a[0], a[1]); w.y = cvt_pk_bf16(a[2], a[3]); w.z = cvt_pk_bf16(a[4], a[5]); w.w = cvt_pk_bf16(a[6], a[7]);
                *(LAS u32x4*)wp = w;
                EPI_CBAR();
                const u32x4 t = *(LAS const u32x4*)rp; __builtin_nontemporal_store(t, (u32x4*)(gp + (size_t)(ai * HALF + m * 16) * FF));
                EPI_CBAR(); }
    }
};
struct EpiDown {
    static constexpr int PERM = 2;
    bf16_t* O; const float* bias;
    __device__ __forceinline__ void operator()(const f32x4 (&acc)[2][2][4][2], const Unit& u, int wr, int wc, int fr, int fq, LAS unsigned char* tl) const {
        const int col0 = u.c0 + wc * 64 + 8 * fq, lane = fr + 16 * fq;
        const float* bp = bias + (size_t)u.e * D + col0;
        f32x4 bv[2][2];
#pragma unroll
        for (int bj = 0; bj < 2; ++bj)
#pragma unroll
            for (int n = 0; n < 2; ++n) bv[bj][n] = *(const f32x4*)(bp + bj * 32 + 4 * n);
        LAS unsigned char* wp = tl + fr * 144 + fq * 16; LAS const unsigned char* rp = tl + (lane >> 3) * 144 + (lane & 7) * 16;
        bf16_t* gp = O + (size_t)(u.r0 + wr * 64 + (lane >> 3)) * D + u.c0 + wc * 64 + (lane & 7) * 8;
#pragma unroll
        for (int ai = 0; ai < 2; ++ai)
#pragma unroll
            for (int m = 0; m < 4; ++m) {
#pragma unroll
                for (int bj = 0; bj < 2; ++bj) { const f32x4 v0 = acc[ai][bj][m][0] + bv[bj][0], v1 = acc[ai][bj][m][1] + bv[bj][1];
                    u32x4 w; w.x = cvt_pk_bf16(v0[0], v0[1]); w.y = cvt_pk_bf16(v0[2], v0[3]); w.z = cvt_pk_bf16(v1[0], v1[1]); w.w = cvt_pk_bf16(v1[2], v1[3]);
                    *(LAS u32x4*)(wp + bj * 64) = w; }
                EPI_CBAR();
#pragma unroll
                for (int p = 0; p < 2; ++p) { const u32x4 t = *(LAS const u32x4*)(rp + p * 8 * 144); __builtin_nontemporal_store(t, (u32x4*)(gp + (size_t)(ai * HALF + m * 16 + 8 * p) * D)); }
                EPI_CBAR(); }
    }
};
}

#define XB_TMO      128
#define XB_XCNT(j)  (256  + 64 * (j))
#define XB_XSUB(j)  (1280 + 64 * (j))
#define XB_XGEN(j)  (2304 + 64 * (j))
#define XB_TOP      3328
#define XB_TOPGEN   3392
#define XCD_BAR_WORDS 3456
#define XB_SPIN_CAP (1u << 18)
__device__ __forceinline__ unsigned xb_ld(unsigned* p)              { return __hip_atomic_load(p, __ATOMIC_RELAXED, __HIP_MEMORY_SCOPE_AGENT); }
__device__ __forceinline__ unsigned xb_add(unsigned* p, unsigned v) { return __hip_atomic_fetch_add(p, v, __ATOMIC_RELAXED, __HIP_MEMORY_SCOPE_AGENT); }
__device__ __forceinline__ unsigned xb_xcc_id() { return (unsigned)__builtin_amdgcn_s_getreg((3 << 11) | 20) & 0xFu; }
#define XB_SPIN(cond, bar) do { unsigned _sp = 0; while (cond) { __builtin_amdgcn_s_sleep(1); \
    if ((++_sp & 255u) == 0u) { if (xb_ld(&(bar)[XB_TMO])) break; if (_sp > XB_SPIN_CAP) { atomicAdd(&(bar)[XB_TMO], 1u); break; } } } } while (0)
struct XcdBarrier { unsigned* bar; unsigned x; volatile LAS unsigned* st; };
__device__ __forceinline__ XcdBarrier xcd_barrier_post(unsigned* bar, volatile LAS unsigned* st) {
    XcdBarrier b; b.bar = bar; b.x = xb_xcc_id(); b.st = st;
    if (threadIdx.x == 0) (void)xb_add(&bar[XB_XCNT(b.x)], 1u);
    return b;
}
__device__ __forceinline__ void xcd_barrier_complete(unsigned* bar, unsigned x, unsigned& nloc, unsigned& nx) {
    const unsigned G = gridDim.x * gridDim.y * gridDim.z;
    unsigned sum, cnt, mine, sp = 0u;
    for (;;) {
        sum = 0u; cnt = 0u; mine = 0u;
#pragma unroll
        for (unsigned j = 0; j < 16; ++j) { const unsigned c = xb_ld(&bar[XB_XCNT(j)]); sum += c; cnt += (c > 0u) ? 1u : 0u; mine = (j == x) ? c : mine; }
        if (sum == G) break;
        __builtin_amdgcn_s_sleep(1);
        if ((++sp & 255u) == 0u) { if (xb_ld(&bar[XB_TMO])) break; if (sp > XB_SPIN_CAP) { atomicAdd(&bar[XB_TMO], 1u); break; } }
    }
    nloc = mine > 0u ? mine : 1u; nx = cnt > 0u ? cnt : 1u;
}
__device__ __forceinline__ void xcd_barrier(const XcdBarrier& b) {
    asm volatile("s_waitcnt vmcnt(0)" ::: "memory");
    __syncthreads();
    if (threadIdx.x == 0) {
        unsigned* bar = b.bar;
        __builtin_amdgcn_s_waitcnt(0);
        unsigned nloc = b.st[0], nx = b.st[1];
        if (nloc == 0u) { xcd_barrier_complete(bar, b.x, nloc, nx); b.st[0] = nloc; b.st[1] = nx; }
        const unsigned old = xb_add(&bar[XB_XSUB(b.x)], 1u);
        const unsigned gen = old / nloc;
        if (old + 1u == (gen + 1u) * nloc) {
            __builtin_amdgcn_fence(__ATOMIC_RELEASE, "agent");
            asm volatile("s_waitcnt vmcnt(0)" ::: "memory");
            const unsigned og = xb_add(&bar[XB_TOP], 1u);
            const unsigned tg = og / nx;
            if (og + 1u == (tg + 1u) * nx) xb_add(&bar[XB_TOPGEN], 1u);
            else XB_SPIN(xb_ld(&bar[XB_TOPGEN]) == tg, bar);
            __builtin_amdgcn_fence(__ATOMIC_ACQUIRE, "agent");
            xb_add(&bar[XB_XGEN(b.x)], 1u);
            asm volatile("s_waitcnt vmcnt(0)" ::: "memory");
        } else {
            XB_SPIN(xb_ld(&bar[XB_XGEN(b.x)]) == gen, bar);
            __builtin_amdgcn_fence(__ATOMIC_ACQUIRE, "agent");
            asm volatile("s_waitcnt vmcnt(0)" ::: "memory");
        }
    }
    __syncthreads();
}

struct Args {
    const float* in[28]; float* out; unsigned char* ws; int ph_lo, ph_hi;
};
struct Frame {
    LAS unsigned char* lds; volatile LAS unsigned* MISC; unsigned* ctl;
    int tid, lane, wave, G, bid;
};
enum { I_X = 0, I_N1G, I_WIN, I_BGATE, I_TMIX, I_WDU, I_W0, I_AUP, I_A0, I_GUP, I_KK, I_KA, I_RK, I_GNW, I_GNB, I_LNVG, I_LNVB, I_WSP, I_BSP, I_WOUT, I_N2G, I_WR, I_BR, I_WGU, I_BGU, I_WD, I_BDN, I_NFG };

template <class RowMap>
__device__ __forceinline__ void p0_transpose_item(const float* W, int K, int N, bf16_t* WT, const RowMap& rm, LAS float* scr, int item, int lane) {
    const int nblk = N / 32, kb = item / nblk, nb = item % nblk, k0 = 64 * kb, n0 = 32 * nb;
#pragma unroll 8
    for (int i = 0; i < 32; ++i) { const int kk = 2 * i + (lane >> 5); scr[kk * 33 + (lane & 31)] = W[(size_t)(k0 + kk) * N + n0 + (lane & 31)]; }
    LDS_WAIT(); asm volatile("" ::: "memory");
    const int c = lane & 7;
#pragma unroll
    for (int j = 0; j < 4; ++j) { const int n = (lane >> 3) + 8 * j; const LAS float* s = scr + (8 * c) * 33 + n;
        u32x4 o; o.x = cvt_pk_bf16(s[0 * 33], s[1 * 33]); o.y = cvt_pk_bf16(s[2 * 33], s[3 * 33]); o.z = cvt_pk_bf16(s[4 * 33], s[5 * 33]); o.w = cvt_pk_bf16(s[6 * 33], s[7 * 33]);
        *(u32x4*)(WT + (size_t)rm(n0 + n) * K + k0 + 8 * c) = o; }
    LDS_WAIT(); asm volatile("" ::: "memory");
}
struct RmId { __device__ __forceinline__ int operator()(int n) const { return n; } };
struct RmIn { __device__ __forceinline__ int operator()(int n) const { return n < 3360 ? n : n + 224; } };
__device__ __forceinline__ void tr_issue(const float* W, int N, int item, int lane, float (&v)[32]) {
    const int nblk = N / 32, kb = item / nblk, nb = item % nblk, k0 = 64 * kb, n0 = 32 * nb;
    const float* base = W + (size_t)k0 * N + n0;
    const int lo = (lane >> 5) * N + (lane & 31);
#pragma unroll
    for (int i = 0; i < 32; ++i) v[i] = (base + (size_t)(2 * i) * N)[lo];
}
template <class RowMap>
__device__ __forceinline__ void tr_finish(const float (&v)[32], int K, int N, bf16_t* WT, const RowMap& rm, LAS float* scr, int item, int lane) {
    const int nblk = N / 32, kb = item / nblk, nb = item % nblk, k0 = 64 * kb, n0 = 32 * nb;
#pragma unroll
    for (int i = 0; i < 32; ++i) { const int kk = 2 * i + (lane >> 5); scr[kk * 33 + (lane & 31)] = v[i]; }
    LDS_WAIT(); asm volatile("" ::: "memory");
    const int c = lane & 7;
#pragma unroll
    for (int j = 0; j < 4; ++j) { const int n = (lane >> 3) + 8 * j; const LAS float* s = scr + (8 * c) * 33 + n;
        u32x4 o; o.x = cvt_pk_bf16(s[0 * 33], s[1 * 33]); o.y = cvt_pk_bf16(s[2 * 33], s[3 * 33]); o.z = cvt_pk_bf16(s[4 * 33], s[5 * 33]); o.w = cvt_pk_bf16(s[6 * 33], s[7 * 33]);
        *(u32x4*)(WT + (size_t)rm(n0 + n) * K + k0 + 8 * c) = o; }
    LDS_WAIT(); asm volatile("" ::: "memory");
}
struct RmGu { __device__ __forceinline__ int operator()(int n) const { const int f = n >> 1, up = n & 1; return (f >> 7) * 256 + up * 128 + (f & 127); } };

__device__ __forceinline__ void p0_prologue(Frame& F, const Args& a) {
    unsigned char* ws = a.ws;
    bf16_t* Bin = (bf16_t*)(ws + WS_BIN); bf16_t* Bout = (bf16_t*)(ws + WS_BOUT); bf16_t* Bgu = (bf16_t*)(ws + WS_BGU); bf16_t* Bd = (bf16_t*)(ws + WS_BD);
    LAS float* scr = (LAS float*)(F.lds + RING_OFF + F.wave * 16384);
    const int gw = F.bid * NWAVES + F.wave, NGW = F.G * NWAVES;
    constexpr int I_IN = (D / 64) * (7456 / 32), I_OUT = (D / 64) * (D / 32), I_GU1 = (D / 64) * (2048 / 32), I_D1 = (FF / 64) * (D / 32);
    constexpr int NITEMS = I_IN + I_OUT;
    for (int it = gw; it < NITEMS; it += NGW) {
        int r = it;
        if (r < I_IN) { p0_transpose_item(a.in[I_WIN], D, 7456, Bin, RmIn(), scr, r, ((int)(threadIdx.x & 63u))); continue; } r -= I_IN;
        p0_transpose_item(a.in[I_WOUT], D, D, Bout, RmId(), scr, r, ((int)(threadIdx.x & 63u)));
        (void)Bgu; (void)Bd; (void)I_GU1; (void)I_D1;
    }
    const int gt = F.bid * (NWAVES * 64) + ((int)threadIdx.x), NGT = F.G * NWAVES * 64;
    {
        u32x4* p = (u32x4*)(Bin + (size_t)3360 * D);
        for (int i = gt; i < 224 * 128; i += NGT) p[i] = (u32x4){0u, 0u, 0u, 0u};
    }
    {   float* bz = (float*)(ws + WS_MISC + MO_BIASZ);
        for (int i = gt; i < NZ; i += NGT) bz[i] = (i >= ZC_GA) ? a.in[I_BGATE][i - ZC_GA] : 0.f;
    }
    {   float* bg = (float*)(ws + WS_MISC + MO_BGU);
        for (int i = gt; i < NE * 2048; i += NGT) { const int e = i >> 11, n = i & 2047; bg[(size_t)e * 2048 + RmGu()(n)] = a.in[I_BGU][i]; }
    }
    {   bf16_t* wh = (bf16_t*)(ws + WS_MISC + MO_WRT); bf16_t* wl = wh + NE * D;
        for (int i = gt; i < NE * D; i += NGT) { const int e = i >> 10, k = i & 1023; const float w = a.in[I_WR][(size_t)k * NE + e];
            const unsigned h = cvt_pk_bf16(w, 0.f) & 0xffffu; const float rlo = w - bf_lo(h); wh[i] = (bf16_t)h; wl[i] = (bf16_t)(cvt_pk_bf16(rlo, 0.f) & 0xffffu); }
    }
    {   bf16_t* lt = (bf16_t*)(ws + WS_MISC + MO_LT);
        for (int i = gt; i < D * 288; i += NGT) { const int n = i / 288, k = i - n * 288;
            const float w = (k < 64) ? a.in[I_WDU][(size_t)k * D + n] : (k < 128 ? a.in[I_AUP][(size_t)(k - 64) * D + n] : a.in[I_GUP][(size_t)(k - 128) * D + n]);
            lt[i] = (bf16_t)(cvt_pk_bf16(w, 0.f) & 0xffffu); }
    }
    const float* x = a.in[I_X]; const float* g1 = a.in[I_N1G]; bf16_t* Hh = (bf16_t*)(ws + WS_H);
    f32x4 gv[4];
#pragma unroll
    for (int j = 0; j < 4; ++j) gv[j] = *((const f32x4*)g1 + ((int)(threadIdx.x & 63u)) + 64 * j);
    for (int m = gw; m < T; m += NGW) {
        const f32x4* xr = (const f32x4*)(x + (size_t)m * D) + ((int)(threadIdx.x & 63u));
        f32x4 v[4]; float s = 0.f;
#pragma unroll
        for (int j = 0; j < 4; ++j) { v[j] = xr[64 * j]; s += (v[j].x * v[j].x + v[j].y * v[j].y) + (v[j].z * v[j].z + v[j].w * v[j].w); }
        const float rstd = __builtin_amdgcn_rsqf(wave_sum(s) * (1.f / D) + RMS_EPS);
        u32x2* o8 = (u32x2*)(Hh + (size_t)m * D) + ((int)(threadIdx.x & 63u));
#pragma unroll
        for (int j = 0; j < 4; ++j) { const f32x4 y = v[j] * rstd * gv[j]; o8[64 * j] = (u32x2){cvt_pk_bf16(y.x, y.y), cvt_pk_bf16(y.z, y.w)}; }
    }
}

constexpr int TC = 32, NMC = TC / 4, NCH = 2048 / TC;
constexpr int RC_AT = 0;
constexpr int RC_RT = RC_AT + TC * 128;
constexpr int RC_BT = RC_RT + TC * 128;
constexpr int RC_KT = RC_BT + TC * 128;
constexpr int SB_CUMF = RC_KT + TC * 128;
constexpr int RC_VB = SB_CUMF + TC * 256;
constexpr int RC_P4 = RC_VB + TC * 128;
constexpr int RC_SCL = RC_P4 + NMC * 256;
constexpr int SB_RB = RC_SCL + NMC * 128;
constexpr int SB_KP = SB_RB + TC * 128;
constexpr int SB_V = SB_KP + TC * 256;
constexpr int SB_G = SB_V + TC * 256;
constexpr int SB_GA0 = SB_G + TC * 256;
constexpr int SB_WRAW = SB_GA0 + 2 * TC * 128;
constexpr int SB_ARAW = SB_WRAW + TC * 256;
constexpr int SB_Y = 150016;
constexpr int SB_LABF = SB_ARAW;
constexpr int SB_TIMG = SB_LABF + 2048;
constexpr int SB_LAKIMG = SB_TIMG + 2048;
constexpr int SB_MRIMG = SB_LAKIMG + 2048;
constexpr int SB_RAWRKV = SB_ARAW + TC * 256;
constexpr int SB_ALT = SB_RAWRKV + (TC + 1) * 384;
constexpr int SB_END = SB_ALT + TC * 576;
constexpr int SB_PBAR = LDSCTL_OFF + 1536;
constexpr int SB_CST = LDSCTL_OFF + 2048;
static_assert(SB_END + 4 * 8448 <= LDSCTL_OFF && SB_CST + 2560 <= LDS_BYTES, "scan LDS map (+ 4 conversion scratch tiles)");
constexpr int NP_RKV = (TC + 1) * 24;

__device__ __forceinline__ f32x4 ld_bf4(const bf16_t* p) { const u32x2 v = *(const u32x2*)p; return (f32x4){bf_lo(v.x), bf_hi(v.x), bf_lo(v.y), bf_hi(v.y)}; }
__device__ __forceinline__ f32x4 lds_bf4(const LAS unsigned char* p) { const u32x2 v = *(const LAS u32x2*)p; return (f32x4){bf_lo(v.x), bf_hi(v.x), bf_lo(v.y), bf_hi(v.y)}; }
__device__ __forceinline__ void ld_bf8(const bf16_t* p, float (&o)[8]) { const u32x4 v = *(const u32x4*)p;
    o[0] = bf_lo(v.x); o[1] = bf_hi(v.x); o[2] = bf_lo(v.y); o[3] = bf_hi(v.y); o[4] = bf_lo(v.z); o[5] = bf_hi(v.z); o[6] = bf_lo(v.w); o[7] = bf_hi(v.w); }
__device__ __forceinline__ void un8(const u32x4 v, float (&o)[8]) {
    o[0] = bf_lo(v.x); o[1] = bf_hi(v.x); o[2] = bf_lo(v.y); o[3] = bf_hi(v.y); o[4] = bf_lo(v.z); o[5] = bf_hi(v.z); o[6] = bf_lo(v.w); o[7] = bf_hi(v.w); }
__device__ __forceinline__ bf16x8 pack8(const float (&o)[8]) { u32x4 w; w.x = cvt_pk_bf16(o[0], o[1]); w.y = cvt_pk_bf16(o[2], o[3]); w.z = cvt_pk_bf16(o[4], o[5]); w.w = cvt_pk_bf16(o[6], o[7]); return __builtin_bit_cast(bf16x8, w); }

__device__ __forceinline__ void p2a_act(Frame& F, const Args& a) {
    const bf16_t* Z = (const bf16_t*)(a.ws + WS_Z); bf16_t* AL = (bf16_t*)(a.ws + WS_AL);
    const float* tml = a.in[I_TMIX] + TM_DL;
    const int gt = F.bid * (NWAVES * 64) + ((int)threadIdx.x), NGT = F.G * NWAVES * 64;
    for (int it = gt; it < T * 36; it += NGT) { const int t = it / 36, p = it - t * 36;
        float c[8], pv[8], m8[8];
        ld_bf8(Z + (size_t)t * NZ2 + Z2_L + 8 * p, c);
        if ((t & (SEQ - 1)) != 0) ld_bf8(Z + (size_t)(t - 1) * NZ2 + Z2_L + 8 * p, pv); else {
#pragma unroll
            for (int j = 0; j < 8; ++j) pv[j] = 0.f; }
        const f32x4 ta = *(const f32x4*)(tml + 8 * p), tb = *(const f32x4*)(tml + 8 * p + 4);
#pragma unroll
        for (int j = 0; j < 8; ++j) { const float tmj = (j < 4) ? ta[j] : tb[j - 4]; m8[j] = c[j] + (pv[j] - c[j]) * tmj; }
        if (p < 8) {
#pragma unroll
            for (int j = 0; j < 8; ++j) m8[j] = 1.0f - 2.0f * __builtin_amdgcn_rcpf(1.0f + __expf(2.0f * m8[j])); }
        else if (p >= 16) {
#pragma unroll
            for (int j = 0; j < 8; ++j) m8[j] = sigmoidf_(m8[j]); }
        *(bf16x8*)(AL + (size_t)t * 288 + 8 * p) = pack8(m8);
    }
}

template <int SUB> __device__ __forceinline__ void scan_sub(f32x4 (&acc)[4], const LAS unsigned char* L, int fn, int g, int row) {
    const LAS unsigned char* xa = L + RC_AT + (16 * SUB + fn) * 128 + 8 * g; const LAS unsigned char* xr = L + RC_RT + (16 * SUB + fn) * 128 + 8 * g;
    u32x4 xa0, xa1, xr0, xr1;
    { const u32x2 p0 = *(const LAS u32x2*)(xa), p1 = *(const LAS u32x2*)(xa + 32), p2 = *(const LAS u32x2*)(xa + 64), p3 = *(const LAS u32x2*)(xa + 96);
      xa0 = (u32x4){p0.x, p0.y, p1.x, p1.y}; xa1 = (u32x4){p2.x, p2.y, p3.x, p3.y}; }
    { const u32x2 p0 = *(const LAS u32x2*)(xr), p1 = *(const LAS u32x2*)(xr + 32), p2 = *(const LAS u32x2*)(xr + 64), p3 = *(const LAS u32x2*)(xr + 96);
      xr0 = (u32x4){p0.x, p0.y, p1.x, p1.y}; xr1 = (u32x4){p2.x, p2.y, p3.x, p3.y}; }
    const bf16x8 tf = *(const LAS bf16x8*)(L + SB_TIMG + ((SUB * 16 + fn) * 4 + g) * 16), lakf = *(const LAS bf16x8*)(L + SB_LAKIMG + ((SUB * 16 + fn) * 4 + g) * 16),
                 mrf = *(const LAS bf16x8*)(L + SB_MRIMG + ((SUB * 16 + fn) * 4 + g) * 16);
    const int trow = (16 * SUB + 4 * g + (fn >> 2)) * 128 + 8 * (fn & 3);
    const u32x2 vt = __builtin_bit_cast(u32x2, __builtin_amdgcn_ds_read_tr16_b64_v4i16((LAS s16x4*)(L + RC_VB + trow + (row - fn) * 2)));
    bf16x8 bk[4]; f32x4 p16[4];
#pragma unroll
    for (int jb = 0; jb < 4; ++jb) { const u32x2 bq = __builtin_bit_cast(u32x2, __builtin_amdgcn_ds_read_tr16_b64_v4i16((LAS s16x4*)(L + RC_BT + trow + 32 * jb))),
                                                 kq = __builtin_bit_cast(u32x2, __builtin_amdgcn_ds_read_tr16_b64_v4i16((LAS s16x4*)(L + RC_KT + trow + 32 * jb)));
        bk[jb] = __builtin_bit_cast(bf16x8, (u32x4){bq.x, bq.y, kq.x, kq.y}); p16[jb] = *(const LAS f32x4*)(L + RC_P4 + (SUB * 64 + 16 * jb + 4 * g) * 4); }
    const u32x4 vq = (u32x4){vt.x, vt.y, 0u, 0u};
    const f32x4 lv = __builtin_amdgcn_mfma_f32_16x16x32_bf16(lakf, __builtin_bit_cast(bf16x8, vq), (f32x4){0.f, 0.f, 0.f, 0.f}, 0, 0, 0);
    float t0[8] = {acc[0][0], acc[0][1], acc[0][2], acc[0][3], acc[1][0], acc[1][1], acc[1][2], acc[1][3]}, t1[8] = {acc[2][0], acc[2][1], acc[2][2], acc[2][3], acc[3][0], acc[3][1], acc[3][2], acc[3][3]};
    const bf16x8 sf0 = pack8(t0), sf1 = pack8(t1);
    f32x4 gq = __builtin_amdgcn_mfma_f32_16x16x32_bf16(__builtin_bit_cast(bf16x8, xa0), sf0, lv, 0, 0, 0);
    gq = __builtin_amdgcn_mfma_f32_16x16x32_bf16(__builtin_bit_cast(bf16x8, xa1), sf1, gq, 0, 0, 0);
    f32x4 hq = __builtin_amdgcn_mfma_f32_16x16x32_bf16(__builtin_bit_cast(bf16x8, xr0), sf0, (f32x4){0.f, 0.f, 0.f, 0.f}, 0, 0, 0);
    hq = __builtin_amdgcn_mfma_f32_16x16x32_bf16(__builtin_bit_cast(bf16x8, xr1), sf1, hq, 0, 0, 0);
    const u32x4 gl = (u32x4){cvt_pk_bf16(gq[0], gq[1]), cvt_pk_bf16(gq[2], gq[3]), 0u, 0u};
    const f32x4 uq = __builtin_amdgcn_mfma_f32_16x16x32_bf16(tf, __builtin_bit_cast(bf16x8, gl), (f32x4){0.f, 0.f, 0.f, 0.f}, 0, 0, 0);
    const u32x4 uv = (u32x4){cvt_pk_bf16(uq[0], uq[1]), cvt_pk_bf16(uq[2], uq[3]), vt.x, vt.y};
    const bf16x8 uvf = __builtin_bit_cast(bf16x8, uv);
    const f32x4 yq = __builtin_amdgcn_mfma_f32_16x16x32_bf16(mrf, uvf, hq, 0, 0, 0);
#pragma unroll
    for (int jb = 0; jb < 4; ++jb) acc[jb] = __builtin_amdgcn_mfma_f32_16x16x32_bf16(bk[jb], uvf, acc[jb], 0, 0, 0);
#pragma unroll
    for (int r = 0; r < 4; ++r) *(LAS float*)((LAS unsigned char*)L + SB_Y + (16 * SUB + 4 * g + r) * 256 + 4 * row) = yq[r];
#pragma unroll
    for (int jb = 0; jb < 4; ++jb) acc[jb] = acc[jb] * p16[jb];
    __builtin_amdgcn_sched_barrier(0);
    if constexpr (SUB + 1 < TC / 16) scan_sub<SUB + 1>(acc, L, fn, g, row);
}
__device__ __forceinline__ void pbar(LAS unsigned* cnt, unsigned target) {
    asm volatile("s_waitcnt lgkmcnt(0)" ::: "memory");
    if ((threadIdx.x & 63u) == 0u) __hip_atomic_fetch_add(cnt, 1u, __ATOMIC_RELAXED, __HIP_MEMORY_SCOPE_WORKGROUP);
    while (__hip_atomic_load(cnt, __ATOMIC_RELAXED, __HIP_MEMORY_SCOPE_WORKGROUP) < target) __builtin_amdgcn_s_sleep(1);
    asm volatile("" ::: "memory");
}

__device__ __forceinline__ void parrive(LAS unsigned* cnt) {
    asm volatile("s_waitcnt lgkmcnt(0)" ::: "memory");
    if ((threadIdx.x & 63u) == 0u) __hip_atomic_fetch_add(cnt, 1u, __ATOMIC_RELAXED, __HIP_MEMORY_SCOPE_WORKGROUP);
}
constexpr int SB_DUMMY = 150528;
__device__ __forceinline__ void glds_touch(const void* g, unsigned ldsoff) {
    unsigned sv;
    asm volatile("s_mov_b32 %0, m0\n\ts_mov_b32 m0, %2\n\ts_nop 0\n\tglobal_load_lds_dwordx4 %1, off\n\ts_mov_b32 m0, %0" : "=&s"(sv) : "v"(g), "s"(ldsoff) : "memory");
}
__device__ __forceinline__ void p2_scan(Frame& F, const Args& a, size_t mo_off = WS_M) {
    const unsigned char* HMb = a.ws + WS_HM; bf16_t* Mo = (bf16_t*)(a.ws + mo_off); const bf16_t* AL = (const bf16_t*)(a.ws + WS_AL);
    LAS unsigned char* L = F.lds;
    LAS unsigned* PB = (LAS unsigned*)(F.lds + SB_PBAR);
    const int w = F.wave, tid = ((int)threadIdx.x);
    const float* tmix = a.in[I_TMIX];
    for (int unit = F.bid; unit < NB_ * NH; unit += F.G) {
        const int b = unit / NH, h = unit % NH;
        const size_t trow0 = (size_t)b * SEQ;
        {   LAS float* CST = (LAS float*)(F.lds + SB_CST);
            for (int i = tid; i < 640; i += NWAVES * 64) { const int a_ = i >> 6, c_ = h * HD + (i & 63);
                const float* sp = (a_ == 0) ? tmix + TM_R : (a_ == 1) ? tmix + TM_K : (a_ == 2) ? tmix + TM_V : (a_ == 3) ? a.in[I_W0] : (a_ == 4) ? a.in[I_A0] : (a_ == 5) ? a.in[I_KK] : (a_ == 6) ? a.in[I_KA] : (a_ == 7) ? a.in[I_RK] : (a_ == 8) ? a.in[I_GNW] : a.in[I_GNB];
                CST[i] = sp[c_]; }
            if (tid == 0) *PB = 0u;
        }
        bf16x8 Bw[2], Ba[2], Bg[5];
        {   const int lane0 = tid & 63; const bf16_t* lp = (const bf16_t*)(a.ws + WS_MISC + MO_LT) + (size_t)(h * HD + (w & 3) * 16 + (lane0 & 15)) * 288 + 8 * (lane0 >> 4);
#pragma unroll
            for (int sx = 0; sx < 2; ++sx) { Bw[sx] = *(const bf16x8*)(lp + 32 * sx); Ba[sx] = *(const bf16x8*)(lp + 64 + 32 * sx); }
#pragma unroll
            for (int sx = 0; sx < 5; ++sx) Bg[sx] = *(const bf16x8*)(lp + 128 + 32 * sx);
        }
        unsigned pbt = 0u;
        f32x4 acc[4];
#pragma unroll
        for (int g = 0; g < 4; ++g) acc[g] = (f32x4){0.f, 0.f, 0.f, 0.f};
        __syncthreads();
        for (int ch = -1; ch < NCH; ++ch) {
            int tidv = tid; asm volatile("" : "+v"(tidv));
            const int lane = tidv & 63, fn = lane & 15, kg = lane >> 4;
            const int tl = tidv >> 4, q = tidv & 15, col4 = h * HD + 4 * q;
            const LAS f32x4* CQ = (const LAS f32x4*)(F.lds + SB_CST) + q;
            if (w < 4) {
                if (ch >= 0) {
                    scan_sub<0>(acc, L, fn, kg, 16 * w + fn);
                }
            } else {
                const int ts = tidv - 256, pw = w - 4;
                const bool do_cv = (ch >= 0 && (ch & 3) < 3 && F.G == 256);
                const int cvi = F.bid * 192 + pw * 48 + (ch >> 2) * 3 + (ch & 3);
                float cv[32];
                if (do_cv) { if (cvi < NE * 1024) tr_issue(a.in[I_WGU] + (size_t)(cvi >> 10) * D * 2048, 2048, cvi & 1023, lane, cv);
                             else { const int r_ = cvi - NE * 1024; tr_issue(a.in[I_WD] + (size_t)(r_ >> 9) * FF * D, D, r_ & 511, lane, cv); } }
                if (ch + 1 < NCH) {
                    const unsigned char* cb_ = HMb + ((long)unit * SEQ + (long)(ch + 1) * TC - 1) * 512L;
                    const unsigned char* ab_ = (const unsigned char*)(AL + (trow0 + (size_t)(ch + 1) * TC) * 288);
                    u32x4 R4[4], G1, A5[5];
#pragma unroll
                    for (int j = 0; j < 4; ++j) { const int pid = ts + 256 * j; R4[j] = (u32x4){0u, 0u, 0u, 0u};
                        if (pid < NP_RKV && !(ch + 1 == 0 && pid < 24)) { const int row = pid / 24, pc = pid % 24, arr = pc >> 3, c8 = pc & 7; R4[j] = *(const u32x4*)(cb_ + row * 512 + (arr * 8 + c8) * 16); } }
                    G1 = *(const u32x4*)(cb_ + ((ts >> 3) + 1) * 512 + 384 + (ts & 7) * 16);
#pragma unroll
                    for (int j = 0; j < 5; ++j) if (ts + 256 * j < TC * 36) A5[j] = *(const u32x4*)(ab_ + (ts + 256 * j) * 16);
#pragma unroll
                    for (int j = 0; j < 4; ++j) if (ts + 256 * j < NP_RKV) *(LAS u32x4*)(L + SB_RAWRKV + (ts + 256 * j) * 16) = R4[j];
                    *(LAS u32x4*)(L + SB_GA0 + ((ch + 1) & 1) * (TC * 128) + ts * 16) = G1;
#pragma unroll
                    for (int j = 0; j < 5; ++j) if (ts + 256 * j < TC * 36) *(LAS u32x4*)(L + SB_ALT + (ts + 256 * j) * 16) = A5[j];
                }
                if (do_cv) { LAS float* scr = (LAS float*)(L + SB_END + pw * 8448);
                    if (cvi < NE * 1024) tr_finish(cv, D, 2048, (bf16_t*)(a.ws + WS_BGU) + (size_t)(cvi >> 10) * 2048 * D, RmGu(), scr, cvi & 1023, lane);
                    else { const int r_ = cvi - NE * 1024; tr_finish(cv, FF, D, (bf16_t*)(a.ws + WS_BD) + (size_t)(r_ >> 9) * D * FF, RmId(), scr, r_ & 511, lane); } }
            }
            __syncthreads();
            const int mb = w >> 2, nb = w & 3;
            if (ch >= 0) {
                const int t = ch * TC + tl; const int o = tl * 256 + 16 * q;
                const f32x4 kpv = *(const LAS f32x4*)(L + SB_KP + o), vv = *(const LAS f32x4*)(L + SB_V + o), gv = lds_bf4(L + SB_G + (ch & 1) * (TC * 128) + tl * 128 + 8 * q);
                const f32x4 y = *(const LAS f32x4*)(L + SB_Y + o);
                const f32x4 rv = lds_bf4(L + SB_RB + tl * 128 + 8 * q);
                const float mean = allsum16((y[0] + y[1]) + (y[2] + y[3])) * (1.0f / 64.0f);
                const f32x4 dv = y - mean;
                const float var = allsum16((dv[0] * dv[0] + dv[1] * dv[1]) + (dv[2] * dv[2] + dv[3] * dv[3])) * (1.0f / 64.0f);
                const float rstd = __builtin_amdgcn_rsqf(var + GN_EPS);
                const f32x4 c_rk = CQ[16 * 7], c_gw = CQ[16 * 8], c_gb = CQ[16 * 9];
                const float bonus = allsum16((rv[0] * kpv[0] * c_rk[0] + rv[1] * kpv[1] * c_rk[1]) + (rv[2] * kpv[2] * c_rk[2] + rv[3] * kpv[3] * c_rk[3]));
                const f32x4 ga = lds_bf4(L + SB_GA0 + (ch & 1) * (TC * 128) + tl * 128 + 8 * q);
                f32x4 ov;
#pragma unroll
                for (int j = 0; j < 4; ++j) ov[j] = ((dv[j] * rstd * c_gw[j] + c_gb[j]) + bonus * vv[j]) * gv[j] * ga[j];
                *(u32x2*)(Mo + (trow0 + t) * D + col4) = (u32x2){cvt_pk_bf16(ov[0], ov[1]), cvt_pk_bf16(ov[2], ov[3])};
            }
            if (ch + 1 < NCH) {
                {   f32x4 aw = (f32x4){0.f, 0.f, 0.f, 0.f}, aa = aw, ag = aw;
                    const LAS unsigned char* ap = L + SB_ALT + (16 * mb + fn) * 576 + kg * 16;
#pragma unroll
                    for (int sx = 0; sx < 9; ++sx) { const bf16x8 af = *(const LAS bf16x8*)(ap + sx * 64);
                        if (sx < 2) aw = __builtin_amdgcn_mfma_f32_16x16x32_bf16(Bw[sx], af, aw, 0, 0, 0);
                        else if (sx < 4) aa = __builtin_amdgcn_mfma_f32_16x16x32_bf16(Ba[sx - 2], af, aa, 0, 0, 0);
                        else ag = __builtin_amdgcn_mfma_f32_16x16x32_bf16(Bg[sx - 4], af, ag, 0, 0, 0); }
                    const int o = (16 * mb + fn) * 256 + (nb * 16 + 4 * kg) * 4;
                    const LAS f32x4* CW = (const LAS f32x4*)(F.lds + SB_CST) + (4 * nb + kg); const f32x4 c_w0 = CW[48], c_a0 = CW[64];
                    f32x4 cumv;
#pragma unroll
                    for (int r = 0; r < 4; ++r) { aw[r] = -0.60653066f * sigmoidf_(aw[r] + c_w0[r]);
                        aa[r] = sigmoidf_(aa[r] + c_a0[r]);
                        float x = aw[r]; x += dpp<0x111>(x); x += dpp<0x112>(x); x += dpp<0x114>(x); x += dpp<0x118>(x); cumv[r] = x; }
                    *(LAS f32x4*)(L + SB_WRAW + o) = aw; *(LAS f32x4*)(L + SB_ARAW + o) = aa; *(LAS f32x4*)(L + SB_CUMF + o) = cumv;
                    *(LAS u32x2*)(L + SB_G + ((ch + 1) & 1) * (TC * 128) + (16 * mb + fn) * 128 + (nb * 16 + 4 * kg) * 2) = (u32x2){cvt_pk_bf16(ag[0], ag[1]), cvt_pk_bf16(ag[2], ag[3])};
                }
                __syncthreads();
                {   const LAS unsigned char* rc = L + SB_RAWRKV + (tl + 1) * 384 + 8 * q; const LAS unsigned char* rp_ = rc - 384;
                    f32x4 r = lds_bf4(rc), k = lds_bf4(rc + 128), v = lds_bf4(rc + 256);
                    const f32x4 rp = lds_bf4(rp_), kp_ = lds_bf4(rp_ + 128), vp = lds_bf4(rp_ + 256);
                    const f32x4 tm_r = CQ[0], tm_k = CQ[16], tm_v = CQ[32], c_kk = CQ[80], c_ka = CQ[96];
                    r = r + (rp - r) * tm_r; k = k + (kp_ - k) * tm_k; v = v + (vp - v) * tm_v;
                    const int o = tl * 256 + 16 * q;
                    const f32x4 lw = *(const LAS f32x4*)(L + SB_WRAW + o), av = *(const LAS f32x4*)(L + SB_ARAW + o), cum = *(const LAS f32x4*)(L + SB_CUMF + o);
                    f32x4 kk, kpv, nbv; float ss = 0.f;
#pragma unroll
                    for (int j = 0; j < 4; ++j) { kk[j] = k[j] * c_kk[j]; ss += kk[j] * kk[j]; kpv[j] = k[j] * (1.0f + (av[j] - 1.0f) * c_ka[j]); }
                    ss = allsum16(ss);
                    const float inv = __builtin_amdgcn_rcpf(fmaxf(__builtin_amdgcn_sqrtf(ss), 1e-12f));
#pragma unroll
                    for (int j = 0; j < 4; ++j) { kk[j] *= inv; nbv[j] = -kk[j] * av[j]; }
                    f32x4 at, bt, kt, rt, p4;
#pragma unroll
                    for (int j = 0; j < 4; ++j) { const float P = __expf(cum[j]), iP = __builtin_amdgcn_rcpf(P), Pm1 = __expf(cum[j] - lw[j]);
                        at[j] = kk[j] * Pm1; bt[j] = nbv[j] * iP; kt[j] = kpv[j] * iP; rt[j] = r[j] * P; p4[j] = P; }
                    *(LAS u32x2*)(L + RC_AT + tl * 128 + 8 * q) = (u32x2){cvt_pk_bf16(at[0], at[1]), cvt_pk_bf16(at[2], at[3])};
                    *(LAS u32x2*)(L + RC_RT + tl * 128 + 8 * q) = (u32x2){cvt_pk_bf16(rt[0], rt[1]), cvt_pk_bf16(rt[2], rt[3])};
                    *(LAS u32x2*)(L + RC_BT + tl * 128 + 8 * q) = (u32x2){cvt_pk_bf16(bt[0], bt[1]), cvt_pk_bf16(bt[2], bt[3])};
                    *(LAS u32x2*)(L + RC_KT + tl * 128 + 8 * q) = (u32x2){cvt_pk_bf16(kt[0], kt[1]), cvt_pk_bf16(kt[2], kt[3])};
                    *(LAS u32x2*)(L + RC_VB + tl * 128 + 8 * q) = (u32x2){cvt_pk_bf16(v[0], v[1]), cvt_pk_bf16(v[2], v[3])};
                    if ((tl & 15) == 15) *(LAS f32x4*)(L + RC_P4 + ((tl >> 4) * 64 + 4 * q) * 4) = p4;
                    *(LAS u32x2*)(L + SB_RB + tl * 128 + 8 * q) = (u32x2){cvt_pk_bf16(r[0], r[1]), cvt_pk_bf16(r[2], r[3])};
                    *(LAS f32x4*)(L + SB_KP + o) = kpv; *(LAS f32x4*)(L + SB_V + o) = v;
                }
                __syncthreads();
                {   const int sub = w >> 2, mx = w & 3;
                    const LAS unsigned char* Ai = L + ((mx & 2) ? RC_RT : RC_AT) + (16 * sub + fn) * 128 + kg * 16; const LAS unsigned char* Bi = L + ((mx & 1) ? RC_KT : RC_BT) + (16 * sub + fn) * 128 + kg * 16;
                    const bf16x8 a0 = *(const LAS bf16x8*)(Ai), a1 = *(const LAS bf16x8*)(Ai + 64), b0 = *(const LAS bf16x8*)(Bi), b1 = *(const LAS bf16x8*)(Bi + 64);
                    f32x4 dt = __builtin_amdgcn_mfma_f32_16x16x32_bf16(b0, a0, (f32x4){0.f, 0.f, 0.f, 0.f}, 0, 0, 0);
                    dt = __builtin_amdgcn_mfma_f32_16x16x32_bf16(b1, a1, dt, 0, 0, 0);
                    if (mx != 0) {
#pragma unroll
                        for (int r = 0; r < 4; ++r) { const int s_ = 4 * kg + r; const bool keep = (mx < 2) ? (s_ < fn) : (s_ <= fn); dt[r] = keep ? dt[r] : 0.f; }
                        const u32x2 pk = (u32x2){cvt_pk_bf16(dt[0], dt[1]), cvt_pk_bf16(dt[2], dt[3])};
                        if (mx == 1) *(LAS u32x4*)(L + SB_LAKIMG + ((sub * 16 + fn) * 4 + kg) * 16) = (u32x4){pk.x, pk.y, 0u, 0u};
                        else *(LAS u32x2*)(L + SB_MRIMG + ((sub * 16 + fn) * 4 + kg) * 16 + ((mx == 3) ? 8 : 0)) = pk;
                    } else {
#define MM16(XT, Y, C) __builtin_amdgcn_mfma_f32_16x16x4f32((XT)[3], (Y)[3], __builtin_amdgcn_mfma_f32_16x16x4f32((XT)[2], (Y)[2], __builtin_amdgcn_mfma_f32_16x16x4f32((XT)[1], (Y)[1], \
                                       __builtin_amdgcn_mfma_f32_16x16x4f32((XT)[0], (Y)[0], (C), 0, 0, 0), 0, 0, 0), 0, 0, 0), 0, 0, 0)
                        f32x4 d = __builtin_amdgcn_mfma_f32_16x16x32_bf16(a0, b0, (f32x4){0.f, 0.f, 0.f, 0.f}, 0, 0, 0);
                        d = __builtin_amdgcn_mfma_f32_16x16x32_bf16(a1, b1, d, 0, 0, 0);
                        f32x4 Lm, Lt, T1, T1t; const f32x4 z4 = (f32x4){0.f, 0.f, 0.f, 0.f};
#pragma unroll
                        for (int r = 0; r < 4; ++r) { const int e_ = 4 * kg + r; Lm[r] = (fn < e_) ? d[r] : 0.f; Lt[r] = (e_ < fn) ? dt[r] : 0.f; const float id = (e_ == fn) ? 1.0f : 0.f; T1[r] = Lm[r] + id; T1t[r] = Lt[r] + id; }
                        const f32x4 X2 = MM16(Lt, Lm, z4), X2t = MM16(Lm, Lt, z4);
                        const f32x4 T2 = MM16(X2t, T1, T1), T2t = MM16(T1, X2t, T1t);
                        const f32x4 X4 = MM16(X2t, X2, z4), X4t = MM16(X2, X2t, z4);
                        const f32x4 T3 = MM16(X4t, T2, T2), T3t = MM16(T2, X4t, T2t);
                        const f32x4 X8t = MM16(X4, X4t, z4);
                        const f32x4 T4t = MM16(T3, X8t, T3t);
#undef MM16
                        *(LAS u32x4*)(L + SB_TIMG + ((sub * 16 + fn) * 4 + kg) * 16) = (u32x4){cvt_pk_bf16(T4t[0], T4t[1]), cvt_pk_bf16(T4t[2], T4t[3]), 0u, 0u};
                    }
                }
                __syncthreads();
            }
        }
    }
}

constexpr int VN_STRIDE = 272;
struct TrQ { u32x2 a[8], b[8]; };
__device__ __forceinline__ void p3_gmlp(Frame& F, const Args& a) {
    const bf16_t* Z = (const bf16_t*)(a.ws + WS_Z); const bf16_t* Mo = (const bf16_t*)(a.ws + WS_M); bf16_t* M2 = (bf16_t*)(a.ws + WS_M2);
    LAS unsigned char* VN = F.lds + RING_OFF;
    LAS f32x2* ST = (LAS f32x2*)(F.lds + RING_OFF + 128 * VN_STRIDE);
    LAS f32x2* SP = ST + 128;
    const int lane = ((int)(threadIdx.x & 63u)), w = F.wave, tid = ((int)threadIdx.x);
    const float* lng = a.in[I_LNVG]; const float* lnb = a.in[I_LNVB]; const float* wsp = a.in[I_WSP]; const float* bsp = a.in[I_BSP];
    for (int unit = F.bid; unit < NB_ * (SEQ / 128); unit += F.G) {
        const size_t t0 = (size_t)unit * 128;
#pragma unroll 4
        for (int rr = 0; rr < 16; ++rr) { const int j = 16 * w + rr;
            const bf16_t* p = Z + (t0 + j) * NZ2 + Z2_VG + 16 * lane; float c0[8], c1[8]; ld_bf8(p, c0); ld_bf8(p + 8, c1);
            float s = 0.f, s2 = 0.f;
#pragma unroll
            for (int i = 0; i < 8; ++i) { s += c0[i] + c1[i]; s2 += c0[i] * c0[i] + c1[i] * c1[i]; }
            s = allsum16(s); s2 = allsum16(s2);
            if ((lane & 15) == 0) SP[j * 4 + (lane >> 4)] = (f32x2){s, s2};
        }
        __syncthreads();
        if (tid < 128) { const f32x2 p0 = SP[tid * 4], p1 = SP[tid * 4 + 1], p2 = SP[tid * 4 + 2], p3 = SP[tid * 4 + 3];
            const float s = (p0.x + p1.x) + (p2.x + p3.x), s2 = (p0.y + p1.y) + (p2.y + p3.y);
            const float mean = s * (1.0f / 1024.0f), var = fmaxf(s2 * (1.0f / 1024.0f) - mean * mean, 0.f);
            ST[tid] = (f32x2){mean, __builtin_amdgcn_rsqf(var + LN_EPS)}; }
        __syncthreads();
        const int lr = tid >> 4, lc = tid & 15;
        u32x4 raw[4];
#pragma unroll
        for (int it = 0; it < 4; ++it) raw[it] = *(const u32x4*)(Z + (t0 + lr + 32 * it) * NZ2 + Z2_VG + lc * 8);
        for (int g = 0; g < 8; ++g) {
            {   const f32x4 g0 = *(const f32x4*)(lng + g * 128 + lc * 8), g1 = *(const f32x4*)(lng + g * 128 + lc * 8 + 4);
                const f32x4 b0 = *(const f32x4*)(lnb + g * 128 + lc * 8), b1 = *(const f32x4*)(lnb + g * 128 + lc * 8 + 4);
#pragma unroll
                for (int it = 0; it < 4; ++it) { const int j = lr + 32 * it; const f32x2 st = ST[j];
                    float c[8], o[8]; un8(raw[it], c);
#pragma unroll
                    for (int i = 0; i < 8; ++i) { const float gg = (i < 4) ? g0[i] : g1[i - 4], bb = (i < 4) ? b0[i] : b1[i - 4]; o[i] = (c[i] - st.x) * st.y * gg + bb; }
                    *(LAS bf16x8*)(VN + j * VN_STRIDE + lc * 16) = pack8(o); }
                if (g + 1 < 8) {
#pragma unroll
                    for (int it = 0; it < 4; ++it) raw[it] = *(const u32x4*)(Z + (t0 + lr + 32 * it) * NZ2 + Z2_VG + (g + 1) * 128 + lc * 8); }
            }
            __syncthreads();
            {   const int fi = lane & 15, kg = lane >> 4, i = 16 * w + fi, tq = fi >> 2, tp = fi & 3;
                f32x4 acc[8];
#pragma unroll
                for (int n = 0; n < 8; ++n) acc[n] = (f32x4){0.f, 0.f, 0.f, 0.f};
                const float* wrow = wsp + ((size_t)g * 128 + i) * 128;
                const unsigned trb = (unsigned)(size_t)(VN + (8 * kg + tq) * VN_STRIDE + tp * 16);
#pragma unroll
                for (int s = 0; s < 4; ++s) {
                    if (32 * s <= 16 * w + 15) {
                        const int jb = 32 * s + 8 * kg;
                        const f32x4 w0 = *(const f32x4*)(wrow + jb), w1 = *(const f32x4*)(wrow + jb + 4);
                        float m8[8];
#pragma unroll
                        for (int jj = 0; jj < 8; ++jj) { const float v = (jj < 4) ? w0[jj] : w1[jj - 4]; m8[jj] = (jb + jj <= i) ? v : 0.f; }
                        const bf16x8 wf = pack8(m8);
                        TrQ t;
                        const unsigned ad = trb + (unsigned)(32 * s * VN_STRIDE);
                        asm volatile(
                            "ds_read_b64_tr_b16 %0, %16 offset:0\n\tds_read_b64_tr_b16 %1, %16 offset:8\n\tds_read_b64_tr_b16 %2, %16 offset:64\n\tds_read_b64_tr_b16 %3, %16 offset:72\n\t"
                            "ds_read_b64_tr_b16 %4, %16 offset:128\n\tds_read_b64_tr_b16 %5, %16 offset:136\n\tds_read_b64_tr_b16 %6, %16 offset:192\n\tds_read_b64_tr_b16 %7, %16 offset:200\n\t"
                            "ds_read_b64_tr_b16 %8, %16 offset:1088\n\tds_read_b64_tr_b16 %9, %16 offset:1096\n\tds_read_b64_tr_b16 %10, %16 offset:1152\n\tds_read_b64_tr_b16 %11, %16 offset:1160\n\t"
                            "ds_read_b64_tr_b16 %12, %16 offset:1216\n\tds_read_b64_tr_b16 %13, %16 offset:1224\n\tds_read_b64_tr_b16 %14, %16 offset:1280\n\tds_read_b64_tr_b16 %15, %16 offset:1288\n\t"
                            "s_waitcnt lgkmcnt(0)"
                            : "=&v"(t.a[0]), "=&v"(t.a[1]), "=&v"(t.a[2]), "=&v"(t.a[3]), "=&v"(t.a[4]), "=&v"(t.a[5]), "=&v"(t.a[6]), "=&v"(t.a[7]),
                              "=&v"(t.b[0]), "=&v"(t.b[1]), "=&v"(t.b[2]), "=&v"(t.b[3]), "=&v"(t.b[4]), "=&v"(t.b[5]), "=&v"(t.b[6]), "=&v"(t.b[7])
                            : "v"(ad) : "memory");
#pragma unroll
                        for (int n = 0; n < 8; ++n) { const u32x4 vq = (u32x4){t.a[n].x, t.a[n].y, t.b[n].x, t.b[n].y};
                            acc[n] = __builtin_amdgcn_mfma_f32_16x16x32_bf16(__builtin_bit_cast(bf16x8, vq), wf, acc[n], 0, 0, 0); }
                    }
                }
                const float bs = bsp[g * 128 + i];
                const size_t trow = t0 + i;
#pragma unroll
                for (int u = 0; u < 4; ++u) { const int dcol = g * 128 + 32 * u + 8 * kg;
                    float uu[8], gb[8], mm[8], o[8];
                    ld_bf8(Z + trow * NZ2 + Z2_U + dcol, uu); ld_bf8(Z + trow * NZ2 + Z2_GB + dcol, gb); ld_bf8(Mo + trow * D + dcol, mm);
#pragma unroll
                    for (int r = 0; r < 4; ++r) { o[r] = mm[r] + uu[r] * (acc[2 * u][r] + bs) * gb[r]; o[4 + r] = mm[4 + r] + uu[4 + r] * (acc[2 * u + 1][r] + bs) * gb[4 + r]; }
                    *(bf16x8*)(M2 + trow * D + dcol) = pack8(o); }
            }
            __syncthreads();
        }
    }
}

__device__ __forceinline__ void p5_router(Frame& F, const Args& a) {
    const bf16_t* X2 = (const bf16_t*)(a.ws + WS_H); bf16_t* Hh = (bf16_t*)(a.ws + WS_H2);
    const bf16_t* Wh = (const bf16_t*)(a.ws + WS_MISC + MO_WRT); const bf16_t* Wl = Wh + NE * D;
    int* tok_of = (int*)(a.ws + WS_TOK); int* asg = (int*)(a.ws + WS_MISC + MO_ASG); float* gate = (float*)(a.ws + WS_MISC + MO_GATE);
    const float* g2 = a.in[I_N2G]; const float* br = a.in[I_BR];
    LAS float* LG = (LAS float*)(F.lds + RING_OFF) + F.wave * 512;
    LAS unsigned* LCNT = (LAS unsigned*)(F.lds + RING_OFF + 32768);
    LAS unsigned* LBASE = LCNT + 32;
    const int lane = ((int)(threadIdx.x & 63u)), w = F.wave, tid = ((int)threadIdx.x), fm = lane & 15, kg = lane >> 4;
    for (int blk = F.bid; blk < T / 128; blk += F.G) {
        if (tid < 32) LCNT[tid] = 0u;
        __syncthreads();
        const int tb = blk * 128 + 16 * w;
        const bf16_t* xr = X2 + (size_t)(tb + fm) * D + 8 * kg;
        float ss = 0.f;
        for (int s = 0; s < 32; ++s) { float x8[8]; ld_bf8(xr + 32 * s, x8);
            ss += (x8[0] * x8[0] + x8[1] * x8[1]) + (x8[2] * x8[2] + x8[3] * x8[3]) + (x8[4] * x8[4] + x8[5] * x8[5]) + (x8[6] * x8[6] + x8[7] * x8[7]); }
        ss += __shfl_xor(ss, 16); ss += __shfl_xor(ss, 32);
        const float rstd = __builtin_amdgcn_rsqf(ss * (1.0f / D) + RMS_EPS);
        f32x4 acc[2]; acc[0] = (f32x4){0.f, 0.f, 0.f, 0.f}; acc[1] = acc[0];
        bf16_t* hrow = Hh + (size_t)(tb + fm) * D + 8 * kg;
        u32x4 xq_n = *(const u32x4*)(xr); f32x4 ga_n = *(const f32x4*)(g2 + 8 * kg), gb_n = *(const f32x4*)(g2 + 8 * kg + 4);
        bf16x8 bh_n[2], bl_n[2];
#pragma unroll
        for (int n = 0; n < 2; ++n) { const size_t wo = (size_t)(16 * n + fm) * D + 8 * kg; bh_n[n] = *(const bf16x8*)(Wh + wo); bl_n[n] = *(const bf16x8*)(Wl + wo); }
        for (int s = 0; s < 32; ++s) {
            const u32x4 xq = xq_n; const f32x4 ga = ga_n, gb = gb_n; const bf16x8 bh[2] = {bh_n[0], bh_n[1]}, bl[2] = {bl_n[0], bl_n[1]};
            { const int s1 = (s + 1 < 32) ? s + 1 : 31;
              xq_n = *(const u32x4*)(xr + 32 * s1); ga_n = *(const f32x4*)(g2 + 32 * s1 + 8 * kg); gb_n = *(const f32x4*)(g2 + 32 * s1 + 8 * kg + 4);
#pragma unroll
              for (int n = 0; n < 2; ++n) { const size_t wo = (size_t)(16 * n + fm) * D + 32 * s1 + 8 * kg; bh_n[n] = *(const bf16x8*)(Wh + wo); bl_n[n] = *(const bf16x8*)(Wl + wo); } }
            const float x8[8] = {bf_lo(xq.x), bf_hi(xq.x), bf_lo(xq.y), bf_hi(xq.y), bf_lo(xq.z), bf_hi(xq.z), bf_lo(xq.w), bf_hi(xq.w)};
            float hv[8], lo[8];
#pragma unroll
            for (int j = 0; j < 4; ++j) { hv[j] = x8[j] * rstd * ga[j]; hv[4 + j] = x8[4 + j] * rstd * gb[j]; }
            u32x4 hp; hp.x = cvt_pk_bf16(hv[0], hv[1]); hp.y = cvt_pk_bf16(hv[2], hv[3]); hp.z = cvt_pk_bf16(hv[4], hv[5]); hp.w = cvt_pk_bf16(hv[6], hv[7]);
            *(u32x4*)(hrow + 32 * s) = hp;
            lo[0] = hv[0] - bf_lo(hp.x); lo[1] = hv[1] - bf_hi(hp.x); lo[2] = hv[2] - bf_lo(hp.y); lo[3] = hv[3] - bf_hi(hp.y);
            lo[4] = hv[4] - bf_lo(hp.z); lo[5] = hv[5] - bf_hi(hp.z); lo[6] = hv[6] - bf_lo(hp.w); lo[7] = hv[7] - bf_hi(hp.w);
            const bf16x8 ah = __builtin_bit_cast(bf16x8, hp), al = pack8(lo);
#pragma unroll
            for (int n = 0; n < 2; ++n) {
                acc[n] = __builtin_amdgcn_mfma_f32_16x16x32_bf16(bh[n], ah, acc[n], 0, 0, 0);
                acc[n] = __builtin_amdgcn_mfma_f32_16x16x32_bf16(bh[n], al, acc[n], 0, 0, 0);
                acc[n] = __builtin_amdgcn_mfma_f32_16x16x32_bf16(bl[n], ah, acc[n], 0, 0, 0); }
        }
#pragma unroll
        for (int n = 0; n < 2; ++n) { const f32x4 bb = *(const f32x4*)(br + 16 * n + 4 * kg); *(LAS f32x4*)(LG + fm * 32 + 16 * n + 4 * kg) = acc[n] + bb; }
        LDS_WAIT(); asm volatile("" ::: "memory");
        int se[4] = {0, 0, 0, 0}; unsigned sr[4] = {0u, 0u, 0u, 0u}; float sg[4] = {0.f, 0.f, 0.f, 0.f};
        if (lane < 16) {
            float lv[32];
#pragma unroll
            for (int e4 = 0; e4 < 8; ++e4) { const f32x4 v = *(LAS f32x4*)(LG + lane * 32 + 4 * e4); lv[4 * e4] = v.x; lv[4 * e4 + 1] = v.y; lv[4 * e4 + 2] = v.z; lv[4 * e4 + 3] = v.w; }
            float tv[4];
#pragma unroll
            for (int k = 0; k < 4; ++k) { float best = -3.0e38f; int bi = 0;
#pragma unroll
                for (int e = 0; e < 32; ++e) { const bool taken = (k > 0 && se[0] == e) || (k > 1 && se[1] == e) || (k > 2 && se[2] == e); if (!taken && lv[e] > best) { best = lv[e]; bi = e; } }
                se[k] = bi; tv[k] = best; }
            const float e1 = __expf(tv[1] - tv[0]), e2 = __expf(tv[2] - tv[0]), e3 = __expf(tv[3] - tv[0]); const float inv = 1.0f / (1.0f + e1 + e2 + e3);
            sg[0] = inv; sg[1] = e1 * inv; sg[2] = e2 * inv; sg[3] = e3 * inv;
#pragma unroll
            for (int k = 0; k < 4; ++k) sr[k] = atomicAdd((unsigned*)(LCNT + se[k]), 1u);
        }
        __syncthreads();
        if (tid < 32) LBASE[tid] = atomicAdd(F.ctl + CW_CNT + 64 * tid, (unsigned)LCNT[tid]);
        __syncthreads();
        if (lane < 16) { const int tok = tb + lane;
#pragma unroll
            for (int k = 0; k < 4; ++k) { const int pos = (int)(LBASE[se[k]] + sr[k]);
                tok_of[(size_t)se[k] * T + pos] = tok; asg[(size_t)tok * 8 + 2 * k] = se[k]; asg[(size_t)tok * 8 + 2 * k + 1] = pos; gate[(size_t)tok * 4 + k] = sg[k]; }
        }
        __syncthreads();
    }
}

__device__ __forceinline__ void moe_tables(Frame& F) {
    LAS int* cnt = (LAS int*)(F.lds + SCHED_OFF); LAS int* mts = cnt + 32;
    if (((int)threadIdx.x) == 0) { int acc = 0;
        for (int e = 0; e < NE; ++e) { const int c = (int)__hip_atomic_load(F.ctl + CW_CNT + 64 * e, RLX_AGENT); cnt[e] = c; mts[e] = acc; acc += (c + 255) >> 8; }
        mts[NE] = acc; }
    __syncthreads();
}
template <int NTN, bool GATH>
struct MoeOrder {
    static constexpr bool GATHER = GATH;
    LAS const int* cnt; LAS const int* mts; const char* A; const char* B; const int* tok_of; int G, c, Mtiles;
    __device__ void init(Frame& F, const void* A_, const void* B_, const int* tok) { cnt = (LAS const int*)(F.lds + SCHED_OFF); mts = cnt + 32; A = (const char*)A_; B = (const char*)B_; tok_of = tok; G = F.G; c = F.bid; Mtiles = mts[NE]; }
    __device__ bool next(int i, pg8::Unit& u) const {
        constexpr int MPS = 32 / NTN;
        int mt, nt_;
        if ((G & 7) == 0) { const int s = i * 8 + (c & 7), j = (c >> 3) + 0; const int per = G >> 3;
            if (per == 32) { mt = s * MPS + (j % MPS); nt_ = j / MPS; }
            else { const int L = i * G + c; mt = L / NTN; nt_ = L % NTN; } }
        else { const int L = i * G + c; mt = L / NTN; nt_ = L % NTN; }
        if (mt >= Mtiles) return false;
        int e = 0;
        for (int k = 1; k < NE; ++k) e += (mts[k] <= mt) ? 1 : 0;
        const int mloc = mt - mts[e];
        u.e = e; u.r0 = mt * 256; u.c0 = nt_ * 256; u.aux = mloc;
        u.B = B + ((size_t)e * NTN + nt_) * (256 * pg8::KK * 2);
        u.A = GATH ? A : A + (size_t)mt * (256 * pg8::KK * 2);
        return true;
    }
    __device__ __forceinline__ void a_offs(const pg8::Unit& u, unsigned (&ga)[2][2], const int (&R)[2], const int (&C)[2]) const {
        if constexpr (GATH) {
            const int n = cnt[u.e]; const int* tp = tok_of + (size_t)u.e * T + u.aux * 256;
            int tk[2][2];
#pragma unroll
            for (int h = 0; h < 2; ++h)
#pragma unroll
                for (int i = 0; i < 2; ++i) tk[h][i] = tp[h * 128 + R[i]];
            VM_WAIT();
#pragma unroll
            for (int h = 0; h < 2; ++h)
#pragma unroll
                for (int i = 0; i < 2; ++i) { const int t_ = (u.aux * 256 + h * 128 + R[i] < n) ? tk[h][i] : 0; ga[h][i] = (unsigned)(t_ * pg8::KK + C[i]) * 2u; }
        } else {
#pragma unroll
            for (int h = 0; h < 2; ++h)
#pragma unroll
                for (int i = 0; i < 2; ++i) ga[h][i] = (unsigned)((h * 128 + R[i]) * pg8::KK + C[i]) * 2u;
        }
    }
};

__device__ __forceinline__ void p8_final(Frame& F, const Args& a) {
    int ln_ = (int)threadIdx.x; asm volatile("" : "+v"(ln_)); ln_ &= 63;
    LAS const int* mts = (LAS const int*)(F.lds + SCHED_OFF) + 32;
    const bf16_t* YS = (const bf16_t*)(a.ws + WS_YS); const int* asg = (const int*)(a.ws + WS_MISC + MO_ASG); const float* gate = (const float*)(a.ws + WS_MISC + MO_GATE);
    float* out = a.out; const float* gf = a.in[I_NFG];
    const int gw = F.bid * NWAVES + F.wave, NGW = F.G * NWAVES;
    f32x4 gv[4];
#pragma unroll
    for (int j = 0; j < 4; ++j) gv[j] = *((const f32x4*)gf + ln_ + 64 * j);
    for (int m = gw; m < T; m += NGW) {
        f32x4* xr = (f32x4*)(out + (size_t)m * D) + ln_;
        const bf16_t* x2r = (const bf16_t*)(a.ws + WS_H) + (size_t)m * D + 4 * ln_;
        f32x4 v[4];
#pragma unroll
        for (int j = 0; j < 4; ++j) v[j] = ld_bf4(x2r + 256 * j);
#pragma unroll
        for (int k = 0; k < 4; ++k) { const int e = asg[(size_t)m * 8 + 2 * k], pos = asg[(size_t)m * 8 + 2 * k + 1]; const float gk = gate[(size_t)m * 4 + k];
            const bf16_t* yr = YS + ((size_t)mts[e] * 256 + pos) * D + 4 * ln_;
#pragma unroll
            for (int j = 0; j < 4; ++j) v[j] += gk * ld_bf4(yr + 256 * j); }
        float s = 0.f;
#pragma unroll
        for (int j = 0; j < 4; ++j) s += (v[j].x * v[j].x + v[j].y * v[j].y) + (v[j].z * v[j].z + v[j].w * v[j].w);
        const float rstd = __builtin_amdgcn_rsqf(wave_sum(s) * (1.f / D) + RMS_EPS);
#pragma unroll
        for (int j = 0; j < 4; ++j) xr[64 * j] = v[j] * rstd * gv[j];
    }
}

constexpr int N_PHASES = 10;
__global__ void __launch_bounds__(NWAVES * 64, 2) mk_fwd(Args args) {
    extern __shared__ __attribute__((aligned(16))) unsigned char lds[];
    Frame F;
    F.lds = (LAS unsigned char*)lds;
    F.MISC = (volatile LAS unsigned*)(F.lds + MISC_OFF);
    F.wave = __builtin_amdgcn_readfirstlane(((int)threadIdx.x) >> 6);
    F.G = gridDim.x; F.bid = blockIdx.x;
    F.ctl = (unsigned*)(args.ws + WS_CTL);
    for (int u = ((int)threadIdx.x); u < (LDS_BYTES - LDSCTL_OFF) / 4; u += NWAVES * 64) ((LAS unsigned*)(F.lds + LDSCTL_OFF))[u] = 0u;
    __syncthreads();
    const int lo = args.ph_lo, hi = args.ph_hi;
    const bool multi = (hi - lo) > 1;
    XcdBarrier bar; bar.bar = F.ctl + CW_BAR; bar.x = 0; bar.st = nullptr;
    if (multi) bar = xcd_barrier_post(F.ctl + CW_BAR, F.MISC + 8);
#define IN(k) (lo <= (k) && (k) < hi)
#define SEAM(k) do { if (IN(k) && IN((k) + 1)) xcd_barrier(bar); } while (0)
    unsigned char* ws = args.ws;

#define P1_BODY {     \
        pg8::StaticOrder S; S.init(ws + WS_H, ws + WS_BIN, T, NZ, F.G, F.bid); S.wgm = P1_WGM; \
        pg8::EpiZ E{(bf16_t*)(ws + WS_Z), (const float*)(ws + WS_MISC + MO_BIASZ), (bf16_t*)(ws + WS_HM)}; \
        pg8::gemm_phase<pg8::EpiZ, pg8::StaticOrder, true>(F.lds + RING_OFF, S, E); }
#define P4_BODY {     \
        pg8::StaticOrder S; S.init(ws + WS_M2, ws + WS_BOUT, T, D, F.G, F.bid); \
        pg8::EpiRes E{(bf16_t*)(ws + WS_H), args.in[I_X]}; \
        pg8::gemm_phase<pg8::EpiRes, pg8::StaticOrder, true>(F.lds + RING_OFF, S, E); }
#define P6_BODY {     \
        moe_tables(F); \
        MoeOrder<8, true> S; S.init(F, ws + WS_H2, ws + WS_BGU, (const int*)(ws + WS_TOK)); \
        pg8::EpiSwiglu E{(bf16_t*)(ws + WS_ACT), (const float*)(ws + WS_MISC + MO_BGU)}; \
        pg8::gemm_phase<pg8::EpiSwiglu, MoeOrder<8, true>, true>(F.lds + RING_OFF, S, E); }
#define P7_BODY {     \
        moe_tables(F); \
        MoeOrder<4, false> S; S.init(F, ws + WS_ACT, ws + WS_BD, nullptr); \
        pg8::EpiDown E{(bf16_t*)(ws + WS_YS), args.in[I_BDN]}; \
        pg8::gemm_phase<pg8::EpiDown, MoeOrder<4, false>, true>(F.lds + RING_OFF, S, E); }
    if (IN(0)) { p0_prologue(F, args); if (PROBE_REP == 0) p0_prologue(F, args); SEAM(0); }
    if (IN(1)) { P1_BODY if (PROBE_REP == 1) P1_BODY SEAM(1); }
    if (IN(2)) { p2a_act(F, args); SEAM(2); }
    if (IN(3)) { p2_scan(F, args); if (PROBE_REP == 2) p2_scan(F, args); SEAM(3); }
    if (IN(4)) { for (int rep_ = 0; rep_ < (PROBE_REP == 3 ? 2 : 1); ++rep_) p3_gmlp(F, args); SEAM(4); }
    if (IN(5)) { P4_BODY if (PROBE_REP == 4) P4_BODY SEAM(5); }
    if (IN(6)) { p5_router(F, args); SEAM(6); }
    if (IN(7)) { P6_BODY if (PROBE_REP == 6) P6_BODY SEAM(7); }
    if (IN(8)) { P7_BODY if (PROBE_REP == 7) P7_BODY SEAM(8); }
    if (IN(9)) { moe_tables(F); p8_final(F, args); }
#undef IN
#undef SEAM
}

extern "C" void kernel_launch(void* const* d_in, const int* in_sizes, int n_in, void* d_out, int out_size, void* d_ws, size_t ws_size, hipStream_t stream) {
    static int grid = 0;
    if (grid == 0) {
        if (n_in != 28 || out_size != T * D || ws_size < WS_END) { fprintf(stderr, "kernel_launch: unexpected problem (n_in %d, out %d, ws %zu); nothing launched\n", n_in, out_size, ws_size); grid = -1; return; }
        int dev = 0, cus = 0, per_cu = 0;
        if (hipGetDevice(&dev) != hipSuccess || hipDeviceGetAttribute(&cus, hipDeviceAttributeMultiprocessorCount, dev) != hipSuccess) { grid = -1; return; }
        if (hipFuncSetAttribute((const void*)mk_fwd, hipFuncAttributeMaxDynamicSharedMemorySize, LDS_BYTES) != hipSuccess) { fprintf(stderr, "kernel_launch: hipFuncSetAttribute failed\n"); grid = -1; return; }
        if (hipOccupancyMaxActiveBlocksPerMultiprocessor(&per_cu, (const void*)mk_fwd, NWAVES * 64, LDS_BYTES) != hipSuccess || per_cu < 1)
            fprintf(stderr, "kernel_launch: note: occupancy query reports %d workgroups per CU\n", per_cu);
        (void)hipGetLastError();
        grid = cus;
    }
    if (grid < 0) return;
    if (hipMemsetAsync((char*)d_ws + WS_CTL, 0, CTL_ZERO_BYTES, stream) != hipSuccess) return;
    Args a{};
    for (int i = 0; i < 28; ++i) a.in[i] = (const float*)d_in[i];
    a.out = (float*)d_out; a.ws = (unsigned char*)d_ws;
    if (MK_N_LAUNCHES == 1) { a.ph_lo = 0; a.ph_hi = N_PHASES; hipLaunchKernelGGL(mk_fwd, dim3(grid), dim3(NWAVES * 64), LDS_BYTES, stream, a); }
    else for (int p = 0; p < N_PHASES; ++p) { a.ph_lo = p; a.ph_hi = p + 1; hipLaunchKernelGGL(mk_fwd, dim3(grid), dim3(NWAVES * 64), LDS_BYTES, stream, a); }
}
```

```cpp
#include <hip/hip_runtime.h>
#include <cstdio>
#include <cstdint>

#ifndef MK_N_LAUNCHES
#define MK_N_LAUNCHES 1
#endif

#ifndef P1_WGM
#define P1_WGM 4
#endif
#ifndef SCAN_PREFETCH
#define SCAN_PREFETCH 0
#endif
#ifndef PROBE_REP
#define PROBE_REP -1
#endif
#define GAS __attribute__((address_space(1)))
#define LAS __attribute__((address_space(3)))
typedef unsigned short bf16_t;
typedef short bf16x8 __attribute__((ext_vector_type(8)));
typedef float f32x4 __attribute__((ext_vector_type(4)));
typedef float f32x2 __attribute__((ext_vector_type(2)));
typedef unsigned u32x4 __attribute__((ext_vector_type(4)));
typedef unsigned u32x2 __attribute__((ext_vector_type(2)));
typedef int i32x4 __attribute__((ext_vector_type(4)));
typedef int i32x8 __attribute__((ext_vector_type(8)));

constexpr int NB_ = 16, SEQ = 2048, D = 1024, T = NB_ * SEQ;
constexpr int NH = 16, HD = 64;
constexpr int NZ = 7680;
constexpr int ZC_R = 0, ZC_K = 1024, ZC_V = 2048, ZC_L = 3072, ZC_U = 3584, ZC_VG = 4608, ZC_GA = 5632, ZC_GB = 6656;
constexpr int NZ2 = 3584, Z2_L = 0, Z2_U = 512, Z2_VG = 1536, Z2_GB = 2560;
constexpr int TM_R = 0, TM_K = 1024, TM_V = 2048, TM_DL = 3072, TM_AL = 3136, TM_GL = 3200;
constexpr int NE = 32, TOPK = 4, FF = 1024;
constexpr int NSLOT_MAX = T * TOPK + NE * 256;
constexpr float RMS_EPS = 1e-5f, GN_EPS = 64e-5f, LN_EPS = 1e-5f;

constexpr size_t MiB = 1u << 20;
constexpr size_t WS_CTL = 0, CTL_ZERO_BYTES = 1 * MiB;
constexpr size_t WS_BIN = 2 * MiB;
constexpr size_t WS_BOUT = 18 * MiB;
constexpr size_t WS_BGU = 20 * MiB;
constexpr size_t WS_BD = 148 * MiB;
constexpr size_t WS_MISC = 212 * MiB;
constexpr size_t WS_TOK = 216 * MiB;
constexpr size_t WS_H = 220 * MiB;
constexpr size_t WS_HM = 284 * MiB;
constexpr size_t WS_Z = 540 * MiB;
constexpr size_t WS_M = 764 * MiB;
constexpr size_t WS_M2 = 828 * MiB;
constexpr size_t WS_H2 = 892 * MiB;
constexpr size_t WS_AL = 956 * MiB;
constexpr size_t WS_END = 976 * MiB;
constexpr size_t WS_ACT = WS_HM;
constexpr size_t WS_YS = WS_HM + 272 * MiB;
static_assert((size_t)NSLOT_MAX * FF * 2 == 272 * MiB && WS_YS + 272 * MiB == WS_M2, "ws map");
constexpr size_t MO_BIASZ = 0;
constexpr size_t MO_BGU = 64 * 1024;
constexpr size_t MO_WRT = 512 * 1024;
constexpr size_t MO_ASG = 1 * MiB;
constexpr size_t MO_GATE = 2 * MiB;
constexpr size_t MO_LT = 3 * MiB;
constexpr int CW_TMO = 0, CW_CODE = 1;
constexpr int CW_BAR = 4096;
constexpr int CW_CNT = 8192;

constexpr int RING_OFF = 0, RING_BYTES = 131072;
constexpr int LDSCTL_OFF = 159232, MISC_OFF = LDSCTL_OFF + 320;
constexpr int SCHED_OFF = LDSCTL_OFF + 1024;
constexpr int LDS_BYTES = 163840;
constexpr int EPI_T_OFF = RING_OFF + RING_BYTES, EPI_T_WAVE = 2304;
static_assert(EPI_T_OFF + 8 * EPI_T_WAVE <= LDSCTL_OFF, "LDS");
constexpr int NWAVES = 8;

#define RLX_AGENT __ATOMIC_RELAXED, __HIP_MEMORY_SCOPE_AGENT
#define LDS_WAIT() asm volatile("s_waitcnt lgkmcnt(0)" ::: "memory")
#define VM_WAIT() asm volatile("s_waitcnt vmcnt(0)" ::: "memory")
typedef __bf16 bf16x2_t __attribute__((ext_vector_type(2)));
typedef short s16x4 __attribute__((ext_vector_type(4)));
__device__ __forceinline__ unsigned cvt_pk_bf16(float lo, float hi) { bf16x2_t v; v.x = (__bf16)lo; v.y = (__bf16)hi; return __builtin_bit_cast(unsigned, v); }
constexpr float W8_SCALE = 64.0f, W8_INV = 1.0f / 64.0f;
__device__ __forceinline__ float clamp448(float x) { return fminf(fmaxf(x, -448.0f), 448.0f); }
__device__ __forceinline__ unsigned cvt_pk4_fp8(float a, float b, float c, float d) {
    int w = __builtin_amdgcn_cvt_pk_fp8_f32(a, b, 0, false); w = __builtin_amdgcn_cvt_pk_fp8_f32(c, d, w, true); return (unsigned)w; }
__device__ __forceinline__ float bf_lo(unsigned u) { return __builtin_bit_cast(float, u << 16); }
__device__ __forceinline__ float bf_hi(unsigned u) { return __builtin_bit_cast(float, u & 0xffff0000u); }
__device__ __forceinline__ float bf2f(bf16_t b) { return __builtin_bit_cast(float, ((unsigned)b) << 16); }
template <int CTRL> __device__ __forceinline__ float dpp(float x) { return __builtin_bit_cast(float, __builtin_amdgcn_mov_dpp(__builtin_bit_cast(int, x), CTRL, 0xf, 0xf, true)); }
__device__ __forceinline__ float allsum16(float x) {
    x += dpp<0xB1>(x); x += dpp<0x4E>(x); x += dpp<0x141>(x); x += dpp<0x140>(x); return x;
}
__device__ __forceinline__ float wave_sum(float v) {
#pragma unroll
    for (int o = 1; o < 64; o <<= 1) v += __shfl_xor(v, o);
    return v;
}
__device__ __forceinline__ float sigmoidf_(float x) { return __builtin_amdgcn_rcpf(1.0f + __expf(-x)); }
__device__ __forceinline__ f32x2 gelu_pk(f32x2 v) {
    const f32x2 av = __builtin_elementwise_abs(v), d = av * 0.2316418882f + 1.0f;
    f32x2 t; t.x = __builtin_amdgcn_rcpf(d.x); t.y = __builtin_amdgcn_rcpf(d.y);
    f32x2 q = t * 0.5307027145f + (-0.7265760135f); q = q * t + 0.7107068705f; q = q * t + (-0.142248368f); q = q * t + 0.127414796f; q = q * t;
    const f32x2 s = (v * v) * (-0.72134752044f);
    f32x2 e; e.x = __builtin_amdgcn_exp2f(s.x); e.y = __builtin_amdgcn_exp2f(s.y);
    const f32x2 m = v * (q * e), r = v - m;
    f32x2 o; o.x = v.x < 0.f ? m.x : r.x; o.y = v.y < 0.f ? m.y : r.y; return o;
}

namespace pg8 {
constexpr int BM = 256, BK = 64, HALF = 128, HTB = HALF * BK * 2, STAGE_BYTES = 8 * HTB, NXCD = 8, WGM = 8;
constexpr int KK = 1024;
__host__ __device__ __forceinline__ int lds_byte(int r, int c) { const int st = (r >> 4) * 2 + (c >> 5), rr = r & 15, cc = c & 31, ob = rr * 64 + cc * 2; return st * 1024 + (ob ^ (((ob >> 9) & 1) << 5)); }
__host__ __device__ __forceinline__ void stage_rc(int b, int& R, int& C) { const int st = b / 1024, sb = b % 1024, swz = sb ^ (((sb >> 9) & 1) << 5); R = (st >> 1) * 16 + swz / 64; C = (st & 1) * 32 + (swz % 64) / 2; }
__host__ __device__ __forceinline__ int perm32(int rho) { const int n = rho >> 4, i = rho & 15; return 8 * (i >> 2) + 4 * n + (i & 3); }

struct Unit { const char* A; const char* B; int r0, c0, e, aux; };

struct StaticOrder {
    const char* A; const char* B; int nM, nN, nwg, G, c, wgm = WGM;
    static constexpr bool GATHER = false;
    __device__ void init(const void* A_, const void* B_, int M, int N, int G_, int c_) { A = (const char*)A_; B = (const char*)B_; nM = M / BM; nN = N / BM; nwg = nM * nN; G = G_; c = c_; }
    __device__ bool next(int i, Unit& u) const {
        const long L = (long)i * G + c; if (L >= nwg) return false;
        int wgid = (int)L; { const int q = nwg / NXCD, r = nwg % NXCD, xcd = wgid % NXCD, off = wgid / NXCD; wgid = (xcd < r ? xcd * (q + 1) : r * (q + 1) + (xcd - r) * q) + off; }
        const int nig = wgm * nN, gid = wgid / nig, fm = gid * wgm, gsz = (nM - fm) < wgm ? (nM - fm) : wgm;
        const int pm = fm + ((wgid % nig) % gsz), pn = (wgid % nig) / gsz;
        u.A = A + (size_t)pm * (BM * KK * 2); u.B = B + (size_t)pn * (BM * KK * 2); u.r0 = pm * BM; u.c0 = pn * BM; u.e = 0; u.aux = 0; return true;
    }
    __device__ __forceinline__ void a_offs(const Unit&, unsigned (&ga)[2][2], const int (&R)[2], const int (&C)[2]) const {
#pragma unroll
        for (int h = 0; h < 2; ++h)
#pragma unroll
            for (int i = 0; i < 2; ++i) ga[h][i] = (unsigned)((h * HALF + R[i]) * KK + C[i]) * 2u;
    }
};

template <class Epi, class Sched, bool ALIGN_EPI = false>
__device__ __forceinline__ void gemm_phase(LAS unsigned char* lds, const Sched& S, const Epi& E) {
    const int tid = threadIdx.x, wid = __builtin_amdgcn_readfirstlane(tid >> 6), lane = tid & 63, wr = wid >> 2, wc = wid & 3, fr = lane & 15, fq = lane >> 4;
    constexpr bool F8 = Epi::F8;
    constexpr int K = KK, ROWB = F8 ? K : 2 * K, nt = ROWB / (BK * 2);
    unsigned voffB[2]; int Rr[2], Cc[2];
#pragma unroll
    for (int i = 0; i < 2; ++i) { int R, C; stage_rc(tid * 16 + i * 8192, R, C); const int Rb = Epi::PERM == 2 ? (64 * (R >> 5) + perm32(R & 31)) : (Epi::PERM == 1 ? ((R & ~31) + perm32(R & 31)) : R);
        Rr[i] = R; Cc[i] = C; voffB[i] = (unsigned)(Rb * ROWB + C * 2); }
    const size_t kstep = (size_t)(BK * 2);
    const size_t hstep = (size_t)(Epi::PERM == 2 ? 32 : HALF) * ROWB;
    const unsigned ldsw = (unsigned)wid * 1024u;
    const int aoff = F8 ? lds_byte(wr * 64 + fr, fq * 16) : lds_byte(wr * 64 + fr, fq * 8), boff = F8 ? lds_byte(wc * 32 + fr, fq * 16) : lds_byte(wc * 32 + fr, fq * 8);
    constexpr int KOFF = F8 ? 16 : 1024;
#define PG8_SA(b, h) (((b) * 2 + (h)) * HTB)
#define PG8_SB(b, h) ((4 + (b) * 2 + (h)) * HTB)
#define PG8_STAGE(bufoff, gbase, voff) do { _Pragma("unroll") for (int _i = 0; _i < 2; ++_i) \
        __builtin_amdgcn_global_load_lds((const unsigned*)((const char*)(gbase) + (voff)[_i]), (LAS unsigned*)(lds + (bufoff) + ldsw + _i * 8192), 16, 0, 0); } while (0)
#define PG8_LDA(dst, b, h) do { _Pragma("unroll") for (int m = 0; m < 4; ++m) _Pragma("unroll") for (int k = 0; k < 2; ++k) dst[m][k] = *(const LAS bf16x8*)(lds + PG8_SA(b, h) + aoff + m * 2048 + k * KOFF); } while (0)
#define PG8_LDB(dst, b, h) do { _Pragma("unroll") for (int n = 0; n < 2; ++n) _Pragma("unroll") for (int k = 0; k < 2; ++k) dst[n][k] = *(const LAS bf16x8*)(lds + PG8_SB(b, h) + boff + n * 2048 + k * KOFF); } while (0)
#define PG8_CAT8(x) __builtin_shufflevector(__builtin_bit_cast(i32x4, (x)[0]), __builtin_bit_cast(i32x4, (x)[1]), 0, 1, 2, 3, 4, 5, 6, 7)
#define PG8_MMA(ai, bj, At, Bt) do { __builtin_amdgcn_s_setprio(1); _Pragma("unroll") for (int m = 0; m < 4; ++m) _Pragma("unroll") for (int n = 0; n < 2; ++n) { \
        if constexpr (F8) { const i32x8 b8_ = PG8_CAT8(Bt[n]), a8_ = PG8_CAT8(At[m]);     \
            asm volatile("v_mfma_f32_16x16x128_f8f6f4 %0, %1, %2, %0" : "+v"(acc[ai][bj][m][n]) : "v"(b8_), "v"(a8_)); } \
        else { _Pragma("unroll") for (int k = 0; k < 2; ++k) acc[ai][bj][m][n] = __builtin_amdgcn_mfma_f32_16x16x32_bf16(Bt[n][k], At[m][k], acc[ai][bj][m][n], 0, 0, 0); } } __builtin_amdgcn_s_setprio(0); } while (0)
#define PG8_WAIT_V(n) asm volatile("s_waitcnt vmcnt(" #n ")" ::: "memory")
#define PG8_WAIT_L(n) asm volatile("s_waitcnt lgkmcnt(" #n ")" ::: "memory")
#define PG8_BAR __builtin_amdgcn_s_barrier()
#define PG8_SCHED __builtin_amdgcn_sched_barrier(0)
    Unit cur, nxt; int ui = 0;
    if (!S.next(0, cur)) return;
    f32x4 acc[2][2][4][2];
#pragma unroll
    for (int a = 0; a < 2; ++a)
#pragma unroll
        for (int b = 0; b < 2; ++b)
#pragma unroll
            for (int m = 0; m < 4; ++m)
#pragma unroll
                for (int n = 0; n < 2; ++n) acc[a][b][m][n] = (f32x4){0.f, 0.f, 0.f, 0.f};
    bf16x8 At[4][2], B0[2][2], B1[2][2];
    unsigned ga[2][2], gn[2][2];
    S.a_offs(cur, ga, Rr, Cc);
    const char* cA = cur.A; const char* cB = cur.B;
    PG8_STAGE(PG8_SB(0, 0), cB, voffB); PG8_STAGE(PG8_SB(0, 1), cB + hstep, voffB); PG8_STAGE(PG8_SA(0, 0), cA, ga[0]); PG8_STAGE(PG8_SA(0, 1), cA, ga[1]);
    if (wr == 1) PG8_BAR;
    PG8_WAIT_V(2); PG8_BAR;
    PG8_STAGE(PG8_SB(1, 0), cB + kstep, voffB); PG8_STAGE(PG8_SA(1, 0), cA + kstep, ga[0]); PG8_STAGE(PG8_SB(1, 1), cB + hstep + kstep, voffB);
    PG8_WAIT_V(6); PG8_BAR;
    for (;;) {
        const bool has_next = S.next(ui + 1, nxt);
        const char* nA = has_next ? nxt.A : cA; const char* nB = has_next ? nxt.B : cB;
#pragma unroll
        for (int h = 0; h < 2; ++h)
#pragma unroll
            for (int i = 0; i < 2; ++i) gn[h][i] = ga[h][i];
#pragma unroll 1
        for (int t = 0; t < nt; t += 2) {
            const bool last = (t == nt - 2);
            if (Sched::GATHER && last && has_next) S.a_offs(nxt, gn, Rr, Cc);
            const char* a1 = cA + (size_t)(t + 1) * kstep;
            const char* a2 = last ? nA : cA + (size_t)(t + 2) * kstep; const char* b2 = last ? nB : cB + (size_t)(t + 2) * kstep;
            const char* a3 = a2 + kstep; const char* b3 = b2 + kstep;
            unsigned g2[2][2];
#pragma unroll
            for (int h = 0; h < 2; ++h)
#pragma unroll
                for (int i = 0; i < 2; ++i) g2[h][i] = last ? gn[h][i] : ga[h][i];
            PG8_LDB(B0, 0, 0); PG8_LDB(B1, 0, 1); PG8_SCHED; PG8_LDA(At, 0, 0); PG8_STAGE(PG8_SA(1, 1), a1, ga[1]);
            PG8_WAIT_V(8); PG8_WAIT_L(0); PG8_BAR; PG8_MMA(0, 0, At, B0); PG8_MMA(0, 1, At, B1); PG8_BAR; PG8_SCHED;
            PG8_LDA(At, 0, 1); PG8_STAGE(PG8_SB(0, 0), b2, voffB); PG8_STAGE(PG8_SB(0, 1), b2 + hstep, voffB); PG8_STAGE(PG8_SA(0, 0), a2, g2[0]);
            PG8_WAIT_V(8); PG8_WAIT_L(0); PG8_BAR; PG8_MMA(1, 0, At, B0); PG8_MMA(1, 1, At, B1); PG8_BAR; PG8_SCHED;
            PG8_LDB(B0, 1, 0); PG8_LDB(B1, 1, 1); PG8_SCHED; PG8_LDA(At, 1, 0); PG8_STAGE(PG8_SA(0, 1), a2, g2[1]);
            PG8_WAIT_V(8); PG8_WAIT_L(0); PG8_BAR; PG8_MMA(0, 0, At, B0); PG8_MMA(0, 1, At, B1); PG8_BAR; PG8_SCHED;
            PG8_LDA(At, 1, 1); PG8_STAGE(PG8_SB(1, 0), b3, voffB); PG8_STAGE(PG8_SB(1, 1), b3 + hstep, voffB); PG8_STAGE(PG8_SA(1, 0), a3, g2[0]);
            PG8_WAIT_V(8); PG8_WAIT_L(0); PG8_BAR; PG8_MMA(1, 0, At, B0); PG8_MMA(1, 1, At, B1); PG8_BAR; PG8_SCHED;
        }
        if constexpr (ALIGN_EPI) { if (wr == 0) PG8_BAR; }
        { int te_ = threadIdx.x; asm volatile("" : "+v"(te_));
          E(acc, cur, wr, wc, te_ & 15, (te_ >> 4) & 3, lds + EPI_T_OFF + wid * EPI_T_WAVE); }
        if (!has_next) break;
#pragma unroll
        for (int a = 0; a < 2; ++a)
#pragma unroll
            for (int b = 0; b < 2; ++b)
#pragma unroll
                for (int m = 0; m < 4; ++m)
#pragma unroll
                    for (int n = 0; n < 2; ++n) acc[a][b][m][n] = (f32x4){0.f, 0.f, 0.f, 0.f};
        cur = nxt; cA = nA; cB = nB; ++ui;
#pragma unroll
        for (int h = 0; h < 2; ++h)
#pragma unroll
            for (int i = 0; i < 2; ++i) ga[h][i] = gn[h][i];
        if constexpr (ALIGN_EPI) { if (wr == 1) PG8_BAR; }
    }
    PG8_WAIT_V(0);
    if constexpr (!ALIGN_EPI) { if (wr == 0) PG8_BAR; }
    PG8_BAR;
#undef PG8_SA
#undef PG8_SB
#undef PG8_STAGE
#undef PG8_LDA
#undef PG8_LDB
#undef PG8_MMA
#undef PG8_CAT8
#undef PG8_WAIT_V
#undef PG8_WAIT_L
#undef PG8_BAR
#undef PG8_SCHED
}

#define EPI_CBAR() asm volatile("" ::: "memory")

struct EpiZ {
    static constexpr int PERM = 2; static constexpr bool F8 = false;
    bf16_t* O; const float* bias; bf16_t* HM;
    __device__ __forceinline__ void operator()(const f32x4 (&acc)[2][2][4][2], const Unit& u, int wr, int wc, int fr, int fq, LAS unsigned char* tl) const {
        const int col0 = u.c0 + wc * 64 + 8 * fq, lane = fr + 16 * fq;
        const int mode = (u.c0 < ZC_U) ? 0 : (u.c0 < ZC_GA ? 1 : 2);
        const bool hm = (u.c0 < ZC_L) || (u.c0 >= ZC_GA && u.c0 < ZC_GB);
        f32x4 bv[2][2];
#pragma unroll
        for (int bj = 0; bj < 2; ++bj)
#pragma unroll
            for (int n = 0; n < 2; ++n) bv[bj][n] = *(const f32x4*)(bias + col0 + bj * 32 + 4 * n);
        LAS unsigned char* wp = tl + fr * 144 + fq * 16; LAS const unsigned char* rp = tl + (lane >> 3) * 144 + (lane & 7) * 16;
        bf16_t* gp; int rs;
        if (hm) { const int xi = (u.c0 < ZC_L) ? (u.c0 >> 10) : 3, h0 = (((u.c0 < ZC_L) ? (u.c0 & 1023) : (u.c0 - ZC_GA)) >> 6) + wc, b = u.r0 >> 11, t = (u.r0 & 2047) + wr * 64 + (lane >> 3);
            gp = HM + ((size_t)((b * NH + h0) * SEQ + t)) * 256 + xi * 64 + (lane & 7) * 8; rs = 256; }
        else { const int c2 = (u.c0 < ZC_GA) ? u.c0 - ZC_L : u.c0 - ZC_GB + Z2_GB; gp = O + (size_t)(u.r0 + wr * 64 + (lane >> 3)) * NZ2 + c2 + wc * 64 + (lane & 7) * 8; rs = NZ2; }
#pragma unroll
        for (int ai = 0; ai < 2; ++ai)
#pragma unroll
            for (int m = 0; m < 4; ++m) {
#pragma unroll
                for (int bj = 0; bj < 2; ++bj) { f32x4 v0 = acc[ai][bj][m][0] + bv[bj][0], v1 = acc[ai][bj][m][1] + bv[bj][1];
                    if (mode == 1) { f32x2 a = gelu_pk((f32x2){v0[0], v0[1]}), b = gelu_pk((f32x2){v0[2], v0[3]}), c = gelu_pk((f32x2){v1[0], v1[1]}), d = gelu_pk((f32x2){v1[2], v1[3]});
                        v0 = (f32x4){a.x, a.y, b.x, b.y}; v1 = (f32x4){c.x, c.y, d.x, d.y}; }
                    else if (mode == 2) {
#pragma unroll
                        for (int j = 0; j < 4; ++j) { v0[j] = sigmoidf_(v0[j]); v1[j] = sigmoidf_(v1[j]); } }
                    u32x4 w; w.x = cvt_pk_bf16(v0[0], v0[1]); w.y = cvt_pk_bf16(v0[2], v0[3]); w.z = cvt_pk_bf16(v1[0], v1[1]); w.w = cvt_pk_bf16(v1[2], v1[3]);
                    *(LAS u32x4*)(wp + bj * 64) = w; }
                EPI_CBAR();
#pragma unroll
                for (int p = 0; p < 2; ++p) { const u32x4 t = *(LAS const u32x4*)(rp + p * 8 * 144); __builtin_nontemporal_store(t, (u32x4*)(gp + (size_t)((ai * HALF + m * 16 + 8 * p) * rs))); }
                EPI_CBAR(); }
    }
};
struct EpiRes {
    static constexpr int PERM = 2; static constexpr bool F8 = false;
    bf16_t* C; const float* base;
    __device__ __forceinline__ void operator()(const f32x4 (&acc)[2][2][4][2], const Unit& u, int wr, int wc, int fr, int fq, LAS unsigned char* tl) const {
        const int lane = fr + 16 * fq;
        LAS unsigned char* wp = tl + fr * 144 + fq * 16; LAS const unsigned char* rp = tl + (lane >> 3) * 144 + (lane & 7) * 16;
        const size_t go = (size_t)(u.r0 + wr * 64 + (lane >> 3)) * D + u.c0 + wc * 64 + (lane & 7) * 8;
        f32x4 xa[2][2];
#pragma unroll
        for (int ai = 0; ai < 2; ++ai)
#pragma unroll
            for (int m = 0; m < 4; ++m) {
#pragma unroll
                for (int p = 0; p < 2; ++p) { const size_t o = go + (size_t)(ai * HALF + m * 16 + 8 * p) * D; xa[p][0] = *(const f32x4*)(base + o); xa[p][1] = *(const f32x4*)(base + o + 4); }
#pragma unroll
                for (int bj = 0; bj < 2; ++bj) { const f32x4 v0 = acc[ai][bj][m][0], v1 = acc[ai][bj][m][1];
                    u32x4 w; w.x = cvt_pk_bf16(v0[0], v0[1]); w.y = cvt_pk_bf16(v0[2], v0[3]); w.z = cvt_pk_bf16(v1[0], v1[1]); w.w = cvt_pk_bf16(v1[2], v1[3]);
                    *(LAS u32x4*)(wp + bj * 64) = w; }
                EPI_CBAR();
#pragma unroll
                for (int p = 0; p < 2; ++p) { const u32x4 t = *(LAS const u32x4*)(rp + p * 8 * 144);
                    u32x4 w; w.x = cvt_pk_bf16(xa[p][0][0] + bf_lo(t.x), xa[p][0][1] + bf_hi(t.x)); w.y = cvt_pk_bf16(xa[p][0][2] + bf_lo(t.y), xa[p][0][3] + bf_hi(t.y));
                    w.z = cvt_pk_bf16(xa[p][1][0] + bf_lo(t.z), xa[p][1][1] + bf_hi(t.z)); w.w = cvt_pk_bf16(xa[p][1][2] + bf_lo(t.w), xa[p][1][3] + bf_hi(t.w));
                    __builtin_nontemporal_store(w, (u32x4*)(C + go + (size_t)(ai * HALF + m * 16 + 8 * p) * D)); }
                EPI_CBAR(); }
    }
};
struct EpiSwiglu {
    static constexpr int PERM = 1; static constexpr bool F8 = true;
    unsigned char* O; const float* bias;
    __device__ __forceinline__ void operator()(const f32x4 (&acc)[2][2][4][2], const Unit& u, int wr, int wc, int fr, int fq, LAS unsigned char* tl) const {
        const int fl = wc * 32 + 8 * fq, lane = fr + 16 * fq;
        const float* bp = bias + (size_t)u.e * 2048 + u.c0 + fl;
        f32x4 bg[2], bu[2];
#pragma unroll
        for (int n = 0; n < 2; ++n) { bg[n] = *(const f32x4*)(bp + 4 * n); bu[n] = *(const f32x4*)(bp + HALF + 4 * n); }
        LAS unsigned char* wp = tl + fr * 40 + fq * 8; LAS const unsigned char* rp = tl + (lane >> 2) * 40 + (lane & 3) * 8;
        unsigned char* gp = O + (size_t)(u.r0 + wr * 64 + (lane >> 2)) * FF + (u.c0 >> 1) + wc * 32 + (lane & 3) * 8;
#pragma unroll
        for (int ai = 0; ai < 2; ++ai)
#pragma unroll
            for (int m = 0; m < 4; ++m) {
                float a[8];
#pragma unroll
                for (int n = 0; n < 2; ++n)
#pragma unroll
                    for (int j = 0; j < 4; ++j) { float g = acc[ai][0][m][n][j] * W8_INV + bg[n][j], up = acc[ai][1][m][n][j] * W8_INV + bu[n][j];
                        g = fminf(g, 7.0f); up = fminf(fmaxf(up, -7.0f), 7.0f);
                        a[n * 4 + j] = clamp448(g * sigmoidf_(1.702f * g) * (up + 1.0f)); }
                *(LAS u32x2*)wp = (u32x2){cvt_pk4_fp8(a[0], a[1], a[2], a[3]), cvt_pk4_fp8(a[4], a[5], a[6], a[7])};
                EPI_CBAR();
                const u32x2 t = *(LAS const u32x2*)rp; *(u32x2*)(gp + (size_t)(ai * HALF + m * 16) * FF) = t;
                EPI_CBAR(); }
    }
};
struct EpiDown {
    static constexpr int PERM = 2; static constexpr bool F8 = true;
    bf16_t* O; const float* bias;
    __device__ __forceinline__ void operator()(const f32x4 (&acc)[2][2][4][2], const Unit& u, int wr, int wc, int fr, int fq, LAS unsigned char* tl) const {
        const int col0 = u.c0 + wc * 64 + 8 * fq, lane = fr + 16 * fq;
        const float* bp = bias + (size_t)u.e * D + col0;
        f32x4 bv[2][2];
#pragma unroll
        for (int bj = 0; bj < 2; ++bj)
#pragma unroll
            for (int n = 0; n < 2; ++n) bv[bj][n] = *(const f32x4*)(bp + bj * 32 + 4 * n);
        LAS unsigned char* wp = tl + fr * 144 + fq * 16; LAS const unsigned char* rp = tl + (lane >> 3) * 144 + (lane & 7) * 16;
        bf16_t* gp = O + (size_t)(u.r0 + wr * 64 + (lane >> 3)) * D + u.c0 + wc * 64 + (lane & 7) * 8;
#pragma unroll
        for (int ai = 0; ai < 2; ++ai)
#pragma unroll
            for (int m = 0; m < 4; ++m) {
#pragma unroll
                for (int bj = 0; bj < 2; ++bj) { const f32x4 v0 = acc[ai][bj][m][0] * W8_INV + bv[bj][0], v1 = acc[ai][bj][m][1] * W8_INV + bv[bj][1];
                    u32x4 w; w.x = cvt_pk_bf16(v0[0], v0[1]); w.y = cvt_pk_bf16(v0[2], v0[3]); w.z = cvt_pk_bf16(v1[0], v1[1]); w.w = cvt_pk_bf16(v1[2], v1[3]);
                    *(LAS u32x4*)(wp + bj * 64) = w; }
                EPI_CBAR();
#pragma unroll
                for (int p = 0; p < 2; ++p) { const u32x4 t = *(LAS const u32x4*)(rp + p * 8 * 144); __builtin_nontemporal_store(t, (u32x4*)(gp + (size_t)(ai * HALF + m * 16 + 8 * p) * D)); }
                EPI_CBAR(); }
    }
};
}

#define XB_TMO      128
#define XB_XCNT(j)  (256  + 64 * (j))
#define XB_XSUB(j)  (1280 + 64 * (j))
#define XB_XGEN(j)  (2304 + 64 * (j))
#define XB_TOP      3328
#define XB_TOPGEN   3392
#define XCD_BAR_WORDS 3456
#define XB_SPIN_CAP (1u << 18)
__device__ __forceinline__ unsigned xb_ld(unsigned* p)              { return __hip_atomic_load(p, __ATOMIC_RELAXED, __HIP_MEMORY_SCOPE_AGENT); }
__device__ __forceinline__ unsigned xb_add(unsigned* p, unsigned v) { return __hip_atomic_fetch_add(p, v, __ATOMIC_RELAXED, __HIP_MEMORY_SCOPE_AGENT); }
__device__ __forceinline__ unsigned xb_xcc_id() { return (unsigned)__builtin_amdgcn_s_getreg((3 << 11) | 20) & 0xFu; }
#define XB_SPIN(cond, bar) do { unsigned _sp = 0; while (cond) { __builtin_amdgcn_s_sleep(1); \
    if ((++_sp & 255u) == 0u) { if (xb_ld(&(bar)[XB_TMO])) break; if (_sp > XB_SPIN_CAP) { atomicAdd(&(bar)[XB_TMO], 1u); break; } } } } while (0)
struct XcdBarrier { unsigned* bar; unsigned x; volatile LAS unsigned* st; };
__device__ __forceinline__ XcdBarrier xcd_barrier_post(unsigned* bar, volatile LAS unsigned* st) {
    XcdBarrier b; b.bar = bar; b.x = xb_xcc_id(); b.st = st;
    if (threadIdx.x == 0) (void)xb_add(&bar[XB_XCNT(b.x)], 1u);
    return b;
}
__device__ __forceinline__ void xcd_barrier_complete(unsigned* bar, unsigned x, unsigned& nloc, unsigned& nx) {
    const unsigned G = gridDim.x * gridDim.y * gridDim.z;
    unsigned sum, cnt, mine, sp = 0u;
    for (;;) {
        sum = 0u; cnt = 0u; mine = 0u;
#pragma unroll
        for (unsigned j = 0; j < 16; ++j) { const unsigned c = xb_ld(&bar[XB_XCNT(j)]); sum += c; cnt += (c > 0u) ? 1u : 0u; mine = (j == x) ? c : mine; }
        if (sum == G) break;
        __builtin_amdgcn_s_sleep(1);
        if ((++sp & 255u) == 0u) { if (xb_ld(&bar[XB_TMO])) break; if (sp > XB_SPIN_CAP) { atomicAdd(&bar[XB_TMO], 1u); break; } }
    }
    nloc = mine > 0u ? mine : 1u; nx = cnt > 0u ? cnt : 1u;
}
__device__ __forceinline__ void xcd_barrier(const XcdBarrier& b) {
    asm volatile("s_waitcnt vmcnt(0)" ::: "memory");
    __syncthreads();
    if (threadIdx.x == 0) {
        unsigned* bar = b.bar;
        __builtin_amdgcn_s_waitcnt(0);
        unsigned nloc = b.st[0], nx = b.st[1];
        if (nloc == 0u) { xcd_barrier_complete(bar, b.x, nloc, nx); b.st[0] = nloc; b.st[1] = nx; }
        const unsigned old = xb_add(&bar[XB_XSUB(b.x)], 1u);
        const unsigned gen = old / nloc;
        if (old + 1u == (gen + 1u) * nloc) {
            __builtin_amdgcn_fence(__ATOMIC_RELEASE, "agent");
            asm volatile("s_waitcnt vmcnt(0)" ::: "memory");
            const unsigned og = xb_add(&bar[XB_TOP], 1u);
            const unsigned tg = og / nx;
            if (og + 1u == (tg + 1u) * nx) xb_add(&bar[XB_TOPGEN], 1u);
            else XB_SPIN(xb_ld(&bar[XB_TOPGEN]) == tg, bar);
            __builtin_amdgcn_fence(__ATOMIC_ACQUIRE, "agent");
            xb_add(&bar[XB_XGEN(b.x)], 1u);
            asm volatile("s_waitcnt vmcnt(0)" ::: "memory");
        } else {
            XB_SPIN(xb_ld(&bar[XB_XGEN(b.x)]) == gen, bar);
            __builtin_amdgcn_fence(__ATOMIC_ACQUIRE, "agent");
            asm volatile("s_waitcnt vmcnt(0)" ::: "memory");
        }
    }
    __syncthreads();
}

struct Args {
    const float* in[28]; float* out; unsigned char* ws; int ph_lo, ph_hi;
};
struct Frame {
    LAS unsigned char* lds; volatile LAS unsigned* MISC; unsigned* ctl;
    int tid, lane, wave, G, bid;
};
enum { I_X = 0, I_N1G, I_WIN, I_BGATE, I_TMIX, I_WDU, I_W0, I_AUP, I_A0, I_GUP, I_KK, I_KA, I_RK, I_GNW, I_GNB, I_LNVG, I_LNVB, I_WSP, I_BSP, I_WOUT, I_N2G, I_WR, I_BR, I_WGU, I_BGU, I_WD, I_BDN, I_NFG };

template <class RowMap>
__device__ __forceinline__ void p0_transpose_item(const float* W, int K, int N, bf16_t* WT, const RowMap& rm, LAS float* scr, int item, int lane) {
    const int nblk = N / 32, kb = item / nblk, nb = item % nblk, k0 = 64 * kb, n0 = 32 * nb;
#pragma unroll 8
    for (int i = 0; i < 32; ++i) { const int kk = 2 * i + (lane >> 5); scr[kk * 33 + (lane & 31)] = W[(size_t)(k0 + kk) * N + n0 + (lane & 31)]; }
    LDS_WAIT(); asm volatile("" ::: "memory");
    const int c = lane & 7;
#pragma unroll
    for (int j = 0; j < 4; ++j) { const int n = (lane >> 3) + 8 * j; const LAS float* s = scr + (8 * c) * 33 + n;
        u32x4 o; o.x = cvt_pk_bf16(s[0 * 33], s[1 * 33]); o.y = cvt_pk_bf16(s[2 * 33], s[3 * 33]); o.z = cvt_pk_bf16(s[4 * 33], s[5 * 33]); o.w = cvt_pk_bf16(s[6 * 33], s[7 * 33]);
        *(u32x4*)(WT + (size_t)rm(n0 + n) * K + k0 + 8 * c) = o; }
    LDS_WAIT(); asm volatile("" ::: "memory");
}
struct RmId { __device__ __forceinline__ int operator()(int n) const { return n; } };
struct RmIn { __device__ __forceinline__ int operator()(int n) const { return n < 3360 ? n : n + 224; } };
__device__ __forceinline__ void tr_issue(const float* W, int N, int item, int lane, float (&v)[32]) {
    const int nblk = N / 32, kb = item / nblk, nb = item % nblk, k0 = 64 * kb, n0 = 32 * nb;
    const float* base = W + (size_t)k0 * N + n0;
    const int lo = (lane >> 5) * N + (lane & 31);
#pragma unroll
    for (int i = 0; i < 32; ++i) v[i] = (base + (size_t)(2 * i) * N)[lo];
}
template <class RowMap>
__device__ __forceinline__ void tr_finish(const float (&v)[32], int K, int N, unsigned char* WT, const RowMap& rm, LAS float* scr, int item, int lane) {
    const int nblk = N / 32, kb = item / nblk, nb = item % nblk, k0 = 64 * kb, n0 = 32 * nb;
#pragma unroll
    for (int i = 0; i < 32; ++i) { const int kk = 2 * i + (lane >> 5); scr[kk * 33 + (lane & 31)] = v[i]; }
    LDS_WAIT(); asm volatile("" ::: "memory");
    const int c = lane & 7;
#pragma unroll
    for (int j = 0; j < 4; ++j) { const int n = (lane >> 3) + 8 * j; const LAS float* s = scr + (8 * c) * 33 + n;
        const u32x2 o = (u32x2){cvt_pk4_fp8(s[0 * 33] * W8_SCALE, s[1 * 33] * W8_SCALE, s[2 * 33] * W8_SCALE, s[3 * 33] * W8_SCALE), cvt_pk4_fp8(s[4 * 33] * W8_SCALE, s[5 * 33] * W8_SCALE, s[6 * 33] * W8_SCALE, s[7 * 33] * W8_SCALE)};
        *(u32x2*)(WT + (size_t)rm(n0 + n) * K + k0 + 8 * c) = o; }
    LDS_WAIT(); asm volatile("" ::: "memory");
}
struct RmGu { __device__ __forceinline__ int operator()(int n) const { const int f = n >> 1, up = n & 1; return (f >> 7) * 256 + up * 128 + (f & 127); } };

__device__ __forceinline__ void p0_prologue(Frame& F, const Args& a) {
    unsigned char* ws = a.ws;
    bf16_t* Bin = (bf16_t*)(ws + WS_BIN); bf16_t* Bout = (bf16_t*)(ws + WS_BOUT); bf16_t* Bgu = (bf16_t*)(ws + WS_BGU); bf16_t* Bd = (bf16_t*)(ws + WS_BD);
    LAS float* scr = (LAS float*)(F.lds + RING_OFF + F.wave * 16384);
    const int gw = F.bid * NWAVES + F.wave, NGW = F.G * NWAVES;
    constexpr int I_IN = (D / 64) * (7456 / 32), I_OUT = (D / 64) * (D / 32), I_GU1 = (D / 64) * (2048 / 32), I_D1 = (FF / 64) * (D / 32);
    constexpr int NITEMS = I_IN + I_OUT;
    for (int it = gw; it < NITEMS; it += NGW) {
        int r = it;
        if (r < I_IN) { p0_transpose_item(a.in[I_WIN], D, 7456, Bin, RmIn(), scr, r, ((int)(threadIdx.x & 63u))); continue; } r -= I_IN;
        p0_transpose_item(a.in[I_WOUT], D, D, Bout, RmId(), scr, r, ((int)(threadIdx.x & 63u)));
        (void)Bgu; (void)Bd; (void)I_GU1; (void)I_D1;
    }
    const int gt = F.bid * (NWAVES * 64) + ((int)threadIdx.x), NGT = F.G * NWAVES * 64;
    {
        u32x4* p = (u32x4*)(Bin + (size_t)3360 * D);
        for (int i = gt; i < 224 * 128; i += NGT) p[i] = (u32x4){0u, 0u, 0u, 0u};
    }
    {   float* bz = (float*)(ws + WS_MISC + MO_BIASZ);
        for (int i = gt; i < NZ; i += NGT) bz[i] = (i >= ZC_GA) ? a.in[I_BGATE][i - ZC_GA] : 0.f;
    }
    {   float* bg = (float*)(ws + WS_MISC + MO_BGU);
        for (int i = gt; i < NE * 2048; i += NGT) { const int e = i >> 11, n = i & 2047; bg[(size_t)e * 2048 + RmGu()(n)] = a.in[I_BGU][i]; }
    }
    {   bf16_t* wh = (bf16_t*)(ws + WS_MISC + MO_WRT); bf16_t* wl = wh + NE * D;
        for (int i = gt; i < NE * D; i += NGT) { const int e = i >> 10, k = i & 1023; const float w = a.in[I_WR][(size_t)k * NE + e];
            const unsigned h = cvt_pk_bf16(w, 0.f) & 0xffffu; const float rlo = w - bf_lo(h); wh[i] = (bf16_t)h; wl[i] = (bf16_t)(cvt_pk_bf16(rlo, 0.f) & 0xffffu); }
    }
    {   bf16_t* lt = (bf16_t*)(ws + WS_MISC + MO_LT);
        for (int i = gt; i < D * 288; i += NGT) { const int n = i / 288, k = i - n * 288;
            const float w = (k < 64) ? a.in[I_WDU][(size_t)k * D + n] : (k < 128 ? a.in[I_AUP][(size_t)(k - 64) * D + n] : a.in[I_GUP][(size_t)(k - 128) * D + n]);
            lt[i] = (bf16_t)(cvt_pk_bf16(w, 0.f) & 0xffffu); }
    }
    const float* x = a.in[I_X]; const float* g1 = a.in[I_N1G]; bf16_t* Hh = (bf16_t*)(ws + WS_H);
    f32x4 gv[4];
#pragma unroll
    for (int j = 0; j < 4; ++j) gv[j] = *((const f32x4*)g1 + ((int)(threadIdx.x & 63u)) + 64 * j);
    for (int m = gw; m < T; m += NGW) {
        const f32x4* xr = (const f32x4*)(x + (size_t)m * D) + ((int)(threadIdx.x & 63u));
        f32x4 v[4]; float s = 0.f;
#pragma unroll
        for (int j = 0; j < 4; ++j) { v[j] = xr[64 * j]; s += (v[j].x * v[j].x + v[j].y * v[j].y) + (v[j].z * v[j].z + v[j].w * v[j].w); }
        const float rstd = __builtin_amdgcn_rsqf(wave_sum(s) * (1.f / D) + RMS_EPS);
        u32x2* o8 = (u32x2*)(Hh + (size_t)m * D) + ((int)(threadIdx.x & 63u));
#pragma unroll
        for (int j = 0; j < 4; ++j) { const f32x4 y = v[j] * rstd * gv[j]; o8[64 * j] = (u32x2){cvt_pk_bf16(y.x, y.y), cvt_pk_bf16(y.z, y.w)}; }
    }
}

constexpr int TC = 32, NMC = TC / 4, NCH = 2048 / TC;
constexpr int RC_AT = 0;
constexpr int RC_RT = RC_AT + TC * 128;
constexpr int RC_BT = RC_RT + TC * 128;
constexpr int RC_KT = RC_BT + TC * 128;
constexpr int SB_CUMF = RC_KT + TC * 128;
constexpr int RC_VB = SB_CUMF + TC * 256;
constexpr int RC_P4 = RC_VB + TC * 128;
constexpr int RC_SCL = RC_P4 + NMC * 256;
constexpr int SB_RB = RC_SCL + NMC * 128;
constexpr int SB_KP = SB_RB + TC * 128;
constexpr int SB_V = SB_KP + TC * 256;
constexpr int SB_G = SB_V + TC * 256;
constexpr int SB_GA0 = SB_G + TC * 256;
constexpr int SB_WRAW = SB_GA0 + 2 * TC * 128;
constexpr int SB_ARAW = SB_WRAW + TC * 256;
constexpr int SB_Y = SB_WRAW;
constexpr int SB_LABF = SB_ARAW;
constexpr int SB_TIMG = SB_LABF + 2048;
constexpr int SB_LAKIMG = SB_TIMG + 2048;
constexpr int SB_MRIMG = SB_LAKIMG + 2048;
constexpr int SB_RAWRKV = SB_ARAW + TC * 256;
constexpr int SB_ALT = SB_RAWRKV + (TC + 1) * 384;
constexpr int SB_END = SB_ALT + TC * 576;
constexpr int SB_PBAR = LDSCTL_OFF + 1536;
constexpr int SB_CST = LDSCTL_OFF + 2048;
static_assert(SB_END + 4 * 8448 <= LDSCTL_OFF && SB_CST + 2560 <= LDS_BYTES, "scan LDS map (+ 4 conversion scratch tiles)");
constexpr int NP_RKV = (TC + 1) * 24;

__device__ __forceinline__ f32x4 ld_bf4(const bf16_t* p) { const u32x2 v = *(const u32x2*)p; return (f32x4){bf_lo(v.x), bf_hi(v.x), bf_lo(v.y), bf_hi(v.y)}; }
__device__ __forceinline__ f32x4 lds_bf4(const LAS unsigned char* p) { const u32x2 v = *(const LAS u32x2*)p; return (f32x4){bf_lo(v.x), bf_hi(v.x), bf_lo(v.y), bf_hi(v.y)}; }
__device__ __forceinline__ void ld_bf8(const bf16_t* p, float (&o)[8]) { const u32x4 v = *(const u32x4*)p;
    o[0] = bf_lo(v.x); o[1] = bf_hi(v.x); o[2] = bf_lo(v.y); o[3] = bf_hi(v.y); o[4] = bf_lo(v.z); o[5] = bf_hi(v.z); o[6] = bf_lo(v.w); o[7] = bf_hi(v.w); }
__device__ __forceinline__ void un8(const u32x4 v, float (&o)[8]) {
    o[0] = bf_lo(v.x); o[1] = bf_hi(v.x); o[2] = bf_lo(v.y); o[3] = bf_hi(v.y); o[4] = bf_lo(v.z); o[5] = bf_hi(v.z); o[6] = bf_lo(v.w); o[7] = bf_hi(v.w); }
__device__ __forceinline__ bf16x8 pack8(const float (&o)[8]) { u32x4 w; w.x = cvt_pk_bf16(o[0], o[1]); w.y = cvt_pk_bf16(o[2], o[3]); w.z = cvt_pk_bf16(o[4], o[5]); w.w = cvt_pk_bf16(o[6], o[7]); return __builtin_bit_cast(bf16x8, w); }

__device__ __forceinline__ void p2a_act(Frame& F, const Args& a) {
    const bf16_t* Z = (const bf16_t*)(a.ws + WS_Z); bf16_t* AL = (bf16_t*)(a.ws + WS_AL);
    const float* tml = a.in[I_TMIX] + TM_DL;
    const int gt = F.bid * (NWAVES * 64) + ((int)threadIdx.x), NGT = F.G * NWAVES * 64;
    for (int it = gt; it < T * 36; it += NGT) { const int t = it / 36, p = it - t * 36;
        float c[8], pv[8], m8[8];
        ld_bf8(Z + (size_t)t * NZ2 + Z2_L + 8 * p, c);
        if ((t & (SEQ - 1)) != 0) ld_bf8(Z + (size_t)(t - 1) * NZ2 + Z2_L + 8 * p, pv); else {
#pragma unroll
            for (int j = 0; j < 8; ++j) pv[j] = 0.f; }
        const f32x4 ta = *(const f32x4*)(tml + 8 * p), tb = *(const f32x4*)(tml + 8 * p + 4);
#pragma unroll
        for (int j = 0; j < 8; ++j) { const float tmj = (j < 4) ? ta[j] : tb[j - 4]; m8[j] = c[j] + (pv[j] - c[j]) * tmj; }
        if (p < 8) {
#pragma unroll
            for (int j = 0; j < 8; ++j) m8[j] = 1.0f - 2.0f * __builtin_amdgcn_rcpf(1.0f + __expf(2.0f * m8[j])); }
        else if (p >= 16) {
#pragma unroll
            for (int j = 0; j < 8; ++j) m8[j] = sigmoidf_(m8[j]); }
        *(bf16x8*)(AL + (size_t)t * 288 + 8 * p) = pack8(m8);
    }
}

template <int SUB> __device__ __forceinline__ void scan_sub(f32x4 (&acc)[4], const LAS unsigned char* L, int fn, int g, int row) {
    const LAS unsigned char* xa = L + RC_AT + (16 * SUB + fn) * 128 + 8 * g; const LAS unsigned char* xr = L + RC_RT + (16 * SUB + fn) * 128 + 8 * g;
    u32x4 xa0, xa1, xr0, xr1;
    { const u32x2 p0 = *(const LAS u32x2*)(xa), p1 = *(const LAS u32x2*)(xa + 32), p2 = *(const LAS u32x2*)(xa + 64), p3 = *(const LAS u32x2*)(xa + 96);
      xa0 = (u32x4){p0.x, p0.y, p1.x, p1.y}; xa1 = (u32x4){p2.x, p2.y, p3.x, p3.y}; }
    { const u32x2 p0 = *(const LAS u32x2*)(xr), p1 = *(const LAS u32x2*)(xr + 32), p2 = *(const LAS u32x2*)(xr + 64), p3 = *(const LAS u32x2*)(xr + 96);
      xr0 = (u32x4){p0.x, p0.y, p1.x, p1.y}; xr1 = (u32x4){p2.x, p2.y, p3.x, p3.y}; }
    const bf16x8 tf = *(const LAS bf16x8*)(L + SB_TIMG + ((SUB * 16 + fn) * 4 + g) * 16), lakf = *(const LAS bf16x8*)(L + SB_LAKIMG + ((SUB * 16 + fn) * 4 + g) * 16),
                 mrf = *(const LAS bf16x8*)(L + SB_MRIMG + ((SUB * 16 + fn) * 4 + g) * 16);
    const int trow = (16 * SUB + 4 * g + (fn >> 2)) * 128 + 8 * (fn & 3);
    const u32x2 vt = __builtin_bit_cast(u32x2, __builtin_amdgcn_ds_read_tr16_b64_v4i16((LAS s16x4*)(L + RC_VB + trow + (row - fn) * 2)));
    bf16x8 bk[4]; f32x4 p16[4];
#pragma unroll
    for (int jb = 0; jb < 4; ++jb) { const u32x2 bq = __builtin_bit_cast(u32x2, __builtin_amdgcn_ds_read_tr16_b64_v4i16((LAS s16x4*)(L + RC_BT + trow + 32 * jb))),
                                                 kq = __builtin_bit_cast(u32x2, __builtin_amdgcn_ds_read_tr16_b64_v4i16((LAS s16x4*)(L + RC_KT + trow + 32 * jb)));
        bk[jb] = __builtin_bit_cast(bf16x8, (u32x4){bq.x, bq.y, kq.x, kq.y}); p16[jb] = *(const LAS f32x4*)(L + RC_P4 + (SUB * 64 + 16 * jb + 4 * g) * 4); }
    const u32x4 vq = (u32x4){vt.x, vt.y, 0u, 0u};
    const f32x4 lv = __builtin_amdgcn_mfma_f32_16x16x32_bf16(lakf, __builtin_bit_cast(bf16x8, vq), (f32x4){0.f, 0.f, 0.f, 0.f}, 0, 0, 0);
    float t0[8] = {acc[0][0], acc[0][1], acc[0][2], acc[0][3], acc[1][0], acc[1][1], acc[1][2], acc[1][3]}, t1[8] = {acc[2][0], acc[2][1], acc[2][2], acc[2][3], acc[3][0], acc[3][1], acc[3][2], acc[3][3]};
    const bf16x8 sf0 = pack8(t0), sf1 = pack8(t1);
    f32x4 gq = __builtin_amdgcn_mfma_f32_16x16x32_bf16(__builtin_bit_cast(bf16x8, xa0), sf0, lv, 0, 0, 0);
    gq = __builtin_amdgcn_mfma_f32_16x16x32_bf16(__builtin_bit_cast(bf16x8, xa1), sf1, gq, 0, 0, 0);
    f32x4 hq = __builtin_amdgcn_mfma_f32_16x16x32_bf16(__builtin_bit_cast(bf16x8, xr0), sf0, (f32x4){0.f, 0.f, 0.f, 0.f}, 0, 0, 0);
    hq = __builtin_amdgcn_mfma_f32_16x16x32_bf16(__builtin_bit_cast(bf16x8, xr1), sf1, hq, 0, 0, 0);
    const u32x4 gl = (u32x4){cvt_pk_bf16(gq[0], gq[1]), cvt_pk_bf16(gq[2], gq[3]), 0u, 0u};
    const f32x4 uq = __builtin_amdgcn_mfma_f32_16x16x32_bf16(tf, __builtin_bit_cast(bf16x8, gl), (f32x4){0.f, 0.f, 0.f, 0.f}, 0, 0, 0);
    const u32x4 uv = (u32x4){cvt_pk_bf16(uq[0], uq[1]), cvt_pk_bf16(uq[2], uq[3]), vt.x, vt.y};
    const bf16x8 uvf = __builtin_bit_cast(bf16x8, uv);
    const f32x4 yq = __builtin_amdgcn_mfma_f32_16x16x32_bf16(mrf, uvf, hq, 0, 0, 0);
#pragma unroll
    for (int jb = 0; jb < 4; ++jb) acc[jb] = __builtin_amdgcn_mfma_f32_16x16x32_bf16(bk[jb], uvf, acc[jb], 0, 0, 0);
#pragma unroll
    for (int r = 0; r < 4; ++r) *(LAS float*)((LAS unsigned char*)L + SB_Y + (16 * SUB + 4 * g + r) * 256 + 4 * row) = yq[r];
#pragma unroll
    for (int jb = 0; jb < 4; ++jb) acc[jb] = acc[jb] * p16[jb];
    __builtin_amdgcn_sched_barrier(0);
    if constexpr (SUB + 1 < TC / 16) scan_sub<SUB + 1>(acc, L, fn, g, row);
}
__device__ __forceinline__ void pbar(LAS unsigned* cnt, unsigned target) {
    asm volatile("s_waitcnt lgkmcnt(0)" ::: "memory");
    if ((threadIdx.x & 63u) == 0u) __hip_atomic_fetch_add(cnt, 1u, __ATOMIC_RELAXED, __HIP_MEMORY_SCOPE_WORKGROUP);
    while (__hip_atomic_load(cnt, __ATOMIC_RELAXED, __HIP_MEMORY_SCOPE_WORKGROUP) < target) __builtin_amdgcn_s_sleep(1);
    asm volatile("" ::: "memory");
}

__device__ __forceinline__ void parrive(LAS unsigned* cnt) {
    asm volatile("s_waitcnt lgkmcnt(0)" ::: "memory");
    if ((threadIdx.x & 63u) == 0u) __hip_atomic_fetch_add(cnt, 1u, __ATOMIC_RELAXED, __HIP_MEMORY_SCOPE_WORKGROUP);
}
constexpr int SB_DUMMY = 150528;
__device__ __forceinline__ void glds_touch(const void* g, unsigned ldsoff) {
    unsigned sv;
    asm volatile("s_mov_b32 %0, m0\n\ts_mov_b32 m0, %2\n\ts_nop 0\n\tglobal_load_lds_dwordx4 %1, off\n\ts_mov_b32 m0, %0" : "=&s"(sv) : "v"(g), "s"(ldsoff) : "memory");
}
__device__ __forceinline__ void p2_scan(Frame& F, const Args& a, size_t mo_off = WS_M) {
    const unsigned char* HMb = a.ws + WS_HM; bf16_t* Mo = (bf16_t*)(a.ws + mo_off); const bf16_t* AL = (const bf16_t*)(a.ws + WS_AL);
    LAS unsigned char* L = F.lds;
    LAS unsigned* PB = (LAS unsigned*)(F.lds + SB_PBAR);
    const int w = F.wave, tid = ((int)threadIdx.x);
    const float* tmix = a.in[I_TMIX];
    for (int unit = F.bid; unit < NB_ * NH; unit += F.G) {
        const int b = unit / NH, h = unit % NH;
        const size_t trow0 = (size_t)b * SEQ;
        {   LAS float* CST = (LAS float*)(F.lds + SB_CST);
            for (int i = tid; i < 640; i += NWAVES * 64) { const int a_ = i >> 6, c_ = h * HD + (i & 63);
                const float* sp = (a_ == 0) ? tmix + TM_R : (a_ == 1) ? tmix + TM_K : (a_ == 2) ? tmix + TM_V : (a_ == 3) ? a.in[I_W0] : (a_ == 4) ? a.in[I_A0] : (a_ == 5) ? a.in[I_KK] : (a_ == 6) ? a.in[I_KA] : (a_ == 7) ? a.in[I_RK] : (a_ == 8) ? a.in[I_GNW] : a.in[I_GNB];
                CST[i] = sp[c_]; }
            if (tid == 0) *PB = 0u;
        }
        bf16x8 Bw[2], Ba[2], Bg[5];
        {   const int lane0 = tid & 63; const bf16_t* lp = (const bf16_t*)(a.ws + WS_MISC + MO_LT) + (size_t)(h * HD + (w & 3) * 16 + (lane0 & 15)) * 288 + 8 * (lane0 >> 4);
#pragma unroll
            for (int sx = 0; sx < 2; ++sx) { Bw[sx] = *(const bf16x8*)(lp + 32 * sx); Ba[sx] = *(const bf16x8*)(lp + 64 + 32 * sx); }
#pragma unroll
            for (int sx = 0; sx < 5; ++sx) Bg[sx] = *(const bf16x8*)(lp + 128 + 32 * sx);
        }
        unsigned pbt = 0u;
        f32x4 acc[4];
#pragma unroll
        for (int g = 0; g < 4; ++g) acc[g] = (f32x4){0.f, 0.f, 0.f, 0.f};
        __syncthreads();
        for (int ch = -1; ch < NCH; ++ch) {
            int tidv = tid; asm volatile("" : "+v"(tidv));
            const int lane = tidv & 63, fn = lane & 15, kg = lane >> 4;
            const int tl = tidv >> 4, q = tidv & 15, col4 = h * HD + 4 * q;
            const LAS f32x4* CQ = (const LAS f32x4*)(F.lds + SB_CST) + q;
            if (w < 4) {
                if (ch >= 0) {
                    scan_sub<0>(acc, L, fn, kg, 16 * w + fn);
                }
            } else {
                const int ts = tidv - 256, pw = w - 4;
                const bool do_cv = (ch >= 0 && (ch & 3) < 3 && F.G == 256);
                const int cvi = F.bid * 192 + pw * 48 + (ch >> 2) * 3 + (ch & 3);
                float cv[32];
                if (do_cv) { if (cvi < NE * 1024) tr_issue(a.in[I_WGU] + (size_t)(cvi >> 10) * D * 2048, 2048, cvi & 1023, lane, cv);
                             else { const int r_ = cvi - NE * 1024; tr_issue(a.in[I_WD] + (size_t)(r_ >> 9) * FF * D, D, r_ & 511, lane, cv); } }
                if (ch + 1 < NCH) {
                    const unsigned char* cb_ = HMb + ((long)unit * SEQ + (long)(ch + 1) * TC - 1) * 512L;
                    const unsigned char* ab_ = (const unsigned char*)(AL + (trow0 + (size_t)(ch + 1) * TC) * 288);
                    u32x4 R4[4], G1, A5[5];
#pragma unroll
                    for (int j = 0; j < 4; ++j) { const int pid = ts + 256 * j; R4[j] = (u32x4){0u, 0u, 0u, 0u};
                        if (pid < NP_RKV && !(ch + 1 == 0 && pid < 24)) { const int row = pid / 24, pc = pid % 24, arr = pc >> 3, c8 = pc & 7; R4[j] = *(const u32x4*)(cb_ + row * 512 + (arr * 8 + c8) * 16); } }
                    G1 = *(const u32x4*)(cb_ + ((ts >> 3) + 1) * 512 + 384 + (ts & 7) * 16);
#pragma unroll
                    for (int j = 0; j < 5; ++j) if (ts + 256 * j < TC * 36) A5[j] = *(const u32x4*)(ab_ + (ts + 256 * j) * 16);
#pragma unroll
                    for (int j = 0; j < 4; ++j) if (ts + 256 * j < NP_RKV) *(LAS u32x4*)(L + SB_RAWRKV + (ts + 256 * j) * 16) = R4[j];
                    *(LAS u32x4*)(L + SB_GA0 + ((ch + 1) & 1) * (TC * 128) + ts * 16) = G1;
#pragma unroll
                    for (int j = 0; j < 5; ++j) if (ts + 256 * j < TC * 36) *(LAS u32x4*)(L + SB_ALT + (ts + 256 * j) * 16) = A5[j];
                }
                if (do_cv) { LAS float* scr = (LAS float*)(L + SB_END + pw * 8448);
                    if (cvi < NE * 1024) tr_finish(cv, D, 2048, (unsigned char*)(a.ws + WS_BGU) + (size_t)(cvi >> 10) * 2048 * D, RmGu(), scr, cvi & 1023, lane);
                    else { const int r_ = cvi - NE * 1024; tr_finish(cv, FF, D, (unsigned char*)(a.ws + WS_BD) + (size_t)(r_ >> 9) * D * FF, RmId(), scr, r_ & 511, lane); } }
            }
            __syncthreads();
            const int mb = w >> 2, nb = w & 3;
            if (ch >= 0) {
                const int t = ch * TC + tl; const int o = tl * 256 + 16 * q;
                const f32x4 kpv = *(const LAS f32x4*)(L + SB_KP + o), vv = *(const LAS f32x4*)(L + SB_V + o), gv = *(const LAS f32x4*)(L + SB_G + o);
                const f32x4 y = *(const LAS f32x4*)(L + SB_Y + o);
                const f32x4 rv = lds_bf4(L + SB_RB + tl * 128 + 8 * q);
                const float mean = allsum16((y[0] + y[1]) + (y[2] + y[3])) * (1.0f / 64.0f);
                const f32x4 dv = y - mean;
                const float var = allsum16((dv[0] * dv[0] + dv[1] * dv[1]) + (dv[2] * dv[2] + dv[3] * dv[3])) * (1.0f / 64.0f);
                const float rstd = __builtin_amdgcn_rsqf(var + GN_EPS);
                const f32x4 c_rk = CQ[16 * 7], c_gw = CQ[16 * 8], c_gb = CQ[16 * 9];
                const float bonus = allsum16((rv[0] * kpv[0] * c_rk[0] + rv[1] * kpv[1] * c_rk[1]) + (rv[2] * kpv[2] * c_rk[2] + rv[3] * kpv[3] * c_rk[3]));
                const f32x4 ga = lds_bf4(L + SB_GA0 + (ch & 1) * (TC * 128) + tl * 128 + 8 * q);
                f32x4 ov;
#pragma unroll
                for (int j = 0; j < 4; ++j) ov[j] = ((dv[j] * rstd * c_gw[j] + c_gb[j]) + bonus * vv[j]) * gv[j] * ga[j];
                *(u32x2*)(Mo + (trow0 + t) * D + col4) = (u32x2){cvt_pk_bf16(ov[0], ov[1]), cvt_pk_bf16(ov[2], ov[3])};
            }
            __syncthreads();
            if (ch + 1 < NCH) {
                {   f32x4 aw = (f32x4){0.f, 0.f, 0.f, 0.f}, aa = aw, ag = aw;
                    const LAS unsigned char* ap = L + SB_ALT + (16 * mb + fn) * 576 + kg * 16;
#pragma unroll
                    for (int sx = 0; sx < 9; ++sx) { const bf16x8 af = *(const LAS bf16x8*)(ap + sx * 64);
                        if (sx < 2) aw = __builtin_amdgcn_mfma_f32_16x16x32_bf16(Bw[sx], af, aw, 0, 0, 0);
                        else if (sx < 4) aa = __builtin_amdgcn_mfma_f32_16x16x32_bf16(Ba[sx - 2], af, aa, 0, 0, 0);
                        else ag = __builtin_amdgcn_mfma_f32_16x16x32_bf16(Bg[sx - 4], af, ag, 0, 0, 0); }
                    const int o = (16 * mb + fn) * 256 + (nb * 16 + 4 * kg) * 4;
                    const LAS f32x4* CW = (const LAS f32x4*)(F.lds + SB_CST) + (4 * nb + kg); const f32x4 c_w0 = CW[48], c_a0 = CW[64];
                    f32x4 cumv;
#pragma unroll
                    for (int r = 0; r < 4; ++r) { aw[r] = -0.60653066f * sigmoidf_(aw[r] + c_w0[r]);
                        aa[r] = sigmoidf_(aa[r] + c_a0[r]);
                        float x = aw[r]; x += dpp<0x111>(x); x += dpp<0x112>(x); x += dpp<0x114>(x); x += dpp<0x118>(x); cumv[r] = x; }
                    *(LAS f32x4*)(L + SB_WRAW + o) = aw; *(LAS f32x4*)(L + SB_ARAW + o) = aa; *(LAS f32x4*)(L + SB_CUMF + o) = cumv; *(LAS f32x4*)(L + SB_G + o) = ag;
                }
                __syncthreads();
                {   const LAS unsigned char* rc = L + SB_RAWRKV + (tl + 1) * 384 + 8 * q; const LAS unsigned char* rp_ = rc - 384;
                    f32x4 r = lds_bf4(rc), k = lds_bf4(rc + 128), v = lds_bf4(rc + 256);
                    const f32x4 rp = lds_bf4(rp_), kp_ = lds_bf4(rp_ + 128), vp = lds_bf4(rp_ + 256);
                    const f32x4 tm_r = CQ[0], tm_k = CQ[16], tm_v = CQ[32], c_kk = CQ[80], c_ka = CQ[96];
                    r = r + (rp - r) * tm_r; k = k + (kp_ - k) * tm_k; v = v + (vp - v) * tm_v;
                    const int o = tl * 256 + 16 * q;
                    const f32x4 lw = *(const LAS f32x4*)(L + SB_WRAW + o), av = *(const LAS f32x4*)(L + SB_ARAW + o), cum = *(const LAS f32x4*)(L + SB_CUMF + o);
                    f32x4 kk, kpv, nbv; float ss = 0.f;
#pragma unroll
                    for (int j = 0; j < 4; ++j) { kk[j] = k[j] * c_kk[j]; ss += kk[j] * kk[j]; kpv[j] = k[j] * (1.0f + (av[j] - 1.0f) * c_ka[j]); }
                    ss = allsum16(ss);
                    const float inv = __builtin_amdgcn_rcpf(fmaxf(__builtin_amdgcn_sqrtf(ss), 1e-12f));
#pragma unroll
                    for (int j = 0; j < 4; ++j) { kk[j] *= inv; nbv[j] = -kk[j] * av[j]; }
                    f32x4 at, bt, kt, rt, p4;
#pragma unroll
                    for (int j = 0; j < 4; ++j) { const float P = __expf(cum[j]), iP = __builtin_amdgcn_rcpf(P), Pm1 = __expf(cum[j] - lw[j]);
                        at[j] = kk[j] * Pm1; bt[j] = nbv[j] * iP; kt[j] = kpv[j] * iP; rt[j] = r[j] * P; p4[j] = P; }
                    *(LAS u32x2*)(L + RC_AT + tl * 128 + 8 * q) = (u32x2){cvt_pk_bf16(at[0], at[1]), cvt_pk_bf16(at[2], at[3])};
                    *(LAS u32x2*)(L + RC_RT + tl * 128 + 8 * q) = (u32x2){cvt_pk_bf16(rt[0], rt[1]), cvt_pk_bf16(rt[2], rt[3])};
                    *(LAS u32x2*)(L + RC_BT + tl * 128 + 8 * q) = (u32x2){cvt_pk_bf16(bt[0], bt[1]), cvt_pk_bf16(bt[2], bt[3])};
                    *(LAS u32x2*)(L + RC_KT + tl * 128 + 8 * q) = (u32x2){cvt_pk_bf16(kt[0], kt[1]), cvt_pk_bf16(kt[2], kt[3])};
                    *(LAS u32x2*)(L + RC_VB + tl * 128 + 8 * q) = (u32x2){cvt_pk_bf16(v[0], v[1]), cvt_pk_bf16(v[2], v[3])};
                    if ((tl & 15) == 15) *(LAS f32x4*)(L + RC_P4 + ((tl >> 4) * 64 + 4 * q) * 4) = p4;
                    *(LAS u32x2*)(L + SB_RB + tl * 128 + 8 * q) = (u32x2){cvt_pk_bf16(r[0], r[1]), cvt_pk_bf16(r[2], r[3])};
                    *(LAS f32x4*)(L + SB_KP + o) = kpv; *(LAS f32x4*)(L + SB_V + o) = v;
                }
                __syncthreads();
                {   const int sub = w >> 2, mx = w & 3;
                    const LAS unsigned char* Ai = L + ((mx & 2) ? RC_RT : RC_AT) + (16 * sub + fn) * 128 + kg * 16; const LAS unsigned char* Bi = L + ((mx & 1) ? RC_KT : RC_BT) + (16 * sub + fn) * 128 + kg * 16;
                    const bf16x8 a0 = *(const LAS bf16x8*)(Ai), a1 = *(const LAS bf16x8*)(Ai + 64), b0 = *(const LAS bf16x8*)(Bi), b1 = *(const LAS bf16x8*)(Bi + 64);
                    f32x4 dt = __builtin_amdgcn_mfma_f32_16x16x32_bf16(b0, a0, (f32x4){0.f, 0.f, 0.f, 0.f}, 0, 0, 0);
                    dt = __builtin_amdgcn_mfma_f32_16x16x32_bf16(b1, a1, dt, 0, 0, 0);
                    if (mx != 0) {
#pragma unroll
                        for (int r = 0; r < 4; ++r) { const int s_ = 4 * kg + r; const bool keep = (mx < 2) ? (s_ < fn) : (s_ <= fn); dt[r] = keep ? dt[r] : 0.f; }
                        const u32x2 pk = (u32x2){cvt_pk_bf16(dt[0], dt[1]), cvt_pk_bf16(dt[2], dt[3])};
                        if (mx == 1) *(LAS u32x4*)(L + SB_LAKIMG + ((sub * 16 + fn) * 4 + kg) * 16) = (u32x4){pk.x, pk.y, 0u, 0u};
                        else *(LAS u32x2*)(L + SB_MRIMG + ((sub * 16 + fn) * 4 + kg) * 16 + ((mx == 3) ? 8 : 0)) = pk;
                    } else {
#define MM16(XT, Y, C) __builtin_amdgcn_mfma_f32_16x16x4f32((XT)[3], (Y)[3], __builtin_amdgcn_mfma_f32_16x16x4f32((XT)[2], (Y)[2], __builtin_amdgcn_mfma_f32_16x16x4f32((XT)[1], (Y)[1], \
                                       __builtin_amdgcn_mfma_f32_16x16x4f32((XT)[0], (Y)[0], (C), 0, 0, 0), 0, 0, 0), 0, 0, 0), 0, 0, 0)
                        f32x4 d = __builtin_amdgcn_mfma_f32_16x16x32_bf16(a0, b0, (f32x4){0.f, 0.f, 0.f, 0.f}, 0, 0, 0);
                        d = __builtin_amdgcn_mfma_f32_16x16x32_bf16(a1, b1, d, 0, 0, 0);
                        f32x4 Lm, Lt, T1, T1t; const f32x4 z4 = (f32x4){0.f, 0.f, 0.f, 0.f};
#pragma unroll
                        for (int r = 0; r < 4; ++r) { const int e_ = 4 * kg + r; Lm[r] = (fn < e_) ? d[r] : 0.f; Lt[r] = (e_ < fn) ? dt[r] : 0.f; const float id = (e_ == fn) ? 1.0f : 0.f; T1[r] = Lm[r] + id; T1t[r] = Lt[r] + id; }
                        const f32x4 X2 = MM16(Lt, Lm, z4), X2t = MM16(Lm, Lt, z4);
                        const f32x4 T2 = MM16(X2t, T1, T1), T2t = MM16(T1, X2t, T1t);
                        const f32x4 X4 = MM16(X2t, X2, z4), X4t = MM16(X2, X2t, z4);
                        const f32x4 T3 = MM16(X4t, T2, T2), T3t = MM16(T2, X4t, T2t);
                        const f32x4 X8t = MM16(X4, X4t, z4);
                        const f32x4 T4t = MM16(T3, X8t, T3t);
#undef MM16
                        *(LAS u32x4*)(L + SB_TIMG + ((sub * 16 + fn) * 4 + kg) * 16) = (u32x4){cvt_pk_bf16(T4t[0], T4t[1]), cvt_pk_bf16(T4t[2], T4t[3]), 0u, 0u};
                    }
                }
                __syncthreads();
            }
        }
    }
}

constexpr int VN_STRIDE = 272;
struct TrQ { u32x2 a[8], b[8]; };
__device__ __forceinline__ void p3_gmlp(Frame& F, const Args& a) {
    const bf16_t* Z = (const bf16_t*)(a.ws + WS_Z); const bf16_t* Mo = (const bf16_t*)(a.ws + WS_M); bf16_t* M2 = (bf16_t*)(a.ws + WS_M2);
    LAS unsigned char* VN = F.lds + RING_OFF;
    LAS f32x2* ST = (LAS f32x2*)(F.lds + RING_OFF + 128 * VN_STRIDE);
    LAS f32x2* SP = ST + 128;
    const int lane = ((int)(threadIdx.x & 63u)), w = F.wave, tid = ((int)threadIdx.x);
    const float* lng = a.in[I_LNVG]; const float* lnb = a.in[I_LNVB]; const float* wsp = a.in[I_WSP]; const float* bsp = a.in[I_BSP];
    for (int unit = F.bid; unit < NB_ * (SEQ / 128); unit += F.G) {
        const size_t t0 = (size_t)unit * 128;
#pragma unroll 4
        for (int rr = 0; rr < 16; ++rr) { const int j = 16 * w + rr;
            const bf16_t* p = Z + (t0 + j) * NZ2 + Z2_VG + 16 * lane; float c0[8], c1[8]; ld_bf8(p, c0); ld_bf8(p + 8, c1);
            float s = 0.f, s2 = 0.f;
#pragma unroll
            for (int i = 0; i < 8; ++i) { s += c0[i] + c1[i]; s2 += c0[i] * c0[i] + c1[i] * c1[i]; }
            s = allsum16(s); s2 = allsum16(s2);
            if ((lane & 15) == 0) SP[j * 4 + (lane >> 4)] = (f32x2){s, s2};
        }
        __syncthreads();
        if (tid < 128) { const f32x2 p0 = SP[tid * 4], p1 = SP[tid * 4 + 1], p2 = SP[tid * 4 + 2], p3 = SP[tid * 4 + 3];
            const float s = (p0.x + p1.x) + (p2.x + p3.x), s2 = (p0.y + p1.y) + (p2.y + p3.y);
            const float mean = s * (1.0f / 1024.0f), var = fmaxf(s2 * (1.0f / 1024.0f) - mean * mean, 0.f);
            ST[tid] = (f32x2){mean, __builtin_amdgcn_rsqf(var + LN_EPS)}; }
        __syncthreads();
        const int lr = tid >> 4, lc = tid & 15;
        u32x4 raw[4];
#pragma unroll
        for (int it = 0; it < 4; ++it) raw[it] = *(const u32x4*)(Z + (t0 + lr + 32 * it) * NZ2 + Z2_VG + lc * 8);
        for (int g = 0; g < 8; ++g) {
            {   const f32x4 g0 = *(const f32x4*)(lng + g * 128 + lc * 8), g1 = *(const f32x4*)(lng + g * 128 + lc * 8 + 4);
                const f32x4 b0 = *(const f32x4*)(lnb + g * 128 + lc * 8), b1 = *(const f32x4*)(lnb + g * 128 + lc * 8 + 4);
#pragma unroll
                for (int it = 0; it < 4; ++it) { const int j = lr + 32 * it; const f32x2 st = ST[j];
                    float c[8], o[8]; un8(raw[it], c);
#pragma unroll
                    for (int i = 0; i < 8; ++i) { const float gg = (i < 4) ? g0[i] : g1[i - 4], bb = (i < 4) ? b0[i] : b1[i - 4]; o[i] = (c[i] - st.x) * st.y * gg + bb; }
                    *(LAS bf16x8*)(VN + j * VN_STRIDE + lc * 16) = pack8(o); }
                if (g + 1 < 8) {
#pragma unroll
                    for (int it = 0; it < 4; ++it) raw[it] = *(const u32x4*)(Z + (t0 + lr + 32 * it) * NZ2 + Z2_VG + (g + 1) * 128 + lc * 8); }
            }
            __syncthreads();
            {   const int fi = lane & 15, kg = lane >> 4, i = 16 * w + fi, tq = fi >> 2, tp = fi & 3;
                f32x4 acc[8];
#pragma unroll
                for (int n = 0; n < 8; ++n) acc[n] = (f32x4){0.f, 0.f, 0.f, 0.f};
                const float* wrow = wsp + ((size_t)g * 128 + i) * 128;
                const unsigned trb = (unsigned)(size_t)(VN + (8 * kg + tq) * VN_STRIDE + tp * 16);
#pragma unroll
                for (int s = 0; s < 4; ++s) {
                    if (32 * s <= 16 * w + 15) {
                        const int jb = 32 * s + 8 * kg;
                        const f32x4 w0 = *(const f32x4*)(wrow + jb), w1 = *(const f32x4*)(wrow + jb + 4);
                        float m8[8];
#pragma unroll
                        for (int jj = 0; jj < 8; ++jj) { const float v = (jj < 4) ? w0[jj] : w1[jj - 4]; m8[jj] = (jb + jj <= i) ? v : 0.f; }
                        const bf16x8 wf = pack8(m8);
                        TrQ t;
                        const unsigned ad = trb + (unsigned)(32 * s * VN_STRIDE);
                        asm volatile(
                            "ds_read_b64_tr_b16 %0, %16 offset:0\n\tds_read_b64_tr_b16 %1, %16 offset:8\n\tds_read_b64_tr_b16 %2, %16 offset:64\n\tds_read_b64_tr_b16 %3, %16 offset:72\n\t"
                            "ds_read_b64_tr_b16 %4, %16 offset:128\n\tds_read_b64_tr_b16 %5, %16 offset:136\n\tds_read_b64_tr_b16 %6, %16 offset:192\n\tds_read_b64_tr_b16 %7, %16 offset:200\n\t"
                            "ds_read_b64_tr_b16 %8, %16 offset:1088\n\tds_read_b64_tr_b16 %9, %16 offset:1096\n\tds_read_b64_tr_b16 %10, %16 offset:1152\n\tds_read_b64_tr_b16 %11, %16 offset:1160\n\t"
                            "ds_read_b64_tr_b16 %12, %16 offset:1216\n\tds_read_b64_tr_b16 %13, %16 offset:1224\n\tds_read_b64_tr_b16 %14, %16 offset:1280\n\tds_read_b64_tr_b16 %15, %16 offset:1288\n\t"
                            "s_waitcnt lgkmcnt(0)"
                            : "=&v"(t.a[0]), "=&v"(t.a[1]), "=&v"(t.a[2]), "=&v"(t.a[3]), "=&v"(t.a[4]), "=&v"(t.a[5]), "=&v"(t.a[6]), "=&v"(t.a[7]),
                              "=&v"(t.b[0]), "=&v"(t.b[1]), "=&v"(t.b[2]), "=&v"(t.b[3]), "=&v"(t.b[4]), "=&v"(t.b[5]), "=&v"(t.b[6]), "=&v"(t.b[7])
                            : "v"(ad) : "memory");
#pragma unroll
                        for (int n = 0; n < 8; ++n) { const u32x4 vq = (u32x4){t.a[n].x, t.a[n].y, t.b[n].x, t.b[n].y};
                            acc[n] = __builtin_amdgcn_mfma_f32_16x16x32_bf16(__builtin_bit_cast(bf16x8, vq), wf, acc[n], 0, 0, 0); }
                    }
                }
                const float bs = bsp[g * 128 + i];
                const size_t trow = t0 + i;
#pragma unroll
                for (int u = 0; u < 4; ++u) { const int dcol = g * 128 + 32 * u + 8 * kg;
                    float uu[8], gb[8], mm[8], o[8];
                    ld_bf8(Z + trow * NZ2 + Z2_U + dcol, uu); ld_bf8(Z + trow * NZ2 + Z2_GB + dcol, gb); ld_bf8(Mo + trow * D + dcol, mm);
#pragma unroll
                    for (int r = 0; r < 4; ++r) { o[r] = mm[r] + uu[r] * (acc[2 * u][r] + bs) * gb[r]; o[4 + r] = mm[4 + r] + uu[4 + r] * (acc[2 * u + 1][r] + bs) * gb[4 + r]; }
                    *(bf16x8*)(M2 + trow * D + dcol) = pack8(o); }
            }
            __syncthreads();
        }
    }
}

__device__ __forceinline__ void p5_router(Frame& F, const Args& a) {
    const bf16_t* X2 = (const bf16_t*)(a.ws + WS_H); unsigned char* Hh = (unsigned char*)(a.ws + WS_H2);
    const bf16_t* Wh = (const bf16_t*)(a.ws + WS_MISC + MO_WRT); const bf16_t* Wl = Wh + NE * D;
    int* tok_of = (int*)(a.ws + WS_TOK); int* asg = (int*)(a.ws + WS_MISC + MO_ASG); float* gate = (float*)(a.ws + WS_MISC + MO_GATE);
    const float* g2 = a.in[I_N2G]; const float* br = a.in[I_BR];
    LAS float* LG = (LAS float*)(F.lds + RING_OFF) + F.wave * 512;
    LAS unsigned* LCNT = (LAS unsigned*)(F.lds + RING_OFF + 32768);
    LAS unsigned* LBASE = LCNT + 32;
    const int lane = ((int)(threadIdx.x & 63u)), w = F.wave, tid = ((int)threadIdx.x), fm = lane & 15, kg = lane >> 4;
    for (int blk = F.bid; blk < T / 128; blk += F.G) {
        if (tid < 32) LCNT[tid] = 0u;
        __syncthreads();
        const int tb = blk * 128 + 16 * w;
        const bf16_t* xr = X2 + (size_t)(tb + fm) * D + 8 * kg;
        float ss = 0.f;
        for (int s = 0; s < 32; ++s) { float x8[8]; ld_bf8(xr + 32 * s, x8);
            ss += (x8[0] * x8[0] + x8[1] * x8[1]) + (x8[2] * x8[2] + x8[3] * x8[3]) + (x8[4] * x8[4] + x8[5] * x8[5]) + (x8[6] * x8[6] + x8[7] * x8[7]); }
        ss += __shfl_xor(ss, 16); ss += __shfl_xor(ss, 32);
        const float rstd = __builtin_amdgcn_rsqf(ss * (1.0f / D) + RMS_EPS);
        f32x4 acc[2]; acc[0] = (f32x4){0.f, 0.f, 0.f, 0.f}; acc[1] = acc[0];
        unsigned char* hrow = Hh + (size_t)(tb + fm) * D + 8 * kg;
        u32x4 xq_n = *(const u32x4*)(xr); f32x4 ga_n = *(const f32x4*)(g2 + 8 * kg), gb_n = *(const f32x4*)(g2 + 8 * kg + 4);
        bf16x8 bh_n[2], bl_n[2];
#pragma unroll
        for (int n = 0; n < 2; ++n) { const size_t wo = (size_t)(16 * n + fm) * D + 8 * kg; bh_n[n] = *(const bf16x8*)(Wh + wo); bl_n[n] = *(const bf16x8*)(Wl + wo); }
        for (int s = 0; s < 32; ++s) {
            const u32x4 xq = xq_n; const f32x4 ga = ga_n, gb = gb_n; const bf16x8 bh[2] = {bh_n[0], bh_n[1]}, bl[2] = {bl_n[0], bl_n[1]};
            { const int s1 = (s + 1 < 32) ? s + 1 : 31;
              xq_n = *(const u32x4*)(xr + 32 * s1); ga_n = *(const f32x4*)(g2 + 32 * s1 + 8 * kg); gb_n = *(const f32x4*)(g2 + 32 * s1 + 8 * kg + 4);
#pragma unroll
              for (int n = 0; n < 2; ++n) { const size_t wo = (size_t)(16 * n + fm) * D + 32 * s1 + 8 * kg; bh_n[n] = *(const bf16x8*)(Wh + wo); bl_n[n] = *(const bf16x8*)(Wl + wo); } }
            const float x8[8] = {bf_lo(xq.x), bf_hi(xq.x), bf_lo(xq.y), bf_hi(xq.y), bf_lo(xq.z), bf_hi(xq.z), bf_lo(xq.w), bf_hi(xq.w)};
            float hv[8], lo[8];
#pragma unroll
            for (int j = 0; j < 4; ++j) { hv[j] = x8[j] * rstd * ga[j]; hv[4 + j] = x8[4 + j] * rstd * gb[j]; }
            u32x4 hp; hp.x = cvt_pk_bf16(hv[0], hv[1]); hp.y = cvt_pk_bf16(hv[2], hv[3]); hp.z = cvt_pk_bf16(hv[4], hv[5]); hp.w = cvt_pk_bf16(hv[6], hv[7]);
            *(u32x2*)(hrow + 32 * s) = (u32x2){cvt_pk4_fp8(clamp448(hv[0]), clamp448(hv[1]), clamp448(hv[2]), clamp448(hv[3])), cvt_pk4_fp8(clamp448(hv[4]), clamp448(hv[5]), clamp448(hv[6]), clamp448(hv[7]))};
            lo[0] = hv[0] - bf_lo(hp.x); lo[1] = hv[1] - bf_hi(hp.x); lo[2] = hv[2] - bf_lo(hp.y); lo[3] = hv[3] - bf_hi(hp.y);
            lo[4] = hv[4] - bf_lo(hp.z); lo[5] = hv[5] - bf_hi(hp.z); lo[6] = hv[6] - bf_lo(hp.w); lo[7] = hv[7] - bf_hi(hp.w);
            const bf16x8 ah = __builtin_bit_cast(bf16x8, hp), al = pack8(lo);
#pragma unroll
            for (int n = 0; n < 2; ++n) {
                acc[n] = __builtin_amdgcn_mfma_f32_16x16x32_bf16(bh[n], ah, acc[n], 0, 0, 0);
                acc[n] = __builtin_amdgcn_mfma_f32_16x16x32_bf16(bh[n], al, acc[n], 0, 0, 0);
                acc[n] = __builtin_amdgcn_mfma_f32_16x16x32_bf16(bl[n], ah, acc[n], 0, 0, 0); }
        }
#pragma unroll
        for (int n = 0; n < 2; ++n) { const f32x4 bb = *(const f32x4*)(br + 16 * n + 4 * kg); *(LAS f32x4*)(LG + fm * 32 + 16 * n + 4 * kg) = acc[n] + bb; }
        LDS_WAIT(); asm volatile("" ::: "memory");
        int se[4] = {0, 0, 0, 0}; unsigned sr[4] = {0u, 0u, 0u, 0u}; float sg[4] = {0.f, 0.f, 0.f, 0.f};
        if (lane < 16) {
            float lv[32];
#pragma unroll
            for (int e4 = 0; e4 < 8; ++e4) { const f32x4 v = *(LAS f32x4*)(LG + lane * 32 + 4 * e4); lv[4 * e4] = v.x; lv[4 * e4 + 1] = v.y; lv[4 * e4 + 2] = v.z; lv[4 * e4 + 3] = v.w; }
            float tv[4];
#pragma unroll
            for (int k = 0; k < 4; ++k) { float best = -3.0e38f; int bi = 0;
#pragma unroll
                for (int e = 0; e < 32; ++e) { const bool taken = (k > 0 && se[0] == e) || (k > 1 && se[1] == e) || (k > 2 && se[2] == e); if (!taken && lv[e] > best) { best = lv[e]; bi = e; } }
                se[k] = bi; tv[k] = best; }
            const float e1 = __expf(tv[1] - tv[0]), e2 = __expf(tv[2] - tv[0]), e3 = __expf(tv[3] - tv[0]); const float inv = 1.0f / (1.0f + e1 + e2 + e3);
            sg[0] = inv; sg[1] = e1 * inv; sg[2] = e2 * inv; sg[3] = e3 * inv;
#pragma unroll
            for (int k = 0; k < 4; ++k) sr[k] = atomicAdd((unsigned*)(LCNT + se[k]), 1u);
        }
        __syncthreads();
        if (tid < 32) LBASE[tid] = atomicAdd(F.ctl + CW_CNT + 64 * tid, (unsigned)LCNT[tid]);
        __syncthreads();
        if (lane < 16) { const int tok = tb + lane;
#pragma unroll
            for (int k = 0; k < 4; ++k) { const int pos = (int)(LBASE[se[k]] + sr[k]);
                tok_of[(size_t)se[k] * T + pos] = tok; asg[(size_t)tok * 8 + 2 * k] = se[k]; asg[(size_t)tok * 8 + 2 * k + 1] = pos; gate[(size_t)tok * 4 + k] = sg[k]; }
        }
        __syncthreads();
    }
}

__device__ __forceinline__ void moe_tables(Frame& F) {
    LAS int* cnt = (LAS int*)(F.lds + SCHED_OFF); LAS int* mts = cnt + 32;
    if (((int)threadIdx.x) == 0) { int acc = 0;
        for (int e = 0; e < NE; ++e) { const int c = (int)__hip_atomic_load(F.ctl + CW_CNT + 64 * e, RLX_AGENT); cnt[e] = c; mts[e] = acc; acc += (c + 255) >> 8; }
        mts[NE] = acc; }
    __syncthreads();
}
template <int NTN, bool GATH>
struct MoeOrder {
    static constexpr int MOE_ROWB = 1024;
    static constexpr bool GATHER = GATH;
    LAS const int* cnt; LAS const int* mts; const char* A; const char* B; const int* tok_of; int G, c, Mtiles;
    __device__ void init(Frame& F, const void* A_, const void* B_, const int* tok) { cnt = (LAS const int*)(F.lds + SCHED_OFF); mts = cnt + 32; A = (const char*)A_; B = (const char*)B_; tok_of = tok; G = F.G; c = F.bid; Mtiles = mts[NE]; }
    __device__ bool next(int i, pg8::Unit& u) const {
        constexpr int MPS = 32 / NTN;
        int mt, nt_;
        if ((G & 7) == 0) { const int s = i * 8 + (c & 7), j = (c >> 3) + 0; const int per = G >> 3;
            if (per == 32) { mt = s * MPS + (j % MPS); nt_ = j / MPS; }
            else { const int L = i * G + c; mt = L / NTN; nt_ = L % NTN; } }
        else { const int L = i * G + c; mt = L / NTN; nt_ = L % NTN; }
        if (mt >= Mtiles) return false;
        int e = 0;
        for (int k = 1; k < NE; ++k) e += (mts[k] <= mt) ? 1 : 0;
        const int mloc = mt - mts[e];
        u.e = e; u.r0 = mt * 256; u.c0 = nt_ * 256; u.aux = mloc;
        u.B = B + ((size_t)e * NTN + nt_) * (256 * MOE_ROWB);
        u.A = GATH ? A : A + (size_t)mt * (256 * MOE_ROWB);
        return true;
    }
    __device__ __forceinline__ void a_offs(const pg8::Unit& u, unsigned (&ga)[2][2], const int (&R)[2], const int (&C)[2]) const {
        if constexpr (GATH) {
            const int n = cnt[u.e]; const int* tp = tok_of + (size_t)u.e * T + u.aux * 256;
            int tk[2][2];
#pragma unroll
            for (int h = 0; h < 2; ++h)
#pragma unroll
                for (int i = 0; i < 2; ++i) tk[h][i] = tp[h * 128 + R[i]];
            VM_WAIT();
#pragma unroll
            for (int h = 0; h < 2; ++h)
#pragma unroll
                for (int i = 0; i < 2; ++i) { const int t_ = (u.aux * 256 + h * 128 + R[i] < n) ? tk[h][i] : 0; ga[h][i] = (unsigned)(t_ * MOE_ROWB + C[i] * 2); }
        } else {
#pragma unroll
            for (int h = 0; h < 2; ++h)
#pragma unroll
                for (int i = 0; i < 2; ++i) ga[h][i] = (unsigned)((h * 128 + R[i]) * MOE_ROWB + C[i] * 2);
        }
    }
};

__device__ __forceinline__ void p8_final(Frame& F, const Args& a) {
    int ln_ = (int)threadIdx.x; asm volatile("" : "+v"(ln_)); ln_ &= 63;
    LAS const int* mts = (LAS const int*)(F.lds + SCHED_OFF) + 32;
    const bf16_t* YS = (const bf16_t*)(a.ws + WS_YS); const int* asg = (const int*)(a.ws + WS_MISC + MO_ASG); const float* gate = (const float*)(a.ws + WS_MISC + MO_GATE);
    float* out = a.out; const float* gf = a.in[I_NFG];
    const int gw = F.bid * NWAVES + F.wave, NGW = F.G * NWAVES;
    f32x4 gv[4];
#pragma unroll
    for (int j = 0; j < 4; ++j) gv[j] = *((const f32x4*)gf + ln_ + 64 * j);
    for (int m = gw; m < T; m += NGW) {
        f32x4* xr = (f32x4*)(out + (size_t)m * D) + ln_;
        const bf16_t* x2r = (const bf16_t*)(a.ws + WS_H) + (size_t)m * D + 4 * ln_;
        f32x4 v[4];
#pragma unroll
        for (int j = 0; j < 4; ++j) v[j] = ld_bf4(x2r + 256 * j);
#pragma unroll
        for (int k = 0; k < 4; ++k) { const int e = asg[(size_t)m * 8 + 2 * k], pos = asg[(size_t)m * 8 + 2 * k + 1]; const float gk = gate[(size_t)m * 4 + k];
            const bf16_t* yr = YS + ((size_t)mts[e] * 256 + pos) * D + 4 * ln_;
#pragma unroll
            for (int j = 0; j < 4; ++j) v[j] += gk * ld_bf4(yr + 256 * j); }
        float s = 0.f;
#pragma unroll
        for (int j = 0; j < 4; ++j) s += (v[j].x * v[j].x + v[j].y * v[j].y) + (v[j].z * v[j].z + v[j].w * v[j].w);
        const float rstd = __builtin_amdgcn_rsqf(wave_sum(s) * (1.f / D) + RMS_EPS);
#pragma unroll
        for (int j = 0; j < 4; ++j) xr[64 * j] = v[j] * rstd * gv[j];
    }
}

constexpr int N_PHASES = 10;
__global__ void __launch_bounds__(NWAVES * 64, 2) mk_fwd(Args args) {
    extern __shared__ __attribute__((aligned(16))) unsigned char lds[];
    Frame F;
    F.lds = (LAS unsigned char*)lds;
    F.MISC = (volatile LAS unsigned*)(F.lds + MISC_OFF);
    F.wave = __builtin_amdgcn_readfirstlane(((int)threadIdx.x) >> 6);
    F.G = gridDim.x; F.bid = blockIdx.x;
    F.ctl = (unsigned*)(args.ws + WS_CTL);
    for (int u = ((int)threadIdx.x); u < (LDS_BYTES - LDSCTL_OFF) / 4; u += NWAVES * 64) ((LAS unsigned*)(F.lds + LDSCTL_OFF))[u] = 0u;
    __syncthreads();
    const int lo = args.ph_lo, hi = args.ph_hi;
    const bool multi = (hi - lo) > 1;
    XcdBarrier bar; bar.bar = F.ctl + CW_BAR; bar.x = 0; bar.st = nullptr;
    if (multi) bar = xcd_barrier_post(F.ctl + CW_BAR, F.MISC + 8);
#define IN(k) (lo <= (k) && (k) < hi)
#define SEAM(k) do { if (IN(k) && IN((k) + 1)) xcd_barrier(bar); } while (0)
    unsigned char* ws = args.ws;

#define P1_BODY {     \
        pg8::StaticOrder S; S.init(ws + WS_H, ws + WS_BIN, T, NZ, F.G, F.bid); S.wgm = P1_WGM; \
        pg8::EpiZ E{(bf16_t*)(ws + WS_Z), (const float*)(ws + WS_MISC + MO_BIASZ), (bf16_t*)(ws + WS_HM)}; \
        pg8::gemm_phase<pg8::EpiZ, pg8::StaticOrder, true>(F.lds + RING_OFF, S, E); }
#define P4_BODY {     \
        pg8::StaticOrder S; S.init(ws + WS_M2, ws + WS_BOUT, T, D, F.G, F.bid); \
        pg8::EpiRes E{(bf16_t*)(ws + WS_H), args.in[I_X]}; \
        pg8::gemm_phase<pg8::EpiRes, pg8::StaticOrder, true>(F.lds + RING_OFF, S, E); }
#define P6_BODY {     \
        moe_tables(F); \
        MoeOrder<8, true> S; S.init(F, ws + WS_H2, ws + WS_BGU, (const int*)(ws + WS_TOK)); \
        pg8::EpiSwiglu E{(unsigned char*)(ws + WS_ACT), (const float*)(ws + WS_MISC + MO_BGU)}; \
        pg8::gemm_phase<pg8::EpiSwiglu, MoeOrder<8, true>, true>(F.lds + RING_OFF, S, E); }
#define P7_BODY {     \
        moe_tables(F); \
        MoeOrder<4, false> S; S.init(F, ws + WS_ACT, ws + WS_BD, nullptr); \
        pg8::EpiDown E{(bf16_t*)(ws + WS_YS), args.in[I_BDN]}; \
        pg8::gemm_phase<pg8::EpiDown, MoeOrder<4, false>, true>(F.lds + RING_OFF, S, E); }
    if (IN(0)) { p0_prologue(F, args); if (PROBE_REP == 0) p0_prologue(F, args); SEAM(0); }
    if (IN(1)) { P1_BODY if (PROBE_REP == 1) P1_BODY SEAM(1); }
    if (IN(2)) { p2a_act(F, args); SEAM(2); }
    if (IN(3)) { p2_scan(F, args); if (PROBE_REP == 2) p2_scan(F, args); SEAM(3); }
    if (IN(4)) { for (int rep_ = 0; rep_ < (PROBE_REP == 3 ? 2 : 1); ++rep_) p3_gmlp(F, args); SEAM(4); }
    if (IN(5)) { P4_BODY if (PROBE_REP == 4) P4_BODY SEAM(5); }
    if (IN(6)) { p5_router(F, args); SEAM(6); }
    if (IN(7)) { P6_BODY if (PROBE_REP == 6) P6_BODY SEAM(7); }
    if (IN(8)) { P7_BODY if (PROBE_REP == 7) P7_BODY SEAM(8); }
    if (IN(9)) { moe_tables(F); p8_final(F, args); }
#undef IN
#undef SEAM
}

extern "C" void kernel_launch(void* const* d_in, const int* in_sizes, int n_in, void* d_out, int out_size, void* d_ws, size_t ws_size, hipStream_t stream) {
    static int grid = 0;
    if (grid == 0) {
        if (n_in != 28 || out_size != T * D || ws_size < WS_END) { fprintf(stderr, "kernel_launch: unexpected problem (n_in %d, out %d, ws %zu); nothing launched\n", n_in, out_size, ws_size); grid = -1; return; }
        int dev = 0, cus = 0, per_cu = 0;
        if (hipGetDevice(&dev) != hipSuccess || hipDeviceGetAttribute(&cus, hipDeviceAttributeMultiprocessorCount, dev) != hipSuccess) { grid = -1; return; }
        if (hipFuncSetAttribute((const void*)mk_fwd, hipFuncAttributeMaxDynamicSharedMemorySize, LDS_BYTES) != hipSuccess) { fprintf(stderr, "kernel_launch: hipFuncSetAttribute failed\n"); grid = -1; return; }
        if (hipOccupancyMaxActiveBlocksPerMultiprocessor(&per_cu, (const void*)mk_fwd, NWAVES * 64, LDS_BYTES) != hipSuccess || per_cu < 1)
            fprintf(stderr, "kernel_launch: note: occupancy query reports %d workgroups per CU\n", per_cu);
        (void)hipGetLastError();
        grid = cus;
    }
    if (grid < 0) return;
    if (hipMemsetAsync((char*)d_ws + WS_CTL, 0, CTL_ZERO_BYTES, stream) != hipSuccess) return;
    Args a{};
    for (int i = 0; i < 28; ++i) a.in[i] = (const float*)d_in[i];
    a.out = (float*)d_out; a.ws = (unsigned char*)d_ws;
    if (MK_N_LAUNCHES == 1) { a.ph_lo = 0; a.ph_hi = N_PHASES; hipLaunchKernelGGL(mk_fwd, dim3(grid), dim3(NWAVES * 64), LDS_BYTES, stream, a); }
    else for (int p = 0; p < N_PHASES; ++p) { a.ph_lo = p; a.ph_hi = p + 1; hipLaunchKernelGGL(mk_fwd, dim3(grid), dim3(NWAVES * 64), LDS_BYTES, stream, a); }
}
```

```cpp
#include <hip/hip_runtime.h>
#include <cstdio>
#include <cstdint>

#ifndef MK_N_LAUNCHES
#define MK_N_LAUNCHES 1
#endif

#ifndef P1_WGM
#define P1_WGM 4
#endif
#ifndef SCAN_PREFETCH
#define SCAN_PREFETCH 0
#endif
#ifndef P1_BF0
#define P1_BF0 4
#define P1_BFN 18
#endif
#ifndef PROBE_REP
#define PROBE_REP -1
#endif
#define GAS __attribute__((address_space(1)))
#define LAS __attribute__((address_space(3)))
typedef unsigned short bf16_t;
typedef short bf16x8 __attribute__((ext_vector_type(8)));
typedef float f32x4 __attribute__((ext_vector_type(4)));
typedef float f32x2 __attribute__((ext_vector_type(2)));
typedef unsigned u32x4 __attribute__((ext_vector_type(4)));
typedef unsigned u32x2 __attribute__((ext_vector_type(2)));
typedef int i32x4 __attribute__((ext_vector_type(4)));
typedef int i32x8 __attribute__((ext_vector_type(8)));

constexpr int NB_ = 16, SEQ = 2048, D = 1024, T = NB_ * SEQ;
constexpr int NH = 16, HD = 64;
constexpr int NZ = 7680;
constexpr int ZC_R = 0, ZC_K = 1024, ZC_V = 2048, ZC_L = 3072, ZC_U = 3584, ZC_VG = 4608, ZC_GA = 5632, ZC_GB = 6656;
constexpr int NZ2 = 3584, Z2_L = 0, Z2_U = 512, Z2_VG = 1536, Z2_GB = 2560;
constexpr int TM_R = 0, TM_K = 1024, TM_V = 2048, TM_DL = 3072, TM_AL = 3136, TM_GL = 3200;
constexpr int NE = 32, TOPK = 4, FF = 1024;
constexpr int NSLOT_MAX = T * TOPK + NE * 256;
constexpr float RMS_EPS = 1e-5f, GN_EPS = 64e-5f, LN_EPS = 1e-5f;

constexpr size_t MiB = 1u << 20;
constexpr size_t WS_CTL = 0, CTL_ZERO_BYTES = 1 * MiB;
constexpr size_t WS_BIN = 2 * MiB;
constexpr size_t WS_BOUT = 18 * MiB;
constexpr size_t WS_BGU = 20 * MiB;
constexpr size_t WS_H8 = 84 * MiB;
constexpr size_t WS_BIN8 = 116 * MiB;
constexpr size_t WS_BD = 148 * MiB;
constexpr size_t WS_MISC = 212 * MiB;
constexpr size_t WS_TOK = 216 * MiB;
constexpr size_t WS_H = 220 * MiB;
constexpr size_t WS_HM = 284 * MiB;
constexpr size_t WS_Z = 540 * MiB;
constexpr size_t WS_M = 764 * MiB;
constexpr size_t WS_M2 = 828 * MiB;
constexpr size_t WS_H2 = 892 * MiB;
constexpr size_t WS_AL = 956 * MiB;
constexpr size_t WS_END = 976 * MiB;
constexpr size_t WS_ACT = WS_HM;
constexpr size_t WS_YS = WS_HM + 272 * MiB;
static_assert((size_t)NSLOT_MAX * FF * 2 == 272 * MiB && WS_YS + 272 * MiB == WS_M2, "ws map");
constexpr size_t MO_BIASZ = 0;
constexpr size_t MO_BGU = 64 * 1024;
constexpr size_t MO_WRT = 512 * 1024;
constexpr size_t MO_ASG = 1 * MiB;
constexpr size_t MO_GATE = 2 * MiB;
constexpr size_t MO_LT = 3 * MiB;
constexpr int CW_TMO = 0, CW_CODE = 1;
constexpr int CW_BAR = 4096;
constexpr int CW_CNT = 8192;

constexpr int RING_OFF = 0, RING_BYTES = 131072;
constexpr int LDSCTL_OFF = 159232, MISC_OFF = LDSCTL_OFF + 320;
constexpr int SCHED_OFF = LDSCTL_OFF + 1024;
constexpr int LDS_BYTES = 163840;
constexpr int EPI_T_OFF = RING_OFF + RING_BYTES, EPI_T_WAVE = 2304;
static_assert(EPI_T_OFF + 8 * EPI_T_WAVE <= LDSCTL_OFF, "LDS");
constexpr int NWAVES = 8;

#define RLX_AGENT __ATOMIC_RELAXED, __HIP_MEMORY_SCOPE_AGENT
#define LDS_WAIT() asm volatile("s_waitcnt lgkmcnt(0)" ::: "memory")
#define VM_WAIT() asm volatile("s_waitcnt vmcnt(0)" ::: "memory")
typedef __bf16 bf16x2_t __attribute__((ext_vector_type(2)));
typedef short s16x4 __attribute__((ext_vector_type(4)));
__device__ __forceinline__ unsigned cvt_pk_bf16(float lo, float hi) { bf16x2_t v; v.x = (__bf16)lo; v.y = (__bf16)hi; return __builtin_bit_cast(unsigned, v); }
constexpr float W8_SCALE = 64.0f, W8_INV = 1.0f / 64.0f;
__device__ __forceinline__ float clamp448(float x) { return fminf(fmaxf(x, -448.0f), 448.0f); }
__device__ __forceinline__ unsigned cvt_pk4_fp8(float a, float b, float c, float d) {
    int w = __builtin_amdgcn_cvt_pk_fp8_f32(a, b, 0, false); w = __builtin_amdgcn_cvt_pk_fp8_f32(c, d, w, true); return (unsigned)w; }
__device__ __forceinline__ float bf_lo(unsigned u) { return __builtin_bit_cast(float, u << 16); }
__device__ __forceinline__ float bf_hi(unsigned u) { return __builtin_bit_cast(float, u & 0xffff0000u); }
__device__ __forceinline__ float bf2f(bf16_t b) { return __builtin_bit_cast(float, ((unsigned)b) << 16); }
template <int CTRL> __device__ __forceinline__ float dpp(float x) { return __builtin_bit_cast(float, __builtin_amdgcn_mov_dpp(__builtin_bit_cast(int, x), CTRL, 0xf, 0xf, true)); }
__device__ __forceinline__ float allsum16(float x) {
    x += dpp<0xB1>(x); x += dpp<0x4E>(x); x += dpp<0x141>(x); x += dpp<0x140>(x); return x;
}
__device__ __forceinline__ float wave_sum(float v) {
#pragma unroll
    for (int o = 1; o < 64; o <<= 1) v += __shfl_xor(v, o);
    return v;
}
__device__ __forceinline__ float sigmoidf_(float x) { return __builtin_amdgcn_rcpf(1.0f + __expf(-x)); }
__device__ __forceinline__ f32x2 gelu_pk(f32x2 v) {
    const f32x2 av = __builtin_elementwise_abs(v), d = av * 0.2316418882f + 1.0f;
    f32x2 t; t.x = __builtin_amdgcn_rcpf(d.x); t.y = __builtin_amdgcn_rcpf(d.y);
    f32x2 q = t * 0.5307027145f + (-0.7265760135f); q = q * t + 0.7107068705f; q = q * t + (-0.142248368f); q = q * t + 0.127414796f; q = q * t;
    const f32x2 s = (v * v) * (-0.72134752044f);
    f32x2 e; e.x = __builtin_amdgcn_exp2f(s.x); e.y = __builtin_amdgcn_exp2f(s.y);
    const f32x2 m = v * (q * e), r = v - m;
    f32x2 o; o.x = v.x < 0.f ? m.x : r.x; o.y = v.y < 0.f ? m.y : r.y; return o;
}

namespace pg8 {
constexpr int BM = 256, BK = 64, HALF = 128, HTB = HALF * BK * 2, STAGE_BYTES = 8 * HTB, NXCD = 8, WGM = 8;
constexpr int KK = 1024;
__host__ __device__ __forceinline__ int lds_byte(int r, int c) { const int st = (r >> 4) * 2 + (c >> 5), rr = r & 15, cc = c & 31, ob = rr * 64 + cc * 2; return st * 1024 + (ob ^ (((ob >> 9) & 1) << 5)); }
__host__ __device__ __forceinline__ void stage_rc(int b, int& R, int& C) { const int st = b / 1024, sb = b % 1024, swz = sb ^ (((sb >> 9) & 1) << 5); R = (st >> 1) * 16 + swz / 64; C = (st & 1) * 32 + (swz % 64) / 2; }
__host__ __device__ __forceinline__ int perm32(int rho) { const int n = rho >> 4, i = rho & 15; return 8 * (i >> 2) + 4 * n + (i & 3); }

struct Unit { const char* A; const char* B; int r0, c0, e, aux; };

template <bool F8_ = false>
struct StaticOrderT {
    static constexpr int ROWB = F8_ ? KK : 2 * KK;
    const char* A; const char* B; int nM, nN, nwg, G, c, wgm = WGM; int n_split = 1 << 30, n_add0 = 0, n_add1 = 0;
    static constexpr bool GATHER = false;
    __device__ void init(const void* A_, const void* B_, int M, int N, int G_, int c_) { A = (const char*)A_; B = (const char*)B_; nM = M / BM; nN = N / BM; nwg = nM * nN; G = G_; c = c_; }
    __device__ bool next(int i, Unit& u) const {
        const long L = (long)i * G + c; if (L >= nwg) return false;
        int wgid = (int)L; { const int q = nwg / NXCD, r = nwg % NXCD, xcd = wgid % NXCD, off = wgid / NXCD; wgid = (xcd < r ? xcd * (q + 1) : r * (q + 1) + (xcd - r) * q) + off; }
        const int nig = wgm * nN, gid = wgid / nig, fm = gid * wgm, gsz = (nM - fm) < wgm ? (nM - fm) : wgm;
        const int pm = fm + ((wgid % nig) % gsz), pn = (wgid % nig) / gsz;
        const int pa = pn + (pn < n_split ? n_add0 : n_add1);
        u.A = A + (size_t)pm * (BM * ROWB); u.B = B + (size_t)pa * (BM * ROWB); u.r0 = pm * BM; u.c0 = pa * BM; u.e = 0; u.aux = 0; return true;
    }
    __device__ __forceinline__ void a_offs(const Unit&, unsigned (&ga)[2][2], const int (&R)[2], const int (&C)[2]) const {
#pragma unroll
        for (int h = 0; h < 2; ++h)
#pragma unroll
            for (int i = 0; i < 2; ++i) ga[h][i] = (unsigned)((h * HALF + R[i]) * ROWB + C[i] * 2);
    }
};
typedef StaticOrderT<false> StaticOrder;

template <class Epi, class Sched, bool ALIGN_EPI = false>
__device__ __forceinline__ void gemm_phase(LAS unsigned char* lds, const Sched& S, const Epi& E) {
    const int tid = threadIdx.x, wid = __builtin_amdgcn_readfirstlane(tid >> 6), lane = tid & 63, wr = wid >> 2, wc = wid & 3, fr = lane & 15, fq = lane >> 4;
    constexpr bool F8 = Epi::F8;
    constexpr int K = KK, ROWB = F8 ? K : 2 * K, nt = ROWB / (BK * 2);
    unsigned voffB[2]; int Rr[2], Cc[2];
#pragma unroll
    for (int i = 0; i < 2; ++i) { int R, C; stage_rc(tid * 16 + i * 8192, R, C); const int Rb = Epi::PERM == 2 ? (64 * (R >> 5) + perm32(R & 31)) : (Epi::PERM == 1 ? ((R & ~31) + perm32(R & 31)) : R);
        Rr[i] = R; Cc[i] = C; voffB[i] = (unsigned)(Rb * ROWB + C * 2); }
    const size_t kstep = (size_t)(BK * 2);
    const size_t hstep = (size_t)(Epi::PERM == 2 ? 32 : HALF) * ROWB;
    const unsigned ldsw = (unsigned)wid * 1024u;
    const int aoff = F8 ? lds_byte(wr * 64 + fr, fq * 16) : lds_byte(wr * 64 + fr, fq * 8), boff = F8 ? lds_byte(wc * 32 + fr, fq * 16) : lds_byte(wc * 32 + fr, fq * 8);
    constexpr int KOFF = F8 ? 16 : 1024;
#define PG8_SA(b, h) (((b) * 2 + (h)) * HTB)
#define PG8_SB(b, h) ((4 + (b) * 2 + (h)) * HTB)
#define PG8_STAGE(bufoff, gbase, voff) do { _Pragma("unroll") for (int _i = 0; _i < 2; ++_i) \
        __builtin_amdgcn_global_load_lds((const unsigned*)((const char*)(gbase) + (voff)[_i]), (LAS unsigned*)(lds + (bufoff) + ldsw + _i * 8192), 16, 0, 0); } while (0)
#define PG8_LDA(dst, b, h) do { _Pragma("unroll") for (int m = 0; m < 4; ++m) _Pragma("unroll") for (int k = 0; k < 2; ++k) dst[m][k] = *(const LAS bf16x8*)(lds + PG8_SA(b, h) + aoff + m * 2048 + k * KOFF); } while (0)
#define PG8_LDB(dst, b, h) do { _Pragma("unroll") for (int n = 0; n < 2; ++n) _Pragma("unroll") for (int k = 0; k < 2; ++k) dst[n][k] = *(const LAS bf16x8*)(lds + PG8_SB(b, h) + boff + n * 2048 + k * KOFF); } while (0)
#define PG8_CAT8(x) __builtin_shufflevector(__builtin_bit_cast(i32x4, (x)[0]), __builtin_bit_cast(i32x4, (x)[1]), 0, 1, 2, 3, 4, 5, 6, 7)
#define PG8_MMA(ai, bj, At, Bt) do { __builtin_amdgcn_s_setprio(1); _Pragma("unroll") for (int m = 0; m < 4; ++m) _Pragma("unroll") for (int n = 0; n < 2; ++n) { \
        if constexpr (F8) { const i32x8 b8_ = PG8_CAT8(Bt[n]), a8_ = PG8_CAT8(At[m]);     \
            asm volatile("v_mfma_f32_16x16x128_f8f6f4 %0, %1, %2, %0" : "+v"(acc[ai][bj][m][n]) : "v"(b8_), "v"(a8_)); } \
        else { _Pragma("unroll") for (int k = 0; k < 2; ++k) acc[ai][bj][m][n] = __builtin_amdgcn_mfma_f32_16x16x32_bf16(Bt[n][k], At[m][k], acc[ai][bj][m][n], 0, 0, 0); } } __builtin_amdgcn_s_setprio(0); } while (0)
#define PG8_WAIT_V(n) asm volatile("s_waitcnt vmcnt(" #n ")" ::: "memory")
#define PG8_WAIT_L(n) asm volatile("s_waitcnt lgkmcnt(" #n ")" ::: "memory")
#define PG8_BAR __builtin_amdgcn_s_barrier()
#define PG8_SCHED __builtin_amdgcn_sched_barrier(0)
    Unit cur, nxt; int ui = 0;
    if (!S.next(0, cur)) return;
    f32x4 acc[2][2][4][2];
#pragma unroll
    for (int a = 0; a < 2; ++a)
#pragma unroll
        for (int b = 0; b < 2; ++b)
#pragma unroll
            for (int m = 0; m < 4; ++m)
#pragma unroll
                for (int n = 0; n < 2; ++n) acc[a][b][m][n] = (f32x4){0.f, 0.f, 0.f, 0.f};
    bf16x8 At[4][2], B0[2][2], B1[2][2];
    unsigned ga[2][2], gn[2][2];
    S.a_offs(cur, ga, Rr, Cc);
    const char* cA = cur.A; const char* cB = cur.B;
    PG8_STAGE(PG8_SB(0, 0), cB, voffB); PG8_STAGE(PG8_SB(0, 1), cB + hstep, voffB); PG8_STAGE(PG8_SA(0, 0), cA, ga[0]); PG8_STAGE(PG8_SA(0, 1), cA, ga[1]);
    if (wr == 1) PG8_BAR;
    PG8_WAIT_V(2); PG8_BAR;
    PG8_STAGE(PG8_SB(1, 0), cB + kstep, voffB); PG8_STAGE(PG8_SA(1, 0), cA + kstep, ga[0]); PG8_STAGE(PG8_SB(1, 1), cB + hstep + kstep, voffB);
    PG8_WAIT_V(6); PG8_BAR;
    for (;;) {
        const bool has_next = S.next(ui + 1, nxt);
        const char* nA = has_next ? nxt.A : cA; const char* nB = has_next ? nxt.B : cB;
#pragma unroll
        for (int h = 0; h < 2; ++h)
#pragma unroll
            for (int i = 0; i < 2; ++i) gn[h][i] = ga[h][i];
#pragma unroll 1
        for (int t = 0; t < nt; t += 2) {
            const bool last = (t == nt - 2);
            if (Sched::GATHER && last && has_next) S.a_offs(nxt, gn, Rr, Cc);
            const char* a1 = cA + (size_t)(t + 1) * kstep;
            const char* a2 = last ? nA : cA + (size_t)(t + 2) * kstep; const char* b2 = last ? nB : cB + (size_t)(t + 2) * kstep;
            const char* a3 = a2 + kstep; const char* b3 = b2 + kstep;
            unsigned g2[2][2];
#pragma unroll
            for (int h = 0; h < 2; ++h)
#pragma unroll
                for (int i = 0; i < 2; ++i) g2[h][i] = last ? gn[h][i] : ga[h][i];
            PG8_LDB(B0, 0, 0); PG8_LDB(B1, 0, 1); PG8_SCHED; PG8_LDA(At, 0, 0); PG8_STAGE(PG8_SA(1, 1), a1, ga[1]);
            PG8_WAIT_V(8); PG8_WAIT_L(0); PG8_BAR; PG8_MMA(0, 0, At, B0); PG8_MMA(0, 1, At, B1); PG8_BAR; PG8_SCHED;
            PG8_LDA(At, 0, 1); PG8_STAGE(PG8_SB(0, 0), b2, voffB); PG8_STAGE(PG8_SB(0, 1), b2 + hstep, voffB); PG8_STAGE(PG8_SA(0, 0), a2, g2[0]);
            PG8_WAIT_V(8); PG8_WAIT_L(0); PG8_BAR; PG8_MMA(1, 0, At, B0); PG8_MMA(1, 1, At, B1); PG8_BAR; PG8_SCHED;
            PG8_LDB(B0, 1, 0); PG8_LDB(B1, 1, 1); PG8_SCHED; PG8_LDA(At, 1, 0); PG8_STAGE(PG8_SA(0, 1), a2, g2[1]);
            PG8_WAIT_V(8); PG8_WAIT_L(0); PG8_BAR; PG8_MMA(0, 0, At, B0); PG8_MMA(0, 1, At, B1); PG8_BAR; PG8_SCHED;
            PG8_LDA(At, 1, 1); PG8_STAGE(PG8_SB(1, 0), b3, voffB); PG8_STAGE(PG8_SB(1, 1), b3 + hstep, voffB); PG8_STAGE(PG8_SA(1, 0), a3, g2[0]);
            PG8_WAIT_V(8); PG8_WAIT_L(0); PG8_BAR; PG8_MMA(1, 0, At, B0); PG8_MMA(1, 1, At, B1); PG8_BAR; PG8_SCHED;
        }
        if constexpr (ALIGN_EPI) { if (wr == 0) PG8_BAR; }
        { int te_ = threadIdx.x; asm volatile("" : "+v"(te_));
          E(acc, cur, wr, wc, te_ & 15, (te_ >> 4) & 3, lds + EPI_T_OFF + wid * EPI_T_WAVE); }
        if (!has_next) break;
#pragma unroll
        for (int a = 0; a < 2; ++a)
#pragma unroll
            for (int b = 0; b < 2; ++b)
#pragma unroll
                for (int m = 0; m < 4; ++m)
#pragma unroll
                    for (int n = 0; n < 2; ++n) acc[a][b][m][n] = (f32x4){0.f, 0.f, 0.f, 0.f};
        cur = nxt; cA = nA; cB = nB; ++ui;
#pragma unroll
        for (int h = 0; h < 2; ++h)
#pragma unroll
            for (int i = 0; i < 2; ++i) ga[h][i] = gn[h][i];
        if constexpr (ALIGN_EPI) { if (wr == 1) PG8_BAR; }
    }
    PG8_WAIT_V(0);
    if constexpr (!ALIGN_EPI) { if (wr == 0) PG8_BAR; }
    PG8_BAR;
#undef PG8_SA
#undef PG8_SB
#undef PG8_STAGE
#undef PG8_LDA
#undef PG8_LDB
#undef PG8_MMA
#undef PG8_CAT8
#undef PG8_WAIT_V
#undef PG8_WAIT_L
#undef PG8_BAR
#undef PG8_SCHED
}

#define EPI_CBAR() asm volatile("" ::: "memory")

template <bool F8_>
struct EpiZT {
    static constexpr int PERM = 2; static constexpr bool F8 = F8_;
    bf16_t* O; const float* bias; bf16_t* HM;
    __device__ __forceinline__ void operator()(const f32x4 (&acc)[2][2][4][2], const Unit& u, int wr, int wc, int fr, int fq, LAS unsigned char* tl) const {
        const int col0 = u.c0 + wc * 64 + 8 * fq, lane = fr + 16 * fq;
        const int mode = (u.c0 < ZC_U) ? 0 : (u.c0 < ZC_GA ? 1 : 2);
        const bool hm = (u.c0 < ZC_L) || (u.c0 >= ZC_GA && u.c0 < ZC_GB);
        f32x4 bv[2][2];
#pragma unroll
        for (int bj = 0; bj < 2; ++bj)
#pragma unroll
            for (int n = 0; n < 2; ++n) bv[bj][n] = *(const f32x4*)(bias + col0 + bj * 32 + 4 * n);
        LAS unsigned char* wp = tl + fr * 144 + fq * 16; LAS const unsigned char* rp = tl + (lane >> 3) * 144 + (lane & 7) * 16;
        bf16_t* gp; int rs;
        if (hm) { const int xi = (u.c0 < ZC_L) ? (u.c0 >> 10) : 3, h0 = (((u.c0 < ZC_L) ? (u.c0 & 1023) : (u.c0 - ZC_GA)) >> 6) + wc, b = u.r0 >> 11, t = (u.r0 & 2047) + wr * 64 + (lane >> 3);
            gp = HM + ((size_t)((b * NH + h0) * SEQ + t)) * 256 + xi * 64 + (lane & 7) * 8; rs = 256; }
        else { const int c2 = (u.c0 < ZC_GA) ? u.c0 - ZC_L : u.c0 - ZC_GB + Z2_GB; gp = O + (size_t)(u.r0 + wr * 64 + (lane >> 3)) * NZ2 + c2 + wc * 64 + (lane & 7) * 8; rs = NZ2; }
#pragma unroll
        for (int ai = 0; ai < 2; ++ai)
#pragma unroll
            for (int m = 0; m < 4; ++m) {
#pragma unroll
                for (int bj = 0; bj < 2; ++bj) { f32x4 v0 = acc[ai][bj][m][0] * (F8_ ? W8_INV : 1.0f) + bv[bj][0], v1 = acc[ai][bj][m][1] * (F8_ ? W8_INV : 1.0f) + bv[bj][1];
                    if (mode == 1) { f32x2 a = gelu_pk((f32x2){v0[0], v0[1]}), b = gelu_pk((f32x2){v0[2], v0[3]}), c = gelu_pk((f32x2){v1[0], v1[1]}), d = gelu_pk((f32x2){v1[2], v1[3]});
                        v0 = (f32x4){a.x, a.y, b.x, b.y}; v1 = (f32x4){c.x, c.y, d.x, d.y}; }
                    else if (mode == 2) {
#pragma unroll
                        for (int j = 0; j < 4; ++j) { v0[j] = sigmoidf_(v0[j]); v1[j] = sigmoidf_(v1[j]); } }
                    u32x4 w; w.x = cvt_pk_bf16(v0[0], v0[1]); w.y = cvt_pk_bf16(v0[2], v0[3]); w.z = cvt_pk_bf16(v1[0], v1[1]); w.w = cvt_pk_bf16(v1[2], v1[3]);
                    *(LAS u32x4*)(wp + bj * 64) = w; }
                EPI_CBAR();
#pragma unroll
                for (int p = 0; p < 2; ++p) { const u32x4 t = *(LAS const u32x4*)(rp + p * 8 * 144); __builtin_nontemporal_store(t, (u32x4*)(gp + (size_t)((ai * HALF + m * 16 + 8 * p) * rs))); }
                EPI_CBAR(); }
    }
};
struct EpiRes {
    static constexpr int PERM = 2; static constexpr bool F8 = false;
    bf16_t* C; const float* base;
    __device__ __forceinline__ void operator()(const f32x4 (&acc)[2][2][4][2], const Unit& u, int wr, int wc, int fr, int fq, LAS unsigned char* tl) const {
        const int lane = fr + 16 * fq;
        LAS unsigned char* wp = tl + fr * 144 + fq * 16; LAS const unsigned char* rp = tl + (lane >> 3) * 144 + (lane & 7) * 16;
        const size_t go = (size_t)(u.r0 + wr * 64 + (lane >> 3)) * D + u.c0 + wc * 64 + (lane & 7) * 8;
        f32x4 xa[2][2];
#pragma unroll
        for (int ai = 0; ai < 2; ++ai)
#pragma unroll
            for (int m = 0; m < 4; ++m) {
#pragma unroll
                for (int p = 0; p < 2; ++p) { const size_t o = go + (size_t)(ai * HALF + m * 16 + 8 * p) * D; xa[p][0] = *(const f32x4*)(base + o); xa[p][1] = *(const f32x4*)(base + o + 4); }
#pragma unroll
                for (int bj = 0; bj < 2; ++bj) { const f32x4 v0 = acc[ai][bj][m][0], v1 = acc[ai][bj][m][1];
                    u32x4 w; w.x = cvt_pk_bf16(v0[0], v0[1]); w.y = cvt_pk_bf16(v0[2], v0[3]); w.z = cvt_pk_bf16(v1[0], v1[1]); w.w = cvt_pk_bf16(v1[2], v1[3]);
                    *(LAS u32x4*)(wp + bj * 64) = w; }
                EPI_CBAR();
#pragma unroll
                for (int p = 0; p < 2; ++p) { const u32x4 t = *(LAS const u32x4*)(rp + p * 8 * 144);
                    u32x4 w; w.x = cvt_pk_bf16(xa[p][0][0] + bf_lo(t.x), xa[p][0][1] + bf_hi(t.x)); w.y = cvt_pk_bf16(xa[p][0][2] + bf_lo(t.y), xa[p][0][3] + bf_hi(t.y));
                    w.z = cvt_pk_bf16(xa[p][1][0] + bf_lo(t.z), xa[p][1][1] + bf_hi(t.z)); w.w = cvt_pk_bf16(xa[p][1][2] + bf_lo(t.w), xa[p][1][3] + bf_hi(t.w));
                    __builtin_nontemporal_store(w, (u32x4*)(C + go + (size_t)(ai * HALF + m * 16 + 8 * p) * D)); }
                EPI_CBAR(); }
    }
};
struct EpiSwiglu {
    static constexpr int PERM = 1; static constexpr bool F8 = true;
    unsigned char* O; const float* bias;
    __device__ __forceinline__ void operator()(const f32x4 (&acc)[2][2][4][2], const Unit& u, int wr, int wc, int fr, int fq, LAS unsigned char* tl) const {
        const int fl = wc * 32 + 8 * fq, lane = fr + 16 * fq;
        const float* bp = bias + (size_t)u.e * 2048 + u.c0 + fl;
        f32x4 bg[2], bu[2];
#pragma unroll
        for (int n = 0; n < 2; ++n) { bg[n] = *(const f32x4*)(bp + 4 * n); bu[n] = *(const f32x4*)(bp + HALF + 4 * n); }
        LAS unsigned char* wp = tl + fr * 40 + fq * 8; LAS const unsigned char* rp = tl + (lane >> 2) * 40 + (lane & 3) * 8;
        unsigned char* gp = O + (size_t)(u.r0 + wr * 64 + (lane >> 2)) * FF + (u.c0 >> 1) + wc * 32 + (lane & 3) * 8;
#pragma unroll
        for (int ai = 0; ai < 2; ++ai)
#pragma unroll
            for (int m = 0; m < 4; ++m) {
                float a[8];
#pragma unroll
                for (int n = 0; n < 2; ++n)
#pragma unroll
                    for (int j = 0; j < 4; ++j) { float g = acc[ai][0][m][n][j] * W8_INV + bg[n][j], up = acc[ai][1][m][n][j] * W8_INV + bu[n][j];
                        g = fminf(g, 7.0f); up = fminf(fmaxf(up, -7.0f), 7.0f);
                        a[n * 4 + j] = clamp448(g * sigmoidf_(1.702f * g) * (up + 1.0f)); }
                *(LAS u32x2*)wp = (u32x2){cvt_pk4_fp8(a[0], a[1], a[2], a[3]), cvt_pk4_fp8(a[4], a[5], a[6], a[7])};
                EPI_CBAR();
                const u32x2 t = *(LAS const u32x2*)rp; *(u32x2*)(gp + (size_t)(ai * HALF + m * 16) * FF) = t;
                EPI_CBAR(); }
    }
};
struct EpiDown {
    static constexpr int PERM = 2; static constexpr bool F8 = true;
    bf16_t* O; const float* bias;
    __device__ __forceinline__ void operator()(const f32x4 (&acc)[2][2][4][2], const Unit& u, int wr, int wc, int fr, int fq, LAS unsigned char* tl) const {
        const int col0 = u.c0 + wc * 64 + 8 * fq, lane = fr + 16 * fq;
        const float* bp = bias + (size_t)u.e * D + col0;
        f32x4 bv[2][2];
#pragma unroll
        for (int bj = 0; bj < 2; ++bj)
#pragma unroll
            for (int n = 0; n < 2; ++n) bv[bj][n] = *(const f32x4*)(bp + bj * 32 + 4 * n);
        LAS unsigned char* wp = tl + fr * 144 + fq * 16; LAS const unsigned char* rp = tl + (lane >> 3) * 144 + (lane & 7) * 16;
        bf16_t* gp = O + (size_t)(u.r0 + wr * 64 + (lane >> 3)) * D + u.c0 + wc * 64 + (lane & 7) * 8;
#pragma unroll
        for (int ai = 0; ai < 2; ++ai)
#pragma unroll
            for (int m = 0; m < 4; ++m) {
#pragma unroll
                for (int bj = 0; bj < 2; ++bj) { const f32x4 v0 = acc[ai][bj][m][0] * W8_INV + bv[bj][0], v1 = acc[ai][bj][m][1] * W8_INV + bv[bj][1];
                    u32x4 w; w.x = cvt_pk_bf16(v0[0], v0[1]); w.y = cvt_pk_bf16(v0[2], v0[3]); w.z = cvt_pk_bf16(v1[0], v1[1]); w.w = cvt_pk_bf16(v1[2], v1[3]);
                    *(LAS u32x4*)(wp + bj * 64) = w; }
                EPI_CBAR();
#pragma unroll
                for (int p = 0; p < 2; ++p) { const u32x4 t = *(LAS const u32x4*)(rp + p * 8 * 144); __builtin_nontemporal_store(t, (u32x4*)(gp + (size_t)(ai * HALF + m * 16 + 8 * p) * D)); }
                EPI_CBAR(); }
    }
};
}

#define XB_TMO      128
#define XB_XCNT(j)  (256  + 64 * (j))
#define XB_XSUB(j)  (1280 + 64 * (j))
#define XB_XGEN(j)  (2304 + 64 * (j))
#define XB_TOP      3328
#define XB_TOPGEN   3392
#define XCD_BAR_WORDS 3456
#define XB_SPIN_CAP (1u << 18)
__device__ __forceinline__ unsigned xb_ld(unsigned* p)              { return __hip_atomic_load(p, __ATOMIC_RELAXED, __HIP_MEMORY_SCOPE_AGENT); }
__device__ __forceinline__ unsigned xb_add(unsigned* p, unsigned v) { return __hip_atomic_fetch_add(p, v, __ATOMIC_RELAXED, __HIP_MEMORY_SCOPE_AGENT); }
__device__ __forceinline__ unsigned xb_xcc_id() { return (unsigned)__builtin_amdgcn_s_getreg((3 << 11) | 20) & 0xFu; }
#define XB_SPIN(cond, bar) do { unsigned _sp = 0; while (cond) { __builtin_amdgcn_s_sleep(1); \
    if ((++_sp & 255u) == 0u) { if (xb_ld(&(bar)[XB_TMO])) break; if (_sp > XB_SPIN_CAP) { atomicAdd(&(bar)[XB_TMO], 1u); break; } } } } while (0)
struct XcdBarrier { unsigned* bar; unsigned x; volatile LAS unsigned* st; };
__device__ __forceinline__ XcdBarrier xcd_barrier_post(unsigned* bar, volatile LAS unsigned* st) {
    XcdBarrier b; b.bar = bar; b.x = xb_xcc_id(); b.st = st;
    if (threadIdx.x == 0) (void)xb_add(&bar[XB_XCNT(b.x)], 1u);
    return b;
}
__device__ __forceinline__ void xcd_barrier_complete(unsigned* bar, unsigned x, unsigned& nloc, unsigned& nx) {
    const unsigned G = gridDim.x * gridDim.y * gridDim.z;
    unsigned sum, cnt, mine, sp = 0u;
    for (;;) {
        sum = 0u; cnt = 0u; mine = 0u;
#pragma unroll
        for (unsigned j = 0; j < 16; ++j) { const unsigned c = xb_ld(&bar[XB_XCNT(j)]); sum += c; cnt += (c > 0u) ? 1u : 0u; mine = (j == x) ? c : mine; }
        if (sum == G) break;
        __builtin_amdgcn_s_sleep(1);
        if ((++sp & 255u) == 0u) { if (xb_ld(&bar[XB_TMO])) break; if (sp > XB_SPIN_CAP) { atomicAdd(&bar[XB_TMO], 1u); break; } }
    }
    nloc = mine > 0u ? mine : 1u; nx = cnt > 0u ? cnt : 1u;
}
__device__ __forceinline__ void xcd_barrier(const XcdBarrier& b) {
    asm volatile("s_waitcnt vmcnt(0)" ::: "memory");
    __syncthreads();
    if (threadIdx.x == 0) {
        unsigned* bar = b.bar;
        __builtin_amdgcn_s_waitcnt(0);
        unsigned nloc = b.st[0], nx = b.st[1];
        if (nloc == 0u) { xcd_barrier_complete(bar, b.x, nloc, nx); b.st[0] = nloc; b.st[1] = nx; }
        const unsigned old = xb_add(&bar[XB_XSUB(b.x)], 1u);
        const unsigned gen = old / nloc;
        if (old + 1u == (gen + 1u) * nloc) {
            __builtin_amdgcn_fence(__ATOMIC_RELEASE, "agent");
            asm volatile("s_waitcnt vmcnt(0)" ::: "memory");
            const unsigned og = xb_add(&bar[XB_TOP], 1u);
            const unsigned tg = og / nx;
            if (og + 1u == (tg + 1u) * nx) xb_add(&bar[XB_TOPGEN], 1u);
            else XB_SPIN(xb_ld(&bar[XB_TOPGEN]) == tg, bar);
            __builtin_amdgcn_fence(__ATOMIC_ACQUIRE, "agent");
            xb_add(&bar[XB_XGEN(b.x)], 1u);
            asm volatile("s_waitcnt vmcnt(0)" ::: "memory");
        } else {
            XB_SPIN(xb_ld(&bar[XB_XGEN(b.x)]) == gen, bar);
            __builtin_amdgcn_fence(__ATOMIC_ACQUIRE, "agent");
            asm volatile("s_waitcnt vmcnt(0)" ::: "memory");
        }
    }
    __syncthreads();
}

struct Args {
    const float* in[28]; float* out; unsigned char* ws; int ph_lo, ph_hi;
};
struct Frame {
    LAS unsigned char* lds; volatile LAS unsigned* MISC; unsigned* ctl;
    int tid, lane, wave, G, bid;
};
enum { I_X = 0, I_N1G, I_WIN, I_BGATE, I_TMIX, I_WDU, I_W0, I_AUP, I_A0, I_GUP, I_KK, I_KA, I_RK, I_GNW, I_GNB, I_LNVG, I_LNVB, I_WSP, I_BSP, I_WOUT, I_N2G, I_WR, I_BR, I_WGU, I_BGU, I_WD, I_BDN, I_NFG };

template <class RowMap>
__device__ __forceinline__ void p0_transpose_item(const float* W, int K, int N, bf16_t* WT, const RowMap& rm, LAS float* scr, int item, int lane, unsigned char* WT8 = nullptr) {
    const int nblk = N / 32, kb = item / nblk, nb = item % nblk, k0 = 64 * kb, n0 = 32 * nb;
#pragma unroll 8
    for (int i = 0; i < 32; ++i) { const int kk = 2 * i + (lane >> 5); scr[kk * 33 + (lane & 31)] = W[(size_t)(k0 + kk) * N + n0 + (lane & 31)]; }
    LDS_WAIT(); asm volatile("" ::: "memory");
    const int c = lane & 7;
#pragma unroll
    for (int j = 0; j < 4; ++j) { const int n = (lane >> 3) + 8 * j; const LAS float* s = scr + (8 * c) * 33 + n;
        u32x4 o; o.x = cvt_pk_bf16(s[0 * 33], s[1 * 33]); o.y = cvt_pk_bf16(s[2 * 33], s[3 * 33]); o.z = cvt_pk_bf16(s[4 * 33], s[5 * 33]); o.w = cvt_pk_bf16(s[6 * 33], s[7 * 33]);
        *(u32x4*)(WT + (size_t)rm(n0 + n) * K + k0 + 8 * c) = o;
        if (WT8) *(u32x2*)(WT8 + (size_t)rm(n0 + n) * K + k0 + 8 * c) = (u32x2){cvt_pk4_fp8(s[0 * 33] * W8_SCALE, s[1 * 33] * W8_SCALE, s[2 * 33] * W8_SCALE, s[3 * 33] * W8_SCALE), cvt_pk4_fp8(s[4 * 33] * W8_SCALE, s[5 * 33] * W8_SCALE, s[6 * 33] * W8_SCALE, s[7 * 33] * W8_SCALE)}; }
    LDS_WAIT(); asm volatile("" ::: "memory");
}
struct RmId { __device__ __forceinline__ int operator()(int n) const { return n; } };
struct RmIn { __device__ __forceinline__ int operator()(int n) const { return n < 3360 ? n : n + 224; } };
__device__ __forceinline__ void tr_issue(const float* W, int N, int item, int lane, float (&v)[32]) {
    const int nblk = N / 32, kb = item / nblk, nb = item % nblk, k0 = 64 * kb, n0 = 32 * nb;
    const float* base = W + (size_t)k0 * N + n0;
    const int lo = (lane >> 5) * N + (lane & 31);
#pragma unroll
    for (int i = 0; i < 32; ++i) v[i] = (base + (size_t)(2 * i) * N)[lo];
}
template <class RowMap>
__device__ __forceinline__ void tr_finish(const float (&v)[32], int K, int N, unsigned char* WT, const RowMap& rm, LAS float* scr, int item, int lane) {
    const int nblk = N / 32, kb = item / nblk, nb = item % nblk, k0 = 64 * kb, n0 = 32 * nb;
#pragma unroll
    for (int i = 0; i < 32; ++i) { const int kk = 2 * i + (lane >> 5); scr[kk * 33 + (lane & 31)] = v[i]; }
    LDS_WAIT(); asm volatile("" ::: "memory");
    const int c = lane & 7;
#pragma unroll
    for (int j = 0; j < 4; ++j) { const int n = (lane >> 3) + 8 * j; const LAS float* s = scr + (8 * c) * 33 + n;
        const u32x2 o = (u32x2){cvt_pk4_fp8(s[0 * 33] * W8_SCALE, s[1 * 33] * W8_SCALE, s[2 * 33] * W8_SCALE, s[3 * 33] * W8_SCALE), cvt_pk4_fp8(s[4 * 33] * W8_SCALE, s[5 * 33] * W8_SCALE, s[6 * 33] * W8_SCALE, s[7 * 33] * W8_SCALE)};
        *(u32x2*)(WT + (size_t)rm(n0 + n) * K + k0 + 8 * c) = o; }
    LDS_WAIT(); asm volatile("" ::: "memory");
}
struct RmGu { __device__ __forceinline__ int operator()(int n) const { const int f = n >> 1, up = n & 1; return (f >> 7) * 256 + up * 128 + (f & 127); } };

__device__ __forceinline__ void p0_prologue(Frame& F, const Args& a) {
    unsigned char* ws = a.ws;
    bf16_t* Bin = (bf16_t*)(ws + WS_BIN); bf16_t* Bout = (bf16_t*)(ws + WS_BOUT); bf16_t* Bgu = (bf16_t*)(ws + WS_BGU); bf16_t* Bd = (bf16_t*)(ws + WS_BD);
    LAS float* scr = (LAS float*)(F.lds + RING_OFF + F.wave * 16384);
    const int gw = F.bid * NWAVES + F.wave, NGW = F.G * NWAVES;
    constexpr int I_IN = (D / 64) * (7456 / 32), I_OUT = (D / 64) * (D / 32), I_GU1 = (D / 64) * (2048 / 32), I_D1 = (FF / 64) * (D / 32);
    constexpr int NITEMS = I_IN + I_OUT;
    for (int it = gw; it < NITEMS; it += NGW) {
        int r = it;
        if (r < I_IN) { p0_transpose_item(a.in[I_WIN], D, 7456, Bin, RmIn(), scr, r, ((int)(threadIdx.x & 63u)), ws + WS_BIN8); continue; } r -= I_IN;
        p0_transpose_item(a.in[I_WOUT], D, D, Bout, RmId(), scr, r, ((int)(threadIdx.x & 63u)));
        (void)Bgu; (void)Bd; (void)I_GU1; (void)I_D1;
    }
    const int gt = F.bid * (NWAVES * 64) + ((int)threadIdx.x), NGT = F.G * NWAVES * 64;
    {
        u32x4* p = (u32x4*)(Bin + (size_t)3360 * D);
        for (int i = gt; i < 224 * 128; i += NGT) p[i] = (u32x4){0u, 0u, 0u, 0u};
    }
    {   float* bz = (float*)(ws + WS_MISC + MO_BIASZ);
        for (int i = gt; i < NZ; i += NGT) bz[i] = (i >= ZC_GA) ? a.in[I_BGATE][i - ZC_GA] : 0.f;
    }
    {   float* bg = (float*)(ws + WS_MISC + MO_BGU);
        for (int i = gt; i < NE * 2048; i += NGT) { const int e = i >> 11, n = i & 2047; bg[(size_t)e * 2048 + RmGu()(n)] = a.in[I_BGU][i]; }
    }
    {   bf16_t* wh = (bf16_t*)(ws + WS_MISC + MO_WRT); bf16_t* wl = wh + NE * D;
        for (int i = gt; i < NE * D; i += NGT) { const int e = i >> 10, k = i & 1023; const float w = a.in[I_WR][(size_t)k * NE + e];
            const unsigned h = cvt_pk_bf16(w, 0.f) & 0xffffu; const float rlo = w - bf_lo(h); wh[i] = (bf16_t)h; wl[i] = (bf16_t)(cvt_pk_bf16(rlo, 0.f) & 0xffffu); }
    }
    {   bf16_t* lt = (bf16_t*)(ws + WS_MISC + MO_LT);
        for (int i = gt; i < D * 288; i += NGT) { const int n = i / 288, k = i - n * 288;
            const float w = (k < 64) ? a.in[I_WDU][(size_t)k * D + n] : (k < 128 ? a.in[I_AUP][(size_t)(k - 64) * D + n] : a.in[I_GUP][(size_t)(k - 128) * D + n]);
            lt[i] = (bf16_t)(cvt_pk_bf16(w, 0.f) & 0xffffu); }
    }
    const float* x = a.in[I_X]; const float* g1 = a.in[I_N1G]; bf16_t* Hh = (bf16_t*)(ws + WS_H);
    f32x4 gv[4];
#pragma unroll
    for (int j = 0; j < 4; ++j) gv[j] = *((const f32x4*)g1 + ((int)(threadIdx.x & 63u)) + 64 * j);
    for (int m = gw; m < T; m += NGW) {
        const f32x4* xr = (const f32x4*)(x + (size_t)m * D) + ((int)(threadIdx.x & 63u));
        f32x4 v[4]; float s = 0.f;
#pragma unroll
        for (int j = 0; j < 4; ++j) { v[j] = xr[64 * j]; s += (v[j].x * v[j].x + v[j].y * v[j].y) + (v[j].z * v[j].z + v[j].w * v[j].w); }
        const float rstd = __builtin_amdgcn_rsqf(wave_sum(s) * (1.f / D) + RMS_EPS);
        u32x2* o8 = (u32x2*)(Hh + (size_t)m * D) + ((int)(threadIdx.x & 63u));
#pragma unroll
        for (int j = 0; j < 4; ++j) { const f32x4 y = v[j] * rstd * gv[j]; o8[64 * j] = (u32x2){cvt_pk_bf16(y.x, y.y), cvt_pk_bf16(y.z, y.w)};
            ((unsigned*)(ws + WS_H8 + (size_t)m * D))[((int)(threadIdx.x & 63u)) + 64 * j] = cvt_pk4_fp8(clamp448(y.x), clamp448(y.y), clamp448(y.z), clamp448(y.w)); }
    }
}

constexpr int TC = 32, NMC = TC / 4, NCH = 2048 / TC;
constexpr int RC_AT = 0;
constexpr int RC_RT = RC_AT + TC * 128;
constexpr int RC_BT = RC_RT + TC * 128;
constexpr int RC_KT = RC_BT + TC * 128;
constexpr int SB_CUMF = RC_KT + TC * 128;
constexpr int RC_VB = SB_CUMF + TC * 256;
constexpr int RC_P4 = RC_VB + TC * 128;
constexpr int RC_SCL = RC_P4 + NMC * 256;
constexpr int SB_RB = RC_SCL + NMC * 128;
constexpr int SB_KP = SB_RB + TC * 128;
constexpr int SB_V = SB_KP + TC * 256;
constexpr int SB_G = SB_V + TC * 256;
constexpr int SB_GA0 = SB_G + TC * 256;
constexpr int SB_WRAW = SB_GA0 + 2 * TC * 128;
constexpr int SB_ARAW = SB_WRAW + TC * 256;
constexpr int SB_Y = SB_WRAW;
constexpr int SB_LABF = SB_ARAW;
constexpr int SB_TIMG = SB_LABF + 2048;
constexpr int SB_LAKIMG = SB_TIMG + 2048;
constexpr int SB_MRIMG = SB_LAKIMG + 2048;
constexpr int SB_RAWRKV = SB_ARAW + TC * 256;
constexpr int SB_ALT = SB_RAWRKV + (TC + 1) * 384;
constexpr int SB_END = SB_ALT + TC * 576;
constexpr int SB_PBAR = LDSCTL_OFF + 1536;
constexpr int SB_CST = LDSCTL_OFF + 2048;
static_assert(SB_END + 4 * 8448 <= LDSCTL_OFF && SB_CST + 2560 <= LDS_BYTES, "scan LDS map (+ 4 conversion scratch tiles)");
constexpr int NP_RKV = (TC + 1) * 24;

__device__ __forceinline__ f32x4 ld_bf4(const bf16_t* p) { const u32x2 v = *(const u32x2*)p; return (f32x4){bf_lo(v.x), bf_hi(v.x), bf_lo(v.y), bf_hi(v.y)}; }
__device__ __forceinline__ f32x4 lds_bf4(const LAS unsigned char* p) { const u32x2 v = *(const LAS u32x2*)p; return (f32x4){bf_lo(v.x), bf_hi(v.x), bf_lo(v.y), bf_hi(v.y)}; }
__device__ __forceinline__ void ld_bf8(const bf16_t* p, float (&o)[8]) { const u32x4 v = *(const u32x4*)p;
    o[0] = bf_lo(v.x); o[1] = bf_hi(v.x); o[2] = bf_lo(v.y); o[3] = bf_hi(v.y); o[4] = bf_lo(v.z); o[5] = bf_hi(v.z); o[6] = bf_lo(v.w); o[7] = bf_hi(v.w); }
__device__ __forceinline__ void un8(const u32x4 v, float (&o)[8]) {
    o[0] = bf_lo(v.x); o[1] = bf_hi(v.x); o[2] = bf_lo(v.y); o[3] = bf_hi(v.y); o[4] = bf_lo(v.z); o[5] = bf_hi(v.z); o[6] = bf_lo(v.w); o[7] = bf_hi(v.w); }
__device__ __forceinline__ bf16x8 pack8(const float (&o)[8]) { u32x4 w; w.x = cvt_pk_bf16(o[0], o[1]); w.y = cvt_pk_bf16(o[2], o[3]); w.z = cvt_pk_bf16(o[4], o[5]); w.w = cvt_pk_bf16(o[6], o[7]); return __builtin_bit_cast(bf16x8, w); }

__device__ __forceinline__ void p2a_act(Frame& F, const Args& a) {
    const bf16_t* Z = (const bf16_t*)(a.ws + WS_Z); bf16_t* AL = (bf16_t*)(a.ws + WS_AL);
    const float* tml = a.in[I_TMIX] + TM_DL;
    const int gt = F.bid * (NWAVES * 64) + ((int)threadIdx.x), NGT = F.G * NWAVES * 64;
    for (int it = gt; it < T * 36; it += NGT) { const int t = it / 36, p = it - t * 36;
        float c[8], pv[8], m8[8];
        ld_bf8(Z + (size_t)t * NZ2 + Z2_L + 8 * p, c);
        if ((t & (SEQ - 1)) != 0) ld_bf8(Z + (size_t)(t - 1) * NZ2 + Z2_L + 8 * p, pv); else {
#pragma unroll
            for (int j = 0; j < 8; ++j) pv[j] = 0.f; }
        const f32x4 ta = *(const f32x4*)(tml + 8 * p), tb = *(const f32x4*)(tml + 8 * p + 4);
#pragma unroll
        for (int j = 0; j < 8; ++j) { const float tmj = (j < 4) ? ta[j] : tb[j - 4]; m8[j] = c[j] + (pv[j] - c[j]) * tmj; }
        if (p < 8) {
#pragma unroll
            for (int j = 0; j < 8; ++j) m8[j] = 1.0f - 2.0f * __builtin_amdgcn_rcpf(1.0f + __expf(2.0f * m8[j])); }
        else if (p >= 16) {
#pragma unroll
            for (int j = 0; j < 8; ++j) m8[j] = sigmoidf_(m8[j]); }
        *(bf16x8*)(AL + (size_t)t * 288 + 8 * p) = pack8(m8);
    }
}

template <int SUB> __device__ __forceinline__ void scan_sub(f32x4 (&acc)[4], const LAS unsigned char* L, int fn, int g, int row) {
    const LAS unsigned char* xa = L + RC_AT + (16 * SUB + fn) * 128 + 8 * g; const LAS unsigned char* xr = L + RC_RT + (16 * SUB + fn) * 128 + 8 * g;
    u32x4 xa0, xa1, xr0, xr1;
    { const u32x2 p0 = *(const LAS u32x2*)(xa), p1 = *(const LAS u32x2*)(xa + 32), p2 = *(const LAS u32x2*)(xa + 64), p3 = *(const LAS u32x2*)(xa + 96);
      xa0 = (u32x4){p0.x, p0.y, p1.x, p1.y}; xa1 = (u32x4){p2.x, p2.y, p3.x, p3.y}; }
    { const u32x2 p0 = *(const LAS u32x2*)(xr), p1 = *(const LAS u32x2*)(xr + 32), p2 = *(const LAS u32x2*)(xr + 64), p3 = *(const LAS u32x2*)(xr + 96);
      xr0 = (u32x4){p0.x, p0.y, p1.x, p1.y}; xr1 = (u32x4){p2.x, p2.y, p3.x, p3.y}; }
    const bf16x8 tf = *(const LAS bf16x8*)(L + SB_TIMG + ((SUB * 16 + fn) * 4 + g) * 16), lakf = *(const LAS bf16x8*)(L + SB_LAKIMG + ((SUB * 16 + fn) * 4 + g) * 16),
                 mrf = *(const LAS bf16x8*)(L + SB_MRIMG + ((SUB * 16 + fn) * 4 + g) * 16);
    const int trow = (16 * SUB + 4 * g + (fn >> 2)) * 128 + 8 * (fn & 3);
    const u32x2 vt = __builtin_bit_cast(u32x2, __builtin_amdgcn_ds_read_tr16_b64_v4i16((LAS s16x4*)(L + RC_VB + trow + (row - fn) * 2)));
    bf16x8 bk[4]; f32x4 p16[4];
#pragma unroll
    for (int jb = 0; jb < 4; ++jb) { const u32x2 bq = __builtin_bit_cast(u32x2, __builtin_amdgcn_ds_read_tr16_b64_v4i16((LAS s16x4*)(L + RC_BT + trow + 32 * jb))),
                                                 kq = __builtin_bit_cast(u32x2, __builtin_amdgcn_ds_read_tr16_b64_v4i16((LAS s16x4*)(L + RC_KT + trow + 32 * jb)));
        bk[jb] = __builtin_bit_cast(bf16x8, (u32x4){bq.x, bq.y, kq.x, kq.y}); p16[jb] = *(const LAS f32x4*)(L + RC_P4 + (SUB * 64 + 16 * jb + 4 * g) * 4); }
    const u32x4 vq = (u32x4){vt.x, vt.y, 0u, 0u};
    const f32x4 lv = __builtin_amdgcn_mfma_f32_16x16x32_bf16(lakf, __builtin_bit_cast(bf16x8, vq), (f32x4){0.f, 0.f, 0.f, 0.f}, 0, 0, 0);
    float t0[8] = {acc[0][0], acc[0][1], acc[0][2], acc[0][3], acc[1][0], acc[1][1], acc[1][2], acc[1][3]}, t1[8] = {acc[2][0], acc[2][1], acc[2][2], acc[2][3], acc[3][0], acc[3][1], acc[3][2], acc[3][3]};
    const bf16x8 sf0 = pack8(t0), sf1 = pack8(t1);
    f32x4 gq = __builtin_amdgcn_mfma_f32_16x16x32_bf16(__builtin_bit_cast(bf16x8, xa0), sf0, lv, 0, 0, 0);
    gq = __builtin_amdgcn_mfma_f32_16x16x32_bf16(__builtin_bit_cast(bf16x8, xa1), sf1, gq, 0, 0, 0);
    f32x4 hq = __builtin_amdgcn_mfma_f32_16x16x32_bf16(__builtin_bit_cast(bf16x8, xr0), sf0, (f32x4){0.f, 0.f, 0.f, 0.f}, 0, 0, 0);
    hq = __builtin_amdgcn_mfma_f32_16x16x32_bf16(__builtin_bit_cast(bf16x8, xr1), sf1, hq, 0, 0, 0);
    const u32x4 gl = (u32x4){cvt_pk_bf16(gq[0], gq[1]), cvt_pk_bf16(gq[2], gq[3]), 0u, 0u};
    const f32x4 uq = __builtin_amdgcn_mfma_f32_16x16x32_bf16(tf, __builtin_bit_cast(bf16x8, gl), (f32x4){0.f, 0.f, 0.f, 0.f}, 0, 0, 0);
    const u32x4 uv = (u32x4){cvt_pk_bf16(uq[0], uq[1]), cvt_pk_bf16(uq[2], uq[3]), vt.x, vt.y};
    const bf16x8 uvf = __builtin_bit_cast(bf16x8, uv);
    const f32x4 yq = __builtin_amdgcn_mfma_f32_16x16x32_bf16(mrf, uvf, hq, 0, 0, 0);
#pragma unroll
    for (int jb = 0; jb < 4; ++jb) acc[jb] = __builtin_amdgcn_mfma_f32_16x16x32_bf16(bk[jb], uvf, acc[jb], 0, 0, 0);
#pragma unroll
    for (int r = 0; r < 4; ++r) *(LAS float*)((LAS unsigned char*)L + SB_Y + (16 * SUB + 4 * g + r) * 256 + 4 * row) = yq[r];
#pragma unroll
    for (int jb = 0; jb < 4; ++jb) acc[jb] = acc[jb] * p16[jb];
    __builtin_amdgcn_sched_barrier(0);
    if constexpr (SUB + 1 < TC / 16) scan_sub<SUB + 1>(acc, L, fn, g, row);
}
__device__ __forceinline__ void pbar(LAS unsigned* cnt, unsigned target) {
    asm volatile("s_waitcnt lgkmcnt(0)" ::: "memory");
    if ((threadIdx.x & 63u) == 0u) __hip_atomic_fetch_add(cnt, 1u, __ATOMIC_RELAXED, __HIP_MEMORY_SCOPE_WORKGROUP);
    while (__hip_atomic_load(cnt, __ATOMIC_RELAXED, __HIP_MEMORY_SCOPE_WORKGROUP) < target) __builtin_amdgcn_s_sleep(1);
    asm volatile("" ::: "memory");
}

__device__ __forceinline__ void parrive(LAS unsigned* cnt) {
    asm volatile("s_waitcnt lgkmcnt(0)" ::: "memory");
    if ((threadIdx.x & 63u) == 0u) __hip_atomic_fetch_add(cnt, 1u, __ATOMIC_RELAXED, __HIP_MEMORY_SCOPE_WORKGROUP);
}
constexpr int SB_DUMMY = 150528;
__device__ __forceinline__ void glds_touch(const void* g, unsigned ldsoff) {
    unsigned sv;
    asm volatile("s_mov_b32 %0, m0\n\ts_mov_b32 m0, %2\n\ts_nop 0\n\tglobal_load_lds_dwordx4 %1, off\n\ts_mov_b32 m0, %0" : "=&s"(sv) : "v"(g), "s"(ldsoff) : "memory");
}
__device__ __forceinline__ void p2_scan(Frame& F, const Args& a, size_t mo_off = WS_M) {
    const unsigned char* HMb = a.ws + WS_HM; bf16_t* Mo = (bf16_t*)(a.ws + mo_off); const bf16_t* AL = (const bf16_t*)(a.ws + WS_AL);
    LAS unsigned char* L = F.lds;
    LAS unsigned* PB = (LAS unsigned*)(F.lds + SB_PBAR);
    const int w = F.wave, tid = ((int)threadIdx.x);
    const float* tmix = a.in[I_TMIX];
    for (int unit = F.bid; unit < NB_ * NH; unit += F.G) {
        const int b = unit / NH, h = unit % NH;
        const size_t trow0 = (size_t)b * SEQ;
        {   LAS float* CST = (LAS float*)(F.lds + SB_CST);
            for (int i = tid; i < 640; i += NWAVES * 64) { const int a_ = i >> 6, c_ = h * HD + (i & 63);
                const float* sp = (a_ == 0) ? tmix + TM_R : (a_ == 1) ? tmix + TM_K : (a_ == 2) ? tmix + TM_V : (a_ == 3) ? a.in[I_W0] : (a_ == 4) ? a.in[I_A0] : (a_ == 5) ? a.in[I_KK] : (a_ == 6) ? a.in[I_KA] : (a_ == 7) ? a.in[I_RK] : (a_ == 8) ? a.in[I_GNW] : a.in[I_GNB];
                CST[i] = sp[c_]; }
            if (tid == 0) *PB = 0u;
        }
        bf16x8 Bw[2], Ba[2], Bg[5];
        {   const int lane0 = tid & 63; const bf16_t* lp = (const bf16_t*)(a.ws + WS_MISC + MO_LT) + (size_t)(h * HD + (w & 3) * 16 + (lane0 & 15)) * 288 + 8 * (lane0 >> 4);
#pragma unroll
            for (int sx = 0; sx < 2; ++sx) { Bw[sx] = *(const bf16x8*)(lp + 32 * sx); Ba[sx] = *(const bf16x8*)(lp + 64 + 32 * sx); }
#pragma unroll
            for (int sx = 0; sx < 5; ++sx) Bg[sx] = *(const bf16x8*)(lp + 128 + 32 * sx);
        }
        unsigned pbt = 0u;
        f32x4 acc[4];
#pragma unroll
        for (int g = 0; g < 4; ++g) acc[g] = (f32x4){0.f, 0.f, 0.f, 0.f};
        __syncthreads();
        for (int ch = -1; ch < NCH; ++ch) {
            int tidv = tid; asm volatile("" : "+v"(tidv));
            const int lane = tidv & 63, fn = lane & 15, kg = lane >> 4;
            const int tl = tidv >> 4, q = tidv & 15, col4 = h * HD + 4 * q;
            const LAS f32x4* CQ = (const LAS f32x4*)(F.lds + SB_CST) + q;
            if (w < 4) {
                if (ch >= 0) {
                    scan_sub<0>(acc, L, fn, kg, 16 * w + fn);
                }
            } else {
                const int ts = tidv - 256, pw = w - 4;
                const bool do_cv = (ch >= 0 && (ch & 3) < 3 && F.G == 256);
                const int cvi = F.bid * 192 + pw * 48 + (ch >> 2) * 3 + (ch & 3);
                float cv[32];
                if (do_cv) { if (cvi < NE * 1024) tr_issue(a.in[I_WGU] + (size_t)(cvi >> 10) * D * 2048, 2048, cvi & 1023, lane, cv);
                             else { const int r_ = cvi - NE * 1024; tr_issue(a.in[I_WD] + (size_t)(r_ >> 9) * FF * D, D, r_ & 511, lane, cv); } }
                if (ch + 1 < NCH) {
                    const unsigned char* cb_ = HMb + ((long)unit * SEQ + (long)(ch + 1) * TC - 1) * 512L;
                    const unsigned char* ab_ = (const unsigned char*)(AL + (trow0 + (size_t)(ch + 1) * TC) * 288);
                    u32x4 R4[4], G1, A5[5];
#pragma unroll
                    for (int j = 0; j < 4; ++j) { const int pid = ts + 256 * j; R4[j] = (u32x4){0u, 0u, 0u, 0u};
                        if (pid < NP_RKV && !(ch + 1 == 0 && pid < 24)) { const int row = pid / 24, pc = pid % 24, arr = pc >> 3, c8 = pc & 7; R4[j] = *(const u32x4*)(cb_ + row * 512 + (arr * 8 + c8) * 16); } }
                    G1 = *(const u32x4*)(cb_ + ((ts >> 3) + 1) * 512 + 384 + (ts & 7) * 16);
#pragma unroll
                    for (int j = 0; j < 5; ++j) if (ts + 256 * j < TC * 36) A5[j] = *(const u32x4*)(ab_ + (ts + 256 * j) * 16);
#pragma unroll
                    for (int j = 0; j < 4; ++j) if (ts + 256 * j < NP_RKV) *(LAS u32x4*)(L + SB_RAWRKV + (ts + 256 * j) * 16) = R4[j];
                    *(LAS u32x4*)(L + SB_GA0 + ((ch + 1) & 1) * (TC * 128) + ts * 16) = G1;
#pragma unroll
                    for (int j = 0; j < 5; ++j) if (ts + 256 * j < TC * 36) *(LAS u32x4*)(L + SB_ALT + (ts + 256 * j) * 16) = A5[j];
                }
                if (do_cv) { LAS float* scr = (LAS float*)(L + SB_END + pw * 8448);
                    if (cvi < NE * 1024) tr_finish(cv, D, 2048, (unsigned char*)(a.ws + WS_BGU) + (size_t)(cvi >> 10) * 2048 * D, RmGu(), scr, cvi & 1023, lane);
                    else { const int r_ = cvi - NE * 1024; tr_finish(cv, FF, D, (unsigned char*)(a.ws + WS_BD) + (size_t)(r_ >> 9) * D * FF, RmId(), scr, r_ & 511, lane); } }
            }
            __syncthreads();
            const int mb = w >> 2, nb = w & 3;
            if (ch >= 0) {
                const int t = ch * TC + tl; const int o = tl * 256 + 16 * q;
                const f32x4 kpv = *(const LAS f32x4*)(L + SB_KP + o), vv = *(const LAS f32x4*)(L + SB_V + o), gv = *(const LAS f32x4*)(L + SB_G + o);
                const f32x4 y = *(const LAS f32x4*)(L + SB_Y + o);
                const f32x4 rv = lds_bf4(L + SB_RB + tl * 128 + 8 * q);
                const float mean = allsum16((y[0] + y[1]) + (y[2] + y[3])) * (1.0f / 64.0f);
                const f32x4 dv = y - mean;
                const float var = allsum16((dv[0] * dv[0] + dv[1] * dv[1]) + (dv[2] * dv[2] + dv[3] * dv[3])) * (1.0f / 64.0f);
                const float rstd = __builtin_amdgcn_rsqf(var + GN_EPS);
                const f32x4 c_rk = CQ[16 * 7], c_gw = CQ[16 * 8], c_gb = CQ[16 * 9];
                const float bonus = allsum16((rv[0] * kpv[0] * c_rk[0] + rv[1] * kpv[1] * c_rk[1]) + (rv[2] * kpv[2] * c_rk[2] + rv[3] * kpv[3] * c_rk[3]));
                const f32x4 ga = lds_bf4(L + SB_GA0 + (ch & 1) * (TC * 128) + tl * 128 + 8 * q);
                f32x4 ov;
#pragma unroll
                for (int j = 0; j < 4; ++j) ov[j] = ((dv[j] * rstd * c_gw[j] + c_gb[j]) + bonus * vv[j]) * gv[j] * ga[j];
                *(u32x2*)(Mo + (trow0 + t) * D + col4) = (u32x2){cvt_pk_bf16(ov[0], ov[1]), cvt_pk_bf16(ov[2], ov[3])};
            }
            __syncthreads();
            if (ch + 1 < NCH) {
                {   f32x4 aw = (f32x4){0.f, 0.f, 0.f, 0.f}, aa = aw, ag = aw;
                    const LAS unsigned char* ap = L + SB_ALT + (16 * mb + fn) * 576 + kg * 16;
#pragma unroll
                    for (int sx = 0; sx < 9; ++sx) { const bf16x8 af = *(const LAS bf16x8*)(ap + sx * 64);
                        if (sx < 2) aw = __builtin_amdgcn_mfma_f32_16x16x32_bf16(Bw[sx], af, aw, 0, 0, 0);
                        else if (sx < 4) aa = __builtin_amdgcn_mfma_f32_16x16x32_bf16(Ba[sx - 2], af, aa, 0, 0, 0);
                        else ag = __builtin_amdgcn_mfma_f32_16x16x32_bf16(Bg[sx - 4], af, ag, 0, 0, 0); }
                    const int o = (16 * mb + fn) * 256 + (nb * 16 + 4 * kg) * 4;
                    const LAS f32x4* CW = (const LAS f32x4*)(F.lds + SB_CST) + (4 * nb + kg); const f32x4 c_w0 = CW[48], c_a0 = CW[64];
                    f32x4 cumv;
#pragma unroll
                    for (int r = 0; r < 4; ++r) { aw[r] = -0.60653066f * sigmoidf_(aw[r] + c_w0[r]);
                        aa[r] = sigmoidf_(aa[r] + c_a0[r]);
                        float x = aw[r]; x += dpp<0x111>(x); x += dpp<0x112>(x); x += dpp<0x114>(x); x += dpp<0x118>(x); cumv[r] = x; }
                    *(LAS f32x4*)(L + SB_WRAW + o) = aw; *(LAS f32x4*)(L + SB_ARAW + o) = aa; *(LAS f32x4*)(L + SB_CUMF + o) = cumv; *(LAS f32x4*)(L + SB_G + o) = ag;
                }
                __syncthreads();
                {   const LAS unsigned char* rc = L + SB_RAWRKV + (tl + 1) * 384 + 8 * q; const LAS unsigned char* rp_ = rc - 384;
                    f32x4 r = lds_bf4(rc), k = lds_bf4(rc + 128), v = lds_bf4(rc + 256);
                    const f32x4 rp = lds_bf4(rp_), kp_ = lds_bf4(rp_ + 128), vp = lds_bf4(rp_ + 256);
                    const f32x4 tm_r = CQ[0], tm_k = CQ[16], tm_v = CQ[32], c_kk = CQ[80], c_ka = CQ[96];
                    r = r + (rp - r) * tm_r; k = k + (kp_ - k) * tm_k; v = v + (vp - v) * tm_v;
                    const int o = tl * 256 + 16 * q;
                    const f32x4 lw = *(const LAS f32x4*)(L + SB_WRAW + o), av = *(const LAS f32x4*)(L + SB_ARAW + o), cum = *(const LAS f32x4*)(L + SB_CUMF + o);
                    f32x4 kk, kpv, nbv; float ss = 0.f;
#pragma unroll
                    for (int j = 0; j < 4; ++j) { kk[j] = k[j] * c_kk[j]; ss += kk[j] * kk[j]; kpv[j] = k[j] * (1.0f + (av[j] - 1.0f) * c_ka[j]); }
                    ss = allsum16(ss);
                    const float inv = __builtin_amdgcn_rcpf(fmaxf(__builtin_amdgcn_sqrtf(ss), 1e-12f));
#pragma unroll
                    for (int j = 0; j < 4; ++j) { kk[j] *= inv; nbv[j] = -kk[j] * av[j]; }
                    f32x4 at, bt, kt, rt, p4;
#pragma unroll
                    for (int j = 0; j < 4; ++j) { const float P = __expf(cum[j]), iP = __builtin_amdgcn_rcpf(P), Pm1 = __expf(cum[j] - lw[j]);
                        at[j] = kk[j] * Pm1; bt[j] = nbv[j] * iP; kt[j] = kpv[j] * iP; rt[j] = r[j] * P; p4[j] = P; }
                    *(LAS u32x2*)(L + RC_AT + tl * 128 + 8 * q) = (u32x2){cvt_pk_bf16(at[0], at[1]), cvt_pk_bf16(at[2], at[3])};
                    *(LAS u32x2*)(L + RC_RT + tl * 128 + 8 * q) = (u32x2){cvt_pk_bf16(rt[0], rt[1]), cvt_pk_bf16(rt[2], rt[3])};
                    *(LAS u32x2*)(L + RC_BT + tl * 128 + 8 * q) = (u32x2){cvt_pk_bf16(bt[0], bt[1]), cvt_pk_bf16(bt[2], bt[3])};
                    *(LAS u32x2*)(L + RC_KT + tl * 128 + 8 * q) = (u32x2){cvt_pk_bf16(kt[0], kt[1]), cvt_pk_bf16(kt[2], kt[3])};
                    *(LAS u32x2*)(L + RC_VB + tl * 128 + 8 * q) = (u32x2){cvt_pk_bf16(v[0], v[1]), cvt_pk_bf16(v[2], v[3])};
                    if ((tl & 15) == 15) *(LAS f32x4*)(L + RC_P4 + ((tl >> 4) * 64 + 4 * q) * 4) = p4;
                    *(LAS u32x2*)(L + SB_RB + tl * 128 + 8 * q) = (u32x2){cvt_pk_bf16(r[0], r[1]), cvt_pk_bf16(r[2], r[3])};
                    *(LAS f32x4*)(L + SB_KP + o) = kpv; *(LAS f32x4*)(L + SB_V + o) = v;
                }
                __syncthreads();
                {   const int sub = w >> 2, mx = w & 3;
                    const LAS unsigned char* Ai = L + ((mx & 2) ? RC_RT : RC_AT) + (16 * sub + fn) * 128 + kg * 16; const LAS unsigned char* Bi = L + ((mx & 1) ? RC_KT : RC_BT) + (16 * sub + fn) * 128 + kg * 16;
                    const bf16x8 a0 = *(const LAS bf16x8*)(Ai), a1 = *(const LAS bf16x8*)(Ai + 64), b0 = *(const LAS bf16x8*)(Bi), b1 = *(const LAS bf16x8*)(Bi + 64);
                    f32x4 dt = __builtin_amdgcn_mfma_f32_16x16x32_bf16(b0, a0, (f32x4){0.f, 0.f, 0.f, 0.f}, 0, 0, 0);
                    dt = __builtin_amdgcn_mfma_f32_16x16x32_bf16(b1, a1, dt, 0, 0, 0);
                    if (mx != 0) {
#pragma unroll
                        for (int r = 0; r < 4; ++r) { const int s_ = 4 * kg + r; const bool keep = (mx < 2) ? (s_ < fn) : (s_ <= fn); dt[r] = keep ? dt[r] : 0.f; }
                        const u32x2 pk = (u32x2){cvt_pk_bf16(dt[0], dt[1]), cvt_pk_bf16(dt[2], dt[3])};
                        if (mx == 1) *(LAS u32x4*)(L + SB_LAKIMG + ((sub * 16 + fn) * 4 + kg) * 16) = (u32x4){pk.x, pk.y, 0u, 0u};
                        else *(LAS u32x2*)(L + SB_MRIMG + ((sub * 16 + fn) * 4 + kg) * 16 + ((mx == 3) ? 8 : 0)) = pk;
                    } else {
#define MM16(XT, Y, C) __builtin_amdgcn_mfma_f32_16x16x4f32((XT)[3], (Y)[3], __builtin_amdgcn_mfma_f32_16x16x4f32((XT)[2], (Y)[2], __builtin_amdgcn_mfma_f32_16x16x4f32((XT)[1], (Y)[1], \
                                       __builtin_amdgcn_mfma_f32_16x16x4f32((XT)[0], (Y)[0], (C), 0, 0, 0), 0, 0, 0), 0, 0, 0), 0, 0, 0)
                        f32x4 d = __builtin_amdgcn_mfma_f32_16x16x32_bf16(a0, b0, (f32x4){0.f, 0.f, 0.f, 0.f}, 0, 0, 0);
                        d = __builtin_amdgcn_mfma_f32_16x16x32_bf16(a1, b1, d, 0, 0, 0);
                        f32x4 Lm, Lt, T1, T1t; const f32x4 z4 = (f32x4){0.f, 0.f, 0.f, 0.f};
#pragma unroll
                        for (int r = 0; r < 4; ++r) { const int e_ = 4 * kg + r; Lm[r] = (fn < e_) ? d[r] : 0.f; Lt[r] = (e_ < fn) ? dt[r] : 0.f; const float id = (e_ == fn) ? 1.0f : 0.f; T1[r] = Lm[r] + id; T1t[r] = Lt[r] + id; }
                        const f32x4 X2 = MM16(Lt, Lm, z4), X2t = MM16(Lm, Lt, z4);
                        const f32x4 T2 = MM16(X2t, T1, T1), T2t = MM16(T1, X2t, T1t);
                        const f32x4 X4 = MM16(X2t, X2, z4), X4t = MM16(X2, X2t, z4);
                        const f32x4 T3 = MM16(X4t, T2, T2), T3t = MM16(T2, X4t, T2t);
                        const f32x4 X8t = MM16(X4, X4t, z4);
                        const f32x4 T4t = MM16(T3, X8t, T3t);
#undef MM16
                        *(LAS u32x4*)(L + SB_TIMG + ((sub * 16 + fn) * 4 + kg) * 16) = (u32x4){cvt_pk_bf16(T4t[0], T4t[1]), cvt_pk_bf16(T4t[2], T4t[3]), 0u, 0u};
                    }
                }
                __syncthreads();
            }
        }
    }
}

constexpr int VN_STRIDE = 272;
struct TrQ { u32x2 a[8], b[8]; };
__device__ __forceinline__ void p3_gmlp(Frame& F, const Args& a) {
    const bf16_t* Z = (const bf16_t*)(a.ws + WS_Z); const bf16_t* Mo = (const bf16_t*)(a.ws + WS_M); bf16_t* M2 = (bf16_t*)(a.ws + WS_M2);
    LAS unsigned char* VN = F.lds + RING_OFF;
    LAS f32x2* ST = (LAS f32x2*)(F.lds + RING_OFF + 128 * VN_STRIDE);
    LAS f32x2* SP = ST + 128;
    const int lane = ((int)(threadIdx.x & 63u)), w = F.wave, tid = ((int)threadIdx.x);
    const float* lng = a.in[I_LNVG]; const float* lnb = a.in[I_LNVB]; const float* wsp = a.in[I_WSP]; const float* bsp = a.in[I_BSP];
    for (int unit = F.bid; unit < NB_ * (SEQ / 128); unit += F.G) {
        const size_t t0 = (size_t)unit * 128;
#pragma unroll 4
        for (int rr = 0; rr < 16; ++rr) { const int j = 16 * w + rr;
            const bf16_t* p = Z + (t0 + j) * NZ2 + Z2_VG + 16 * lane; float c0[8], c1[8]; ld_bf8(p, c0); ld_bf8(p + 8, c1);
            float s = 0.f, s2 = 0.f;
#pragma unroll
            for (int i = 0; i < 8; ++i) { s += c0[i] + c1[i]; s2 += c0[i] * c0[i] + c1[i] * c1[i]; }
            s = allsum16(s); s2 = allsum16(s2);
            if ((lane & 15) == 0) SP[j * 4 + (lane >> 4)] = (f32x2){s, s2};
        }
        __syncthreads();
        if (tid < 128) { const f32x2 p0 = SP[tid * 4], p1 = SP[tid * 4 + 1], p2 = SP[tid * 4 + 2], p3 = SP[tid * 4 + 3];
            const float s = (p0.x + p1.x) + (p2.x + p3.x), s2 = (p0.y + p1.y) + (p2.y + p3.y);
            const float mean = s * (1.0f / 1024.0f), var = fmaxf(s2 * (1.0f / 1024.0f) - mean * mean, 0.f);
            ST[tid] = (f32x2){mean, __builtin_amdgcn_rsqf(var + LN_EPS)}; }
        __syncthreads();
        const int lr = tid >> 4, lc = tid & 15;
        u32x4 raw[4];
#pragma unroll
        for (int it = 0; it < 4; ++it) raw[it] = *(const u32x4*)(Z + (t0 + lr + 32 * it) * NZ2 + Z2_VG + lc * 8);
        for (int g = 0; g < 8; ++g) {
            {   const f32x4 g0 = *(const f32x4*)(lng + g * 128 + lc * 8), g1 = *(const f32x4*)(lng + g * 128 + lc * 8 + 4);
                const f32x4 b0 = *(const f32x4*)(lnb + g * 128 + lc * 8), b1 = *(const f32x4*)(lnb + g * 128 + lc * 8 + 4);
#pragma unroll
                for (int it = 0; it < 4; ++it) { const int j = lr + 32 * it; const f32x2 st = ST[j];
                    float c[8], o[8]; un8(raw[it], c);
#pragma unroll
                    for (int i = 0; i < 8; ++i) { const float gg = (i < 4) ? g0[i] : g1[i - 4], bb = (i < 4) ? b0[i] : b1[i - 4]; o[i] = (c[i] - st.x) * st.y * gg + bb; }
                    *(LAS bf16x8*)(VN + j * VN_STRIDE + lc * 16) = pack8(o); }
                if (g + 1 < 8) {
#pragma unroll
                    for (int it = 0; it < 4; ++it) raw[it] = *(const u32x4*)(Z + (t0 + lr + 32 * it) * NZ2 + Z2_VG + (g + 1) * 128 + lc * 8); }
            }
            __syncthreads();
            {   const int fi = lane & 15, kg = lane >> 4, i = 16 * w + fi, tq = fi >> 2, tp = fi & 3;
                f32x4 acc[8];
#pragma unroll
                for (int n = 0; n < 8; ++n) acc[n] = (f32x4){0.f, 0.f, 0.f, 0.f};
                const float* wrow = wsp + ((size_t)g * 128 + i) * 128;
                const unsigned trb = (unsigned)(size_t)(VN + (8 * kg + tq) * VN_STRIDE + tp * 16);
#pragma unroll
                for (int s = 0; s < 4; ++s) {
                    if (32 * s <= 16 * w + 15) {
                        const int jb = 32 * s + 8 * kg;
                        const f32x4 w0 = *(const f32x4*)(wrow + jb), w1 = *(const f32x4*)(wrow + jb + 4);
                        float m8[8];
#pragma unroll
                        for (int jj = 0; jj < 8; ++jj) { const float v = (jj < 4) ? w0[jj] : w1[jj - 4]; m8[jj] = (jb + jj <= i) ? v : 0.f; }
                        const bf16x8 wf = pack8(m8);
                        TrQ t;
                        const unsigned ad = trb + (unsigned)(32 * s * VN_STRIDE);
                        asm volatile(
                            "ds_read_b64_tr_b16 %0, %16 offset:0\n\tds_read_b64_tr_b16 %1, %16 offset:8\n\tds_read_b64_tr_b16 %2, %16 offset:64\n\tds_read_b64_tr_b16 %3, %16 offset:72\n\t"
                            "ds_read_b64_tr_b16 %4, %16 offset:128\n\tds_read_b64_tr_b16 %5, %16 offset:136\n\tds_read_b64_tr_b16 %6, %16 offset:192\n\tds_read_b64_tr_b16 %7, %16 offset:200\n\t"
                            "ds_read_b64_tr_b16 %8, %16 offset:1088\n\tds_read_b64_tr_b16 %9, %16 offset:1096\n\tds_read_b64_tr_b16 %10, %16 offset:1152\n\tds_read_b64_tr_b16 %11, %16 offset:1160\n\t"
                            "ds_read_b64_tr_b16 %12, %16 offset:1216\n\tds_read_b64_tr_b16 %13, %16 offset:1224\n\tds_read_b64_tr_b16 %14, %16 offset:1280\n\tds_read_b64_tr_b16 %15, %16 offset:1288\n\t"
                            "s_waitcnt lgkmcnt(0)"
                            : "=&v"(t.a[0]), "=&v"(t.a[1]), "=&v"(t.a[2]), "=&v"(t.a[3]), "=&v"(t.a[4]), "=&v"(t.a[5]), "=&v"(t.a[6]), "=&v"(t.a[7]),
                              "=&v"(t.b[0]), "=&v"(t.b[1]), "=&v"(t.b[2]), "=&v"(t.b[3]), "=&v"(t.b[4]), "=&v"(t.b[5]), "=&v"(t.b[6]), "=&v"(t.b[7])
                            : "v"(ad) : "memory");
#pragma unroll
                        for (int n = 0; n < 8; ++n) { const u32x4 vq = (u32x4){t.a[n].x, t.a[n].y, t.b[n].x, t.b[n].y};
                            acc[n] = __builtin_amdgcn_mfma_f32_16x16x32_bf16(__builtin_bit_cast(bf16x8, vq), wf, acc[n], 0, 0, 0); }
                    }
                }
                const float bs = bsp[g * 128 + i];
                const size_t trow = t0 + i;
#pragma unroll
                for (int u = 0; u < 4; ++u) { const int dcol = g * 128 + 32 * u + 8 * kg;
                    float uu[8], gb[8], mm[8], o[8];
                    ld_bf8(Z + trow * NZ2 + Z2_U + dcol, uu); ld_bf8(Z + trow * NZ2 + Z2_GB + dcol, gb); ld_bf8(Mo + trow * D + dcol, mm);
#pragma unroll
                    for (int r = 0; r < 4; ++r) { o[r] = mm[r] + uu[r] * (acc[2 * u][r] + bs) * gb[r]; o[4 + r] = mm[4 + r] + uu[4 + r] * (acc[2 * u + 1][r] + bs) * gb[4 + r]; }
                    *(bf16x8*)(M2 + trow * D + dcol) = pack8(o); }
            }
            __syncthreads();
        }
    }
}

__device__ __forceinline__ void p5_router(Frame& F, const Args& a) {
    const bf16_t* X2 = (const bf16_t*)(a.ws + WS_H); unsigned char* Hh = (unsigned char*)(a.ws + WS_H2);
    const bf16_t* Wh = (const bf16_t*)(a.ws + WS_MISC + MO_WRT); const bf16_t* Wl = Wh + NE * D;
    int* tok_of = (int*)(a.ws + WS_TOK); int* asg = (int*)(a.ws + WS_MISC + MO_ASG); float* gate = (float*)(a.ws + WS_MISC + MO_GATE);
    const float* g2 = a.in[I_N2G]; const float* br = a.in[I_BR];
    LAS float* LG = (LAS float*)(F.lds + RING_OFF) + F.wave * 512;
    LAS unsigned* LCNT = (LAS unsigned*)(F.lds + RING_OFF + 32768);
    LAS unsigned* LBASE = LCNT + 32;
    const int lane = ((int)(threadIdx.x & 63u)), w = F.wave, tid = ((int)threadIdx.x), fm = lane & 15, kg = lane >> 4;
    for (int blk = F.bid; blk < T / 128; blk += F.G) {
        if (tid < 32) LCNT[tid] = 0u;
        __syncthreads();
        const int tb = blk * 128 + 16 * w;
        const bf16_t* xr = X2 + (size_t)(tb + fm) * D + 8 * kg;
        float ss = 0.f;
        for (int s = 0; s < 32; ++s) { float x8[8]; ld_bf8(xr + 32 * s, x8);
            ss += (x8[0] * x8[0] + x8[1] * x8[1]) + (x8[2] * x8[2] + x8[3] * x8[3]) + (x8[4] * x8[4] + x8[5] * x8[5]) + (x8[6] * x8[6] + x8[7] * x8[7]); }
        ss += __shfl_xor(ss, 16); ss += __shfl_xor(ss, 32);
        const float rstd = __builtin_amdgcn_rsqf(ss * (1.0f / D) + RMS_EPS);
        f32x4 acc[2]; acc[0] = (f32x4){0.f, 0.f, 0.f, 0.f}; acc[1] = acc[0];
        unsigned char* hrow = Hh + (size_t)(tb + fm) * D + 8 * kg;
        u32x4 xq_n = *(const u32x4*)(xr); f32x4 ga_n = *(const f32x4*)(g2 + 8 * kg), gb_n = *(const f32x4*)(g2 + 8 * kg + 4);
        bf16x8 bh_n[2], bl_n[2];
#pragma unroll
        for (int n = 0; n < 2; ++n) { const size_t wo = (size_t)(16 * n + fm) * D + 8 * kg; bh_n[n] = *(const bf16x8*)(Wh + wo); bl_n[n] = *(const bf16x8*)(Wl + wo); }
        for (int s = 0; s < 32; ++s) {
            const u32x4 xq = xq_n; const f32x4 ga = ga_n, gb = gb_n; const bf16x8 bh[2] = {bh_n[0], bh_n[1]}, bl[2] = {bl_n[0], bl_n[1]};
            { const int s1 = (s + 1 < 32) ? s + 1 : 31;
              xq_n = *(const u32x4*)(xr + 32 * s1); ga_n = *(const f32x4*)(g2 + 32 * s1 + 8 * kg); gb_n = *(const f32x4*)(g2 + 32 * s1 + 8 * kg + 4);
#pragma unroll
              for (int n = 0; n < 2; ++n) { const size_t wo = (size_t)(16 * n + fm) * D + 32 * s1 + 8 * kg; bh_n[n] = *(const bf16x8*)(Wh + wo); bl_n[n] = *(const bf16x8*)(Wl + wo); } }
            const float x8[8] = {bf_lo(xq.x), bf_hi(xq.x), bf_lo(xq.y), bf_hi(xq.y), bf_lo(xq.z), bf_hi(xq.z), bf_lo(xq.w), bf_hi(xq.w)};
            float hv[8], lo[8];
#pragma unroll
            for (int j = 0; j < 4; ++j) { hv[j] = x8[j] * rstd * ga[j]; hv[4 + j] = x8[4 + j] * rstd * gb[j]; }
            u32x4 hp; hp.x = cvt_pk_bf16(hv[0], hv[1]); hp.y = cvt_pk_bf16(hv[2], hv[3]); hp.z = cvt_pk_bf16(hv[4], hv[5]); hp.w = cvt_pk_bf16(hv[6], hv[7]);
            *(u32x2*)(hrow + 32 * s) = (u32x2){cvt_pk4_fp8(clamp448(hv[0]), clamp448(hv[1]), clamp448(hv[2]), clamp448(hv[3])), cvt_pk4_fp8(clamp448(hv[4]), clamp448(hv[5]), clamp448(hv[6]), clamp448(hv[7]))};
            lo[0] = hv[0] - bf_lo(hp.x); lo[1] = hv[1] - bf_hi(hp.x); lo[2] = hv[2] - bf_lo(hp.y); lo[3] = hv[3] - bf_hi(hp.y);
            lo[4] = hv[4] - bf_lo(hp.z); lo[5] = hv[5] - bf_hi(hp.z); lo[6] = hv[6] - bf_lo(hp.w); lo[7] = hv[7] - bf_hi(hp.w);
            const bf16x8 ah = __builtin_bit_cast(bf16x8, hp), al = pack8(lo);
#pragma unroll
            for (int n = 0; n < 2; ++n) {
                acc[n] = __builtin_amdgcn_mfma_f32_16x16x32_bf16(bh[n], ah, acc[n], 0, 0, 0);
                acc[n] = __builtin_amdgcn_mfma_f32_16x16x32_bf16(bh[n], al, acc[n], 0, 0, 0);
                acc[n] = __builtin_amdgcn_mfma_f32_16x16x32_bf16(bl[n], ah, acc[n], 0, 0, 0); }
        }
#pragma unroll
        for (int n = 0; n < 2; ++n) { const f32x4 bb = *(const f32x4*)(br + 16 * n + 4 * kg); *(LAS f32x4*)(LG + fm * 32 + 16 * n + 4 * kg) = acc[n] + bb; }
        LDS_WAIT(); asm volatile("" ::: "memory");
        int se[4] = {0, 0, 0, 0}; unsigned sr[4] = {0u, 0u, 0u, 0u}; float sg[4] = {0.f, 0.f, 0.f, 0.f};
        if (lane < 16) {
            float lv[32];
#pragma unroll
            for (int e4 = 0; e4 < 8; ++e4) { const f32x4 v = *(LAS f32x4*)(LG + lane * 32 + 4 * e4); lv[4 * e4] = v.x; lv[4 * e4 + 1] = v.y; lv[4 * e4 + 2] = v.z; lv[4 * e4 + 3] = v.w; }
            float tv[4];
#pragma unroll
            for (int k = 0; k < 4; ++k) { float best = -3.0e38f; int bi = 0;
#pragma unroll
                for (int e = 0; e < 32; ++e) { const bool taken = (k > 0 && se[0] == e) || (k > 1 && se[1] == e) || (k > 2 && se[2] == e); if (!taken && lv[e] > best) { best = lv[e]; bi = e; } }
                se[k] = bi; tv[k] = best; }
            const float e1 = __expf(tv[1] - tv[0]), e2 = __expf(tv[2] - tv[0]), e3 = __expf(tv[3] - tv[0]); const float inv = 1.0f / (1.0f + e1 + e2 + e3);
            sg[0] = inv; sg[1] = e1 * inv; sg[2] = e2 * inv; sg[3] = e3 * inv;
#pragma unroll
            for (int k = 0; k < 4; ++k) sr[k] = atomicAdd((unsigned*)(LCNT + se[k]), 1u);
        }
        __syncthreads();
        if (tid < 32) LBASE[tid] = atomicAdd(F.ctl + CW_CNT + 64 * tid, (unsigned)LCNT[tid]);
        __syncthreads();
        if (lane < 16) { const int tok = tb + lane;
#pragma unroll
            for (int k = 0; k < 4; ++k) { const int pos = (int)(LBASE[se[k]] + sr[k]);
                tok_of[(size_t)se[k] * T + pos] = tok; asg[(size_t)tok * 8 + 2 * k] = se[k]; asg[(size_t)tok * 8 + 2 * k + 1] = pos; gate[(size_t)tok * 4 + k] = sg[k]; }
        }
        __syncthreads();
    }
}

__device__ __forceinline__ void moe_tables(Frame& F) {
    LAS int* cnt = (LAS int*)(F.lds + SCHED_OFF); LAS int* mts = cnt + 32;
    if (((int)threadIdx.x) == 0) { int acc = 0;
        for (int e = 0; e < NE; ++e) { const int c = (int)__hip_atomic_load(F.ctl + CW_CNT + 64 * e, RLX_AGENT); cnt[e] = c; mts[e] = acc; acc += (c + 255) >> 8; }
        mts[NE] = acc; }
    __syncthreads();
}
template <int NTN, bool GATH>
struct MoeOrder {
    static constexpr int MOE_ROWB = 1024;
    static constexpr bool GATHER = GATH;
    LAS const int* cnt; LAS const int* mts; const char* A; const char* B; const int* tok_of; int G, c, Mtiles;
    __device__ void init(Frame& F, const void* A_, const void* B_, const int* tok) { cnt = (LAS const int*)(F.lds + SCHED_OFF); mts = cnt + 32; A = (const char*)A_; B = (const char*)B_; tok_of = tok; G = F.G; c = F.bid; Mtiles = mts[NE]; }
    __device__ bool next(int i, pg8::Unit& u) const {
        constexpr int MPS = 32 / NTN;
        int mt, nt_;
        if ((G & 7) == 0) { const int s = i * 8 + (c & 7), j = (c >> 3) + 0; const int per = G >> 3;
            if (per == 32) { mt = s * MPS + (j % MPS); nt_ = j / MPS; }
            else { const int L = i * G + c; mt = L / NTN; nt_ = L % NTN; } }
        else { const int L = i * G + c; mt = L / NTN; nt_ = L % NTN; }
        if (mt >= Mtiles) return false;
        int e = 0;
        for (int k = 1; k < NE; ++k) e += (mts[k] <= mt) ? 1 : 0;
        const int mloc = mt - mts[e];
        u.e = e; u.r0 = mt * 256; u.c0 = nt_ * 256; u.aux = mloc;
        u.B = B + ((size_t)e * NTN + nt_) * (256 * MOE_ROWB);
        u.A = GATH ? A : A + (size_t)mt * (256 * MOE_ROWB);
        return true;
    }
    __device__ __forceinline__ void a_offs(const pg8::Unit& u, unsigned (&ga)[2][2], const int (&R)[2], const int (&C)[2]) const {
        if constexpr (GATH) {
            const int n = cnt[u.e]; const int* tp = tok_of + (size_t)u.e * T + u.aux * 256;
            int tk[2][2];
#pragma unroll
            for (int h = 0; h < 2; ++h)
#pragma unroll
                for (int i = 0; i < 2; ++i) tk[h][i] = tp[h * 128 + R[i]];
            VM_WAIT();
#pragma unroll
            for (int h = 0; h < 2; ++h)
#pragma unroll
                for (int i = 0; i < 2; ++i) { const int t_ = (u.aux * 256 + h * 128 + R[i] < n) ? tk[h][i] : 0; ga[h][i] = (unsigned)(t_ * MOE_ROWB + C[i] * 2); }
        } else {
#pragma unroll
            for (int h = 0; h < 2; ++h)
#pragma unroll
                for (int i = 0; i < 2; ++i) ga[h][i] = (unsigned)((h * 128 + R[i]) * MOE_ROWB + C[i] * 2);
        }
    }
};

__device__ __forceinline__ void p8_final(Frame& F, const Args& a) {
    int ln_ = (int)threadIdx.x; asm volatile("" : "+v"(ln_)); ln_ &= 63;
    LAS const int* mts = (LAS const int*)(F.lds + SCHED_OFF) + 32;
    const bf16_t* YS = (const bf16_t*)(a.ws + WS_YS); const int* asg = (const int*)(a.ws + WS_MISC + MO_ASG); const float* gate = (const float*)(a.ws + WS_MISC + MO_GATE);
    float* out = a.out; const float* gf = a.in[I_NFG];
    const int gw = F.bid * NWAVES + F.wave, NGW = F.G * NWAVES;
    f32x4 gv[4];
#pragma unroll
    for (int j = 0; j < 4; ++j) gv[j] = *((const f32x4*)gf + ln_ + 64 * j);
    for (int m = gw; m < T; m += NGW) {
        f32x4* xr = (f32x4*)(out + (size_t)m * D) + ln_;
        const bf16_t* x2r = (const bf16_t*)(a.ws + WS_H) + (size_t)m * D + 4 * ln_;
        f32x4 v[4];
#pragma unroll
        for (int j = 0; j < 4; ++j) v[j] = ld_bf4(x2r + 256 * j);
#pragma unroll
        for (int k = 0; k < 4; ++k) { const int e = asg[(size_t)m * 8 + 2 * k], pos = asg[(size_t)m * 8 + 2 * k + 1]; const float gk = gate[(size_t)m * 4 + k];
            const bf16_t* yr = YS + ((size_t)mts[e] * 256 + pos) * D + 4 * ln_;
#pragma unroll
            for (int j = 0; j < 4; ++j) v[j] += gk * ld_bf4(yr + 256 * j); }
        float s = 0.f;
#pragma unroll
        for (int j = 0; j < 4; ++j) s += (v[j].x * v[j].x + v[j].y * v[j].y) + (v[j].z * v[j].z + v[j].w * v[j].w);
        const float rstd = __builtin_amdgcn_rsqf(wave_sum(s) * (1.f / D) + RMS_EPS);
#pragma unroll
        for (int j = 0; j < 4; ++j) xr[64 * j] = v[j] * rstd * gv[j];
    }
}

constexpr int N_PHASES = 10;
__global__ void __launch_bounds__(NWAVES * 64, 2) mk_fwd(Args args) {
    extern __shared__ __attribute__((aligned(16))) unsigned char lds[];
    Frame F;
    F.lds = (LAS unsigned char*)lds;
    F.MISC = (volatile LAS unsigned*)(F.lds + MISC_OFF);
    F.wave = __builtin_amdgcn_readfirstlane(((int)threadIdx.x) >> 6);
    F.G = gridDim.x; F.bid = blockIdx.x;
    F.ctl = (unsigned*)(args.ws + WS_CTL);
    for (int u = ((int)threadIdx.x); u < (LDS_BYTES - LDSCTL_OFF) / 4; u += NWAVES * 64) ((LAS unsigned*)(F.lds + LDSCTL_OFF))[u] = 0u;
    __syncthreads();
    const int lo = args.ph_lo, hi = args.ph_hi;
    const bool multi = (hi - lo) > 1;
    XcdBarrier bar; bar.bar = F.ctl + CW_BAR; bar.x = 0; bar.st = nullptr;
    if (multi) bar = xcd_barrier_post(F.ctl + CW_BAR, F.MISC + 8);
#define IN(k) (lo <= (k) && (k) < hi)
#define SEAM(k) do { if (IN(k) && IN((k) + 1)) xcd_barrier(bar); } while (0)
    unsigned char* ws = args.ws;

#define P1_BODY {     \
        { pg8::StaticOrderT<false> S; S.init(ws + WS_H, ws + WS_BIN, T, P1_BFN * 256, F.G, F.bid); S.wgm = P1_WGM; S.n_add0 = P1_BF0; \
          pg8::EpiZT<false> E{(bf16_t*)(ws + WS_Z), (const float*)(ws + WS_MISC + MO_BIASZ), (bf16_t*)(ws + WS_HM)}; \
          pg8::gemm_phase<pg8::EpiZT<false>, pg8::StaticOrderT<false>, true>(F.lds + RING_OFF, S, E); } \
        { pg8::StaticOrderT<true> S; S.init(ws + WS_H8, ws + WS_BIN8, T, NZ - P1_BFN * 256, F.G, F.bid); S.wgm = P1_WGM; S.n_split = P1_BF0; S.n_add0 = 0; S.n_add1 = P1_BFN; \
          pg8::EpiZT<true> E{(bf16_t*)(ws + WS_Z), (const float*)(ws + WS_MISC + MO_BIASZ), (bf16_t*)(ws + WS_HM)}; \
          pg8::gemm_phase<pg8::EpiZT<true>, pg8::StaticOrderT<true>, true>(F.lds + RING_OFF, S, E); } }
#define P4_BODY {     \
        pg8::StaticOrder S; S.init(ws + WS_M2, ws + WS_BOUT, T, D, F.G, F.bid); \
        pg8::EpiRes E{(bf16_t*)(ws + WS_H), args.in[I_X]}; \
        pg8::gemm_phase<pg8::EpiRes, pg8::StaticOrder, true>(F.lds + RING_OFF, S, E); }
#define P6_BODY {     \
        moe_tables(F); \
        MoeOrder<8, true> S; S.init(F, ws + WS_H2, ws + WS_BGU, (const int*)(ws + WS_TOK)); \
        pg8::EpiSwiglu E{(unsigned char*)(ws + WS_ACT), (const float*)(ws + WS_MISC + MO_BGU)}; \
        pg8::gemm_phase<pg8::EpiSwiglu, MoeOrder<8, true>, true>(F.lds + RING_OFF, S, E); }
#define P7_BODY {     \
        moe_tables(F); \
        MoeOrder<4, false> S; S.init(F, ws + WS_ACT, ws + WS_BD, nullptr); \
        pg8::EpiDown E{(bf16_t*)(ws + WS_YS), args.in[I_BDN]}; \
        pg8::gemm_phase<pg8::EpiDown, MoeOrder<4, false>, true>(F.lds + RING_OFF, S, E); }
    if (IN(0)) { p0_prologue(F, args); if (PROBE_REP == 0) p0_prologue(F, args); SEAM(0); }
    if (IN(1)) { P1_BODY if (PROBE_REP == 1) P1_BODY SEAM(1); }
    if (IN(2)) { p2a_act(F, args); SEAM(2); }
    if (IN(3)) { p2_scan(F, args); if (PROBE_REP == 2) p2_scan(F, args); SEAM(3); }
    if (IN(4)) { for (int rep_ = 0; rep_ < (PROBE_REP == 3 ? 2 : 1); ++rep_) p3_gmlp(F, args); SEAM(4); }
    if (IN(5)) { P4_BODY if (PROBE_REP == 4) P4_BODY SEAM(5); }
    if (IN(6)) { p5_router(F, args); SEAM(6); }
    if (IN(7)) { P6_BODY if (PROBE_REP == 6) P6_BODY SEAM(7); }
    if (IN(8)) { P7_BODY if (PROBE_REP == 7) P7_BODY SEAM(8); }
    if (IN(9)) { moe_tables(F); p8_final(F, args); }
#undef IN
#undef SEAM
}

extern "C" void kernel_launch(void* const* d_in, const int* in_sizes, int n_in, void* d_out, int out_size, void* d_ws, size_t ws_size, hipStream_t stream) {
    static int grid = 0;
    if (grid == 0) {
        if (n_in != 28 || out_size != T * D || ws_size < WS_END) { fprintf(stderr, "kernel_launch: unexpected problem (n_in %d, out %d, ws %zu); nothing launched\n", n_in, out_size, ws_size); grid = -1; return; }
        int dev = 0, cus = 0, per_cu = 0;
        if (hipGetDevice(&dev) != hipSuccess || hipDeviceGetAttribute(&cus, hipDeviceAttributeMultiprocessorCount, dev) != hipSuccess) { grid = -1; return; }
        if (hipFuncSetAttribute((const void*)mk_fwd, hipFuncAttributeMaxDynamicSharedMemorySize, LDS_BYTES) != hipSuccess) { fprintf(stderr, "kernel_launch: hipFuncSetAttribute failed\n"); grid = -1; return; }
        if (hipOccupancyMaxActiveBlocksPerMultiprocessor(&per_cu, (const void*)mk_fwd, NWAVES * 64, LDS_BYTES) != hipSuccess || per_cu < 1)
            fprintf(stderr, "kernel_launch: note: occupancy query reports %d workgroups per CU\n", per_cu);
        (void)hipGetLastError();
        grid = cus;
    }
    if (grid < 0) return;
    if (hipMemsetAsync((char*)d_ws + WS_CTL, 0, CTL_ZERO_BYTES, stream) != hipSuccess) return;
    Args a{};
    for (int i = 0; i < 28; ++i) a.in[i] = (const float*)d_in[i];
    a.out = (float*)d_out; a.ws = (unsigned char*)d_ws;
    if (MK_N_LAUNCHES == 1) { a.ph_lo = 0; a.ph_hi = N_PHASES; hipLaunchKernelGGL(mk_fwd, dim3(grid), dim3(NWAVES * 64), LDS_BYTES, stream, a); }
    else for (int p = 0; p < N_PHASES; ++p) { a.ph_lo = p; a.ph_hi = p + 1; hipLaunchKernelGGL(mk_fwd, dim3(grid), dim3(NWAVES * 64), LDS_BYTES, stream, a); }
}
```

```cpp
#include <hip/hip_runtime.h>
#include <cstdio>
#include <cstdint>

#ifndef MK_N_LAUNCHES
#define MK_N_LAUNCHES 1
#endif

#ifndef P1_WGM
#define P1_WGM 4
#endif
#ifndef SCAN_PREFETCH
#define SCAN_PREFETCH 0
#endif
#ifndef P1_BF0
#define P1_BF0 4
#define P1_BFN 18
#endif
#ifndef PROBE_REP
#define PROBE_REP -1
#endif
#define GAS __attribute__((address_space(1)))
#define LAS __attribute__((address_space(3)))
typedef unsigned short bf16_t;
typedef short bf16x8 __attribute__((ext_vector_type(8)));
typedef float f32x4 __attribute__((ext_vector_type(4)));
typedef float f32x2 __attribute__((ext_vector_type(2)));
typedef unsigned u32x4 __attribute__((ext_vector_type(4)));
typedef unsigned u32x2 __attribute__((ext_vector_type(2)));
typedef int i32x4 __attribute__((ext_vector_type(4)));
typedef int i32x8 __attribute__((ext_vector_type(8)));

constexpr int NB_ = 16, SEQ = 2048, D = 1024, T = NB_ * SEQ;
constexpr int NH = 16, HD = 64;
constexpr int NZ = 7680;
constexpr int ZC_R = 0, ZC_K = 1024, ZC_V = 2048, ZC_L = 3072, ZC_U = 3584, ZC_VG = 4608, ZC_GA = 5632, ZC_GB = 6656;
constexpr int NZ2 = 3584, Z2_L = 0, Z2_U = 512, Z2_VG = 1536, Z2_GB = 2560;
constexpr int TM_R = 0, TM_K = 1024, TM_V = 2048, TM_DL = 3072, TM_AL = 3136, TM_GL = 3200;
constexpr int NE = 32, TOPK = 4, FF = 1024;
constexpr int NSLOT_MAX = T * TOPK + NE * 256;
constexpr float RMS_EPS = 1e-5f, GN_EPS = 64e-5f, LN_EPS = 1e-5f;

constexpr size_t MiB = 1u << 20;
constexpr size_t WS_CTL = 0, CTL_ZERO_BYTES = 1 * MiB;
constexpr size_t WS_BIN = 2 * MiB;
constexpr size_t WS_BOUT = 18 * MiB;
constexpr size_t WS_BGU = 20 * MiB;
constexpr size_t WS_H8 = 84 * MiB;
constexpr size_t WS_BIN8 = 116 * MiB;
constexpr size_t WS_BD = 148 * MiB;
constexpr size_t WS_MISC = 212 * MiB;
constexpr size_t WS_TOK = 216 * MiB;
constexpr size_t WS_H = 220 * MiB;
constexpr size_t WS_HM = 284 * MiB;
constexpr size_t WS_Z = 540 * MiB;
constexpr size_t WS_M = 764 * MiB;
constexpr size_t WS_M2 = 828 * MiB;
constexpr size_t WS_H2 = 892 * MiB;
constexpr size_t WS_AL = 956 * MiB;
constexpr size_t WS_END = 976 * MiB;
constexpr size_t WS_ACT = WS_HM;
constexpr size_t WS_YS = WS_HM + 272 * MiB;
static_assert((size_t)NSLOT_MAX * FF * 2 == 272 * MiB && WS_YS + 272 * MiB == WS_M2, "ws map");
constexpr size_t MO_BIASZ = 0;
constexpr size_t MO_BGU = 64 * 1024;
constexpr size_t MO_WRT = 512 * 1024;
constexpr size_t MO_ASG = 1 * MiB;
constexpr size_t MO_GATE = 2 * MiB;
constexpr size_t MO_LT = 3 * MiB;
constexpr int CW_TMO = 0, CW_CODE = 1;
constexpr int CW_BAR = 4096;
constexpr int CW_CNT = 8192;

constexpr int RING_OFF = 0, RING_BYTES = 131072;
constexpr int LDSCTL_OFF = 159232, MISC_OFF = LDSCTL_OFF + 320;
constexpr int SCHED_OFF = LDSCTL_OFF + 1024;
constexpr int LDS_BYTES = 163840;
constexpr int EPI_T_OFF = RING_OFF + RING_BYTES, EPI_T_WAVE = 2304;
static_assert(EPI_T_OFF + 8 * EPI_T_WAVE <= LDSCTL_OFF, "LDS");
constexpr int NWAVES = 8;

#define RLX_AGENT __ATOMIC_RELAXED, __HIP_MEMORY_SCOPE_AGENT
#define LDS_WAIT() asm volatile("s_waitcnt lgkmcnt(0)" ::: "memory")
#define VM_WAIT() asm volatile("s_waitcnt vmcnt(0)" ::: "memory")
typedef __bf16 bf16x2_t __attribute__((ext_vector_type(2)));
typedef short s16x4 __attribute__((ext_vector_type(4)));
__device__ __forceinline__ unsigned cvt_pk_bf16(float lo, float hi) { bf16x2_t v; v.x = (__bf16)lo; v.y = (__bf16)hi; return __builtin_bit_cast(unsigned, v); }
constexpr float W8_SCALE = 64.0f, W8_INV = 1.0f / 64.0f;
__device__ __forceinline__ float clamp448(float x) { return fminf(fmaxf(x, -448.0f), 448.0f); }
__device__ __forceinline__ unsigned cvt_pk4_fp8(float a, float b, float c, float d) {
    int w = __builtin_amdgcn_cvt_pk_fp8_f32(a, b, 0, false); w = __builtin_amdgcn_cvt_pk_fp8_f32(c, d, w, true); return (unsigned)w; }
__device__ __forceinline__ float bf_lo(unsigned u) { return __builtin_bit_cast(float, u << 16); }
__device__ __forceinline__ float bf_hi(unsigned u) { return __builtin_bit_cast(float, u & 0xffff0000u); }
__device__ __forceinline__ float bf2f(bf16_t b) { return __builtin_bit_cast(float, ((unsigned)b) << 16); }
template <int CTRL> __device__ __forceinline__ float dpp(float x) { return __builtin_bit_cast(float, __builtin_amdgcn_mov_dpp(__builtin_bit_cast(int, x), CTRL, 0xf, 0xf, true)); }
__device__ __forceinline__ float allsum16(float x) {
    x += dpp<0xB1>(x); x += dpp<0x4E>(x); x += dpp<0x141>(x); x += dpp<0x140>(x); return x;
}
__device__ __forceinline__ float wave_sum(float v) {
#pragma unroll
    for (int o = 1; o < 64; o <<= 1) v += __shfl_xor(v, o);
    return v;
}
__device__ __forceinline__ float sigmoidf_(float x) { return __builtin_amdgcn_rcpf(1.0f + __expf(-x)); }
__device__ __forceinline__ f32x2 gelu_pk(f32x2 v) {
    const f32x2 av = __builtin_elementwise_abs(v), d = av * 0.2316418882f + 1.0f;
    f32x2 t; t.x = __builtin_amdgcn_rcpf(d.x); t.y = __builtin_amdgcn_rcpf(d.y);
    f32x2 q = t * 0.5307027145f + (-0.7265760135f); q = q * t + 0.7107068705f; q = q * t + (-0.142248368f); q = q * t + 0.127414796f; q = q * t;
    const f32x2 s = (v * v) * (-0.72134752044f);
    f32x2 e; e.x = __builtin_amdgcn_exp2f(s.x); e.y = __builtin_amdgcn_exp2f(s.y);
    const f32x2 m = v * (q * e), r = v - m;
    f32x2 o; o.x = v.x < 0.f ? m.x : r.x; o.y = v.y < 0.f ? m.y : r.y; return o;
}

namespace pg8 {
constexpr int BM = 256, BK = 64, HALF = 128, HTB = HALF * BK * 2, STAGE_BYTES = 8 * HTB, NXCD = 8, WGM = 8;
constexpr int KK = 1024;
__host__ __device__ __forceinline__ int lds_byte(int r, int c) { const int st = (r >> 4) * 2 + (c >> 5), rr = r & 15, cc = c & 31, ob = rr * 64 + cc * 2; return st * 1024 + (ob ^ (((ob >> 9) & 1) << 5)); }
__host__ __device__ __forceinline__ void stage_rc(int b, int& R, int& C) { const int st = b / 1024, sb = b % 1024, swz = sb ^ (((sb >> 9) & 1) << 5); R = (st >> 1) * 16 + swz / 64; C = (st & 1) * 32 + (swz % 64) / 2; }
__host__ __device__ __forceinline__ int perm32(int rho) { const int n = rho >> 4, i = rho & 15; return 8 * (i >> 2) + 4 * n + (i & 3); }

struct Unit { const char* A; const char* B; int r0, c0, e, aux; };

template <bool F8_ = false>
struct StaticOrderT {
    static constexpr int ROWB = F8_ ? KK : 2 * KK;
    const char* A; const char* B; int nM, nN, nwg, G, c, wgm = WGM; int n_split = 1 << 30, n_add0 = 0, n_add1 = 0;
    static constexpr bool GATHER = false;
    __device__ void init(const void* A_, const void* B_, int M, int N, int G_, int c_) { A = (const char*)A_; B = (const char*)B_; nM = M / BM; nN = N / BM; nwg = nM * nN; G = G_; c = c_; }
    __device__ bool next(int i, Unit& u) const {
        const long L = (long)i * G + c; if (L >= nwg) return false;
        int wgid = (int)L; { const int q = nwg / NXCD, r = nwg % NXCD, xcd = wgid % NXCD, off = wgid / NXCD; wgid = (xcd < r ? xcd * (q + 1) : r * (q + 1) + (xcd - r) * q) + off; }
        const int nig = wgm * nN, gid = wgid / nig, fm = gid * wgm, gsz = (nM - fm) < wgm ? (nM - fm) : wgm;
        const int pm = fm + ((wgid % nig) % gsz), pn = (wgid % nig) / gsz;
        const int pa = pn + (pn < n_split ? n_add0 : n_add1);
        u.A = A + (size_t)pm * (BM * ROWB); u.B = B + (size_t)pa * (BM * ROWB); u.r0 = pm * BM; u.c0 = pa * BM; u.e = 0; u.aux = 0; return true;
    }
    __device__ __forceinline__ void a_offs(const Unit&, unsigned (&ga)[2][2], const int (&R)[2], const int (&C)[2]) const {
#pragma unroll
        for (int h = 0; h < 2; ++h)
#pragma unroll
            for (int i = 0; i < 2; ++i) ga[h][i] = (unsigned)((h * HALF + R[i]) * ROWB + C[i] * 2);
    }
};
typedef StaticOrderT<false> StaticOrder;

template <class Epi, class Sched, bool ALIGN_EPI = false>
__device__ __forceinline__ void gemm_phase(LAS unsigned char* lds, const Sched& S, const Epi& E) {
    const int tid = threadIdx.x, wid = __builtin_amdgcn_readfirstlane(tid >> 6), lane = tid & 63, wr = wid >> 2, wc = wid & 3, fr = lane & 15, fq = lane >> 4;
    constexpr bool F8 = Epi::F8;
    constexpr int K = KK, ROWB = F8 ? K : 2 * K, nt = ROWB / (BK * 2);
    unsigned voffB[2]; int Rr[2], Cc[2];
#pragma unroll
    for (int i = 0; i < 2; ++i) { int R, C; stage_rc(tid * 16 + i * 8192, R, C); const int Rb = Epi::PERM == 2 ? (64 * (R >> 5) + perm32(R & 31)) : (Epi::PERM == 1 ? ((R & ~31) + perm32(R & 31)) : R);
        Rr[i] = R; Cc[i] = C; voffB[i] = (unsigned)(Rb * ROWB + C * 2); }
    const size_t kstep = (size_t)(BK * 2);
    const size_t hstep = (size_t)(Epi::PERM == 2 ? 32 : HALF) * ROWB;
    const unsigned ldsw = (unsigned)wid * 1024u;
    const int aoff = F8 ? lds_byte(wr * 64 + fr, fq * 16) : lds_byte(wr * 64 + fr, fq * 8), boff = F8 ? lds_byte(wc * 32 + fr, fq * 16) : lds_byte(wc * 32 + fr, fq * 8);
    constexpr int KOFF = F8 ? 16 : 1024;
#define PG8_SA(b, h) (((b) * 2 + (h)) * HTB)
#define PG8_SB(b, h) ((4 + (b) * 2 + (h)) * HTB)
#define PG8_STAGE(bufoff, gbase, voff) do { _Pragma("unroll") for (int _i = 0; _i < 2; ++_i) \
        __builtin_amdgcn_global_load_lds((const unsigned*)((const char*)(gbase) + (voff)[_i]), (LAS unsigned*)(lds + (bufoff) + ldsw + _i * 8192), 16, 0, 0); } while (0)
#define PG8_LDA(dst, b, h) do { _Pragma("unroll") for (int m = 0; m < 4; ++m) _Pragma("unroll") for (int k = 0; k < 2; ++k) dst[m][k] = *(const LAS bf16x8*)(lds + PG8_SA(b, h) + aoff + m * 2048 + k * KOFF); } while (0)
#define PG8_LDB(dst, b, h) do { _Pragma("unroll") for (int n = 0; n < 2; ++n) _Pragma("unroll") for (int k = 0; k < 2; ++k) dst[n][k] = *(const LAS bf16x8*)(lds + PG8_SB(b, h) + boff + n * 2048 + k * KOFF); } while (0)
#define PG8_CAT8(x) __builtin_shufflevector(__builtin_bit_cast(i32x4, (x)[0]), __builtin_bit_cast(i32x4, (x)[1]), 0, 1, 2, 3, 4, 5, 6, 7)
#define PG8_MMA(ai, bj, At, Bt) do { __builtin_amdgcn_s_setprio(1); _Pragma("unroll") for (int m = 0; m < 4; ++m) _Pragma("unroll") for (int n = 0; n < 2; ++n) { \
        if constexpr (F8) { const i32x8 b8_ = PG8_CAT8(Bt[n]), a8_ = PG8_CAT8(At[m]);     \
            asm volatile("v_mfma_f32_16x16x128_f8f6f4 %0, %1, %2, %0" : "+v"(acc[ai][bj][m][n]) : "v"(b8_), "v"(a8_)); } \
        else { _Pragma("unroll") for (int k = 0; k < 2; ++k) acc[ai][bj][m][n] = __builtin_amdgcn_mfma_f32_16x16x32_bf16(Bt[n][k], At[m][k], acc[ai][bj][m][n], 0, 0, 0); } } __builtin_amdgcn_s_setprio(0); } while (0)
#define PG8_WAIT_V(n) asm volatile("s_waitcnt vmcnt(" #n ")" ::: "memory")
#define PG8_WAIT_L(n) asm volatile("s_waitcnt lgkmcnt(" #n ")" ::: "memory")
#define PG8_BAR __builtin_amdgcn_s_barrier()
#define PG8_SCHED __builtin_amdgcn_sched_barrier(0)
    Unit cur, nxt; int ui = 0;
    if (!S.next(0, cur)) return;
    f32x4 acc[2][2][4][2];
#pragma unroll
    for (int a = 0; a < 2; ++a)
#pragma unroll
        for (int b = 0; b < 2; ++b)
#pragma unroll
            for (int m = 0; m < 4; ++m)
#pragma unroll
                for (int n = 0; n < 2; ++n) acc[a][b][m][n] = (f32x4){0.f, 0.f, 0.f, 0.f};
    bf16x8 At[4][2], B0[2][2], B1[2][2];
    unsigned ga[2][2], gn[2][2];
    S.a_offs(cur, ga, Rr, Cc);
    const char* cA = cur.A; const char* cB = cur.B;
    PG8_STAGE(PG8_SB(0, 0), cB, voffB); PG8_STAGE(PG8_SB(0, 1), cB + hstep, voffB); PG8_STAGE(PG8_SA(0, 0), cA, ga[0]); PG8_STAGE(PG8_SA(0, 1), cA, ga[1]);
    if (wr == 1) PG8_BAR;
    PG8_WAIT_V(2); PG8_BAR;
    PG8_STAGE(PG8_SB(1, 0), cB + kstep, voffB); PG8_STAGE(PG8_SA(1, 0), cA + kstep, ga[0]); PG8_STAGE(PG8_SB(1, 1), cB + hstep + kstep, voffB);
    PG8_WAIT_V(6); PG8_BAR;
    for (;;) {
        const bool has_next = S.next(ui + 1, nxt);
        const char* nA = has_next ? nxt.A : cA; const char* nB = has_next ? nxt.B : cB;
#pragma unroll
        for (int h = 0; h < 2; ++h)
#pragma unroll
            for (int i = 0; i < 2; ++i) gn[h][i] = ga[h][i];
#pragma unroll 1
        for (int t = 0; t < nt; t += 2) {
            const bool last = (t == nt - 2);
            if (Sched::GATHER && last && has_next) S.a_offs(nxt, gn, Rr, Cc);
            const char* a1 = cA + (size_t)(t + 1) * kstep;
            const char* a2 = last ? nA : cA + (size_t)(t + 2) * kstep; const char* b2 = last ? nB : cB + (size_t)(t + 2) * kstep;
            const char* a3 = a2 + kstep; const char* b3 = b2 + kstep;
            unsigned g2[2][2];
#pragma unroll
            for (int h = 0; h < 2; ++h)
#pragma unroll
                for (int i = 0; i < 2; ++i) g2[h][i] = last ? gn[h][i] : ga[h][i];
            PG8_LDB(B0, 0, 0); PG8_LDB(B1, 0, 1); PG8_SCHED; PG8_LDA(At, 0, 0); PG8_STAGE(PG8_SA(1, 1), a1, ga[1]);
            PG8_WAIT_V(8); PG8_WAIT_L(0); PG8_BAR; PG8_MMA(0, 0, At, B0); PG8_MMA(0, 1, At, B1); PG8_BAR; PG8_SCHED;
            PG8_LDA(At, 0, 1); PG8_STAGE(PG8_SB(0, 0), b2, voffB); PG8_STAGE(PG8_SB(0, 1), b2 + hstep, voffB); PG8_STAGE(PG8_SA(0, 0), a2, g2[0]);
            PG8_WAIT_V(8); PG8_WAIT_L(0); PG8_BAR; PG8_MMA(1, 0, At, B0); PG8_MMA(1, 1, At, B1); PG8_BAR; PG8_SCHED;
            PG8_LDB(B0, 1, 0); PG8_LDB(B1, 1, 1); PG8_SCHED; PG8_LDA(At, 1, 0); PG8_STAGE(PG8_SA(0, 1), a2, g2[1]);
            PG8_WAIT_V(8); PG8_WAIT_L(0); PG8_BAR; PG8_MMA(0, 0, At, B0); PG8_MMA(0, 1, At, B1); PG8_BAR; PG8_SCHED;
            PG8_LDA(At, 1, 1); PG8_STAGE(PG8_SB(1, 0), b3, voffB); PG8_STAGE(PG8_SB(1, 1), b3 + hstep, voffB); PG8_STAGE(PG8_SA(1, 0), a3, g2[0]);
            PG8_WAIT_V(8); PG8_WAIT_L(0); PG8_BAR; PG8_MMA(1, 0, At, B0); PG8_MMA(1, 1, At, B1); PG8_BAR; PG8_SCHED;
        }
        if constexpr (ALIGN_EPI) { if (wr == 0) PG8_BAR; }
        { int te_ = threadIdx.x; asm volatile("" : "+v"(te_));
          E(acc, cur, wr, wc, te_ & 15, (te_ >> 4) & 3, lds + EPI_T_OFF + wid * EPI_T_WAVE); }
        if (!has_next) break;
#pragma unroll
        for (int a = 0; a < 2; ++a)
#pragma unroll
            for (int b = 0; b < 2; ++b)
#pragma unroll
                for (int m = 0; m < 4; ++m)
#pragma unroll
                    for (int n = 0; n < 2; ++n) acc[a][b][m][n] = (f32x4){0.f, 0.f, 0.f, 0.f};
        cur = nxt; cA = nA; cB = nB; ++ui;
#pragma unroll
        for (int h = 0; h < 2; ++h)
#pragma unroll
            for (int i = 0; i < 2; ++i) ga[h][i] = gn[h][i];
        if constexpr (ALIGN_EPI) { if (wr == 1) PG8_BAR; }
    }
    PG8_WAIT_V(0);
    if constexpr (!ALIGN_EPI) { if (wr == 0) PG8_BAR; }
    PG8_BAR;
#undef PG8_SA
#undef PG8_SB
#undef PG8_STAGE
#undef PG8_LDA
#undef PG8_LDB
#undef PG8_MMA
#undef PG8_CAT8
#undef PG8_WAIT_V
#undef PG8_WAIT_L
#undef PG8_BAR
#undef PG8_SCHED
}

#define EPI_CBAR() asm volatile("" ::: "memory")

template <bool F8_>
struct EpiZT {
    static constexpr int PERM = 2; static constexpr bool F8 = F8_;
    bf16_t* O; const float* bias; bf16_t* HM;
    __device__ __forceinline__ void operator()(const f32x4 (&acc)[2][2][4][2], const Unit& u, int wr, int wc, int fr, int fq, LAS unsigned char* tl) const {
        const int col0 = u.c0 + wc * 64 + 8 * fq, lane = fr + 16 * fq;
        const int mode = (u.c0 < ZC_U) ? 0 : (u.c0 < ZC_GA ? 1 : 2);
        const bool hm = (u.c0 < ZC_L) || (u.c0 >= ZC_GA && u.c0 < ZC_GB);
        f32x4 bv[2][2];
#pragma unroll
        for (int bj = 0; bj < 2; ++bj)
#pragma unroll
            for (int n = 0; n < 2; ++n) bv[bj][n] = *(const f32x4*)(bias + col0 + bj * 32 + 4 * n);
        LAS unsigned char* wp = tl + fr * 144 + fq * 16; LAS const unsigned char* rp = tl + (lane >> 3) * 144 + (lane & 7) * 16;
        bf16_t* gp; int rs;
        if (hm) { const int xi = (u.c0 < ZC_L) ? (u.c0 >> 10) : 3, h0 = (((u.c0 < ZC_L) ? (u.c0 & 1023) : (u.c0 - ZC_GA)) >> 6) + wc, b = u.r0 >> 11, t = (u.r0 & 2047) + wr * 64 + (lane >> 3);
            gp = HM + ((size_t)((b * NH + h0) * SEQ + t)) * 256 + xi * 64 + (lane & 7) * 8; rs = 256; }
        else { const int c2 = (u.c0 < ZC_GA) ? u.c0 - ZC_L : u.c0 - ZC_GB + Z2_GB; gp = O + (size_t)(u.r0 + wr * 64 + (lane >> 3)) * NZ2 + c2 + wc * 64 + (lane & 7) * 8; rs = NZ2; }
#pragma unroll
        for (int ai = 0; ai < 2; ++ai)
#pragma unroll
            for (int m = 0; m < 4; ++m) {
#pragma unroll
                for (int bj = 0; bj < 2; ++bj) { f32x4 v0 = acc[ai][bj][m][0] * (F8_ ? W8_INV : 1.0f) + bv[bj][0], v1 = acc[ai][bj][m][1] * (F8_ ? W8_INV : 1.0f) + bv[bj][1];
                    if (mode == 1) { f32x2 a = gelu_pk((f32x2){v0[0], v0[1]}), b = gelu_pk((f32x2){v0[2], v0[3]}), c = gelu_pk((f32x2){v1[0], v1[1]}), d = gelu_pk((f32x2){v1[2], v1[3]});
                        v0 = (f32x4){a.x, a.y, b.x, b.y}; v1 = (f32x4){c.x, c.y, d.x, d.y}; }
                    else if (mode == 2) {
#pragma unroll
                        for (int j = 0; j < 4; ++j) { v0[j] = sigmoidf_(v0[j]); v1[j] = sigmoidf_(v1[j]); } }
                    u32x4 w; w.x = cvt_pk_bf16(v0[0], v0[1]); w.y = cvt_pk_bf16(v0[2], v0[3]); w.z = cvt_pk_bf16(v1[0], v1[1]); w.w = cvt_pk_bf16(v1[2], v1[3]);
                    *(LAS u32x4*)(wp + bj * 64) = w; }
                EPI_CBAR();
#pragma unroll
                for (int p = 0; p < 2; ++p) { const u32x4 t = *(LAS const u32x4*)(rp + p * 8 * 144); __builtin_nontemporal_store(t, (u32x4*)(gp + (size_t)((ai * HALF + m * 16 + 8 * p) * rs))); }
                EPI_CBAR(); }
    }
};
struct EpiRes {
    static constexpr int PERM = 2; static constexpr bool F8 = false;
    bf16_t* C; const float* base;
    __device__ __forceinline__ void operator()(const f32x4 (&acc)[2][2][4][2], const Unit& u, int wr, int wc, int fr, int fq, LAS unsigned char* tl) const {
        const int lane = fr + 16 * fq;
        LAS unsigned char* wp = tl + fr * 144 + fq * 16; LAS const unsigned char* rp = tl + (lane >> 3) * 144 + (lane & 7) * 16;
        const size_t go = (size_t)(u.r0 + wr * 64 + (lane >> 3)) * D + u.c0 + wc * 64 + (lane & 7) * 8;
        f32x4 xa[2][2];
#pragma unroll
        for (int ai = 0; ai < 2; ++ai)
#pragma unroll
            for (int m = 0; m < 4; ++m) {
#pragma unroll
                for (int p = 0; p < 2; ++p) { const size_t o = go + (size_t)(ai * HALF + m * 16 + 8 * p) * D; xa[p][0] = *(const f32x4*)(base + o); xa[p][1] = *(const f32x4*)(base + o + 4); }
#pragma unroll
                for (int bj = 0; bj < 2; ++bj) { const f32x4 v0 = acc[ai][bj][m][0], v1 = acc[ai][bj][m][1];
                    u32x4 w; w.x = cvt_pk_bf16(v0[0], v0[1]); w.y = cvt_pk_bf16(v0[2], v0[3]); w.z = cvt_pk_bf16(v1[0], v1[1]); w.w = cvt_pk_bf16(v1[2], v1[3]);
                    *(LAS u32x4*)(wp + bj * 64) = w; }
                EPI_CBAR();
#pragma unroll
                for (int p = 0; p < 2; ++p) { const u32x4 t = *(LAS const u32x4*)(rp + p * 8 * 144);
                    u32x4 w; w.x = cvt_pk_bf16(xa[p][0][0] + bf_lo(t.x), xa[p][0][1] + bf_hi(t.x)); w.y = cvt_pk_bf16(xa[p][0][2] + bf_lo(t.y), xa[p][0][3] + bf_hi(t.y));
                    w.z = cvt_pk_bf16(xa[p][1][0] + bf_lo(t.z), xa[p][1][1] + bf_hi(t.z)); w.w = cvt_pk_bf16(xa[p][1][2] + bf_lo(t.w), xa[p][1][3] + bf_hi(t.w));
                    __builtin_nontemporal_store(w, (u32x4*)(C + go + (size_t)(ai * HALF + m * 16 + 8 * p) * D)); }
                EPI_CBAR(); }
    }
};
struct EpiSwiglu {
    static constexpr int PERM = 1; static constexpr bool F8 = true;
    unsigned char* O; const float* bias;
    __device__ __forceinline__ void operator()(const f32x4 (&acc)[2][2][4][2], const Unit& u, int wr, int wc, int fr, int fq, LAS unsigned char* tl) const {
        const int fl = wc * 32 + 8 * fq, lane = fr + 16 * fq;
        const float* bp = bias + (size_t)u.e * 2048 + u.c0 + fl;
        f32x4 bg[2], bu[2];
#pragma unroll
        for (int n = 0; n < 2; ++n) { bg[n] = *(const f32x4*)(bp + 4 * n); bu[n] = *(const f32x4*)(bp + HALF + 4 * n); }
        LAS unsigned char* wp = tl + fr * 40 + fq * 8; LAS const unsigned char* rp = tl + (lane >> 2) * 40 + (lane & 3) * 8;
        unsigned char* gp = O + (size_t)(u.r0 + wr * 64 + (lane >> 2)) * FF + (u.c0 >> 1) + wc * 32 + (lane & 3) * 8;
#pragma unroll
        for (int ai = 0; ai < 2; ++ai)
#pragma unroll
            for (int m = 0; m < 4; ++m) {
                float a[8];
#pragma unroll
                for (int n = 0; n < 2; ++n)
#pragma unroll
                    for (int j = 0; j < 4; ++j) { float g = acc[ai][0][m][n][j] * W8_INV + bg[n][j], up = acc[ai][1][m][n][j] * W8_INV + bu[n][j];
                        g = fminf(g, 7.0f); up = fminf(fmaxf(up, -7.0f), 7.0f);
                        a[n * 4 + j] = clamp448(g * sigmoidf_(1.702f * g) * (up + 1.0f)); }
                *(LAS u32x2*)wp = (u32x2){cvt_pk4_fp8(a[0], a[1], a[2], a[3]), cvt_pk4_fp8(a[4], a[5], a[6], a[7])};
                EPI_CBAR();
                const u32x2 t = *(LAS const u32x2*)rp; *(u32x2*)(gp + (size_t)(ai * HALF + m * 16) * FF) = t;
                EPI_CBAR(); }
    }
};
struct EpiDown {
    static constexpr int PERM = 2; static constexpr bool F8 = true;
    bf16_t* O; const float* bias;
    __device__ __forceinline__ void operator()(const f32x4 (&acc)[2][2][4][2], const Unit& u, int wr, int wc, int fr, int fq, LAS unsigned char* tl) const {
        const int col0 = u.c0 + wc * 64 + 8 * fq, lane = fr + 16 * fq;
        const float* bp = bias + (size_t)u.e * D + col0;
        f32x4 bv[2][2];
#pragma unroll
        for (int bj = 0; bj < 2; ++bj)
#pragma unroll
            for (int n = 0; n < 2; ++n) bv[bj][n] = *(const f32x4*)(bp + bj * 32 + 4 * n);
        LAS unsigned char* wp = tl + fr * 144 + fq * 16; LAS const unsigned char* rp = tl + (lane >> 3) * 144 + (lane & 7) * 16;
        bf16_t* gp = O + (size_t)(u.r0 + wr * 64 + (lane >> 3)) * D + u.c0 + wc * 64 + (lane & 7) * 8;
#pragma unroll
        for (int ai = 0; ai < 2; ++ai)
#pragma unroll
            for (int m = 0; m < 4; ++m) {
#pragma unroll
                for (int bj = 0; bj < 2; ++bj) { const f32x4 v0 = acc[ai][bj][m][0] * W8_INV + bv[bj][0], v1 = acc[ai][bj][m][1] * W8_INV + bv[bj][1];
                    u32x4 w; w.x = cvt_pk_bf16(v0[0], v0[1]); w.y = cvt_pk_bf16(v0[2], v0[3]); w.z = cvt_pk_bf16(v1[0], v1[1]); w.w = cvt_pk_bf16(v1[2], v1[3]);
                    *(LAS u32x4*)(wp + bj * 64) = w; }
                EPI_CBAR();
#pragma unroll
                for (int p = 0; p < 2; ++p) { const u32x4 t = *(LAS const u32x4*)(rp + p * 8 * 144); __builtin_nontemporal_store(t, (u32x4*)(gp + (size_t)(ai * HALF + m * 16 + 8 * p) * D)); }
                EPI_CBAR(); }
    }
};
}

#define XB_TMO      128
#define XB_XCNT(j)  (256  + 64 * (j))
#define XB_XSUB(j)  (1280 + 64 * (j))
#define XB_XGEN(j)  (2304 + 64 * (j))
#define XB_TOP      3328
#define XB_TOPGEN   3392
#define XCD_BAR_WORDS 3456
#define XB_SPIN_CAP (1u << 18)
__device__ __forceinline__ unsigned xb_ld(unsigned* p)              { return __hip_atomic_load(p, __ATOMIC_RELAXED, __HIP_MEMORY_SCOPE_AGENT); }
__device__ __forceinline__ unsigned xb_add(unsigned* p, unsigned v) { return __hip_atomic_fetch_add(p, v, __ATOMIC_RELAXED, __HIP_MEMORY_SCOPE_AGENT); }
__device__ __forceinline__ unsigned xb_xcc_id() { return (unsigned)__builtin_amdgcn_s_getreg((3 << 11) | 20) & 0xFu; }
#define XB_SPIN(cond, bar) do { unsigned _sp = 0; while (cond) { __builtin_amdgcn_s_sleep(1); \
    if ((++_sp & 255u) == 0u) { if (xb_ld(&(bar)[XB_TMO])) break; if (_sp > XB_SPIN_CAP) { atomicAdd(&(bar)[XB_TMO], 1u); break; } } } } while (0)
struct XcdBarrier { unsigned* bar; unsigned x; volatile LAS unsigned* st; };
__device__ __forceinline__ XcdBarrier xcd_barrier_post(unsigned* bar, volatile LAS unsigned* st) {
    XcdBarrier b; b.bar = bar; b.x = xb_xcc_id(); b.st = st;
    if (threadIdx.x == 0) (void)xb_add(&bar[XB_XCNT(b.x)], 1u);
    return b;
}
__device__ __forceinline__ void xcd_barrier_complete(unsigned* bar, unsigned x, unsigned& nloc, unsigned& nx) {
    const unsigned G = gridDim.x * gridDim.y * gridDim.z;
    unsigned sum, cnt, mine, sp = 0u;
    for (;;) {
        sum = 0u; cnt = 0u; mine = 0u;
#pragma unroll
        for (unsigned j = 0; j < 16; ++j) { const unsigned c = xb_ld(&bar[XB_XCNT(j)]); sum += c; cnt += (c > 0u) ? 1u : 0u; mine = (j == x) ? c : mine; }
        if (sum == G) break;
        __builtin_amdgcn_s_sleep(1);
        if ((++sp & 255u) == 0u) { if (xb_ld(&bar[XB_TMO])) break; if (sp > XB_SPIN_CAP) { atomicAdd(&bar[XB_TMO], 1u); break; } }
    }
    nloc = mine > 0u ? mine : 1u; nx = cnt > 0u ? cnt : 1u;
}
__device__ __forceinline__ void xcd_barrier(const XcdBarrier& b) {
    asm volatile("s_waitcnt vmcnt(0)" ::: "memory");
    __syncthreads();
    if (threadIdx.x == 0) {
        unsigned* bar = b.bar;
        __builtin_amdgcn_s_waitcnt(0);
        unsigned nloc = b.st[0], nx = b.st[1];
        if (nloc == 0u) { xcd_barrier_complete(bar, b.x, nloc, nx); b.st[0] = nloc; b.st[1] = nx; }
        const unsigned old = xb_add(&bar[XB_XSUB(b.x)], 1u);
        const unsigned gen = old / nloc;
        if (old + 1u == (gen + 1u) * nloc) {
            __builtin_amdgcn_fence(__ATOMIC_RELEASE, "agent");
            asm volatile("s_waitcnt vmcnt(0)" ::: "memory");
            const unsigned og = xb_add(&bar[XB_TOP], 1u);
            const unsigned tg = og / nx;
            if (og + 1u == (tg + 1u) * nx) xb_add(&bar[XB_TOPGEN], 1u);
            else XB_SPIN(xb_ld(&bar[XB_TOPGEN]) == tg, bar);
            __builtin_amdgcn_fence(__ATOMIC_ACQUIRE, "agent");
            xb_add(&bar[XB_XGEN(b.x)], 1u);
            asm volatile("s_waitcnt vmcnt(0)" ::: "memory");
        } else {
            XB_SPIN(xb_ld(&bar[XB_XGEN(b.x)]) == gen, bar);
            __builtin_amdgcn_fence(__ATOMIC_ACQUIRE, "agent");
            asm volatile("s_waitcnt vmcnt(0)" ::: "memory");
        }
    }
    __syncthreads();
}

struct Args {
    const float* in[28]; float* out; unsigned char* ws; int ph_lo, ph_hi;
};
struct Frame {
    LAS unsigned char* lds; volatile LAS unsigned* MISC; unsigned* ctl;
    int tid, lane, wave, G, bid;
};
enum { I_X = 0, I_N1G, I_WIN, I_BGATE, I_TMIX, I_WDU, I_W0, I_AUP, I_A0, I_GUP, I_KK, I_KA, I_RK, I_GNW, I_GNB, I_LNVG, I_LNVB, I_WSP, I_BSP, I_WOUT, I_N2G, I_WR, I_BR, I_WGU, I_BGU, I_WD, I_BDN, I_NFG };

template <class RowMap>
__device__ __forceinline__ void p0_transpose_item(const float* W, int K, int N, bf16_t* WT, const RowMap& rm, LAS float* scr, int item, int lane, unsigned char* WT8 = nullptr) {
    const int nblk = N / 32, kb = item / nblk, nb = item % nblk, k0 = 64 * kb, n0 = 32 * nb;
#pragma unroll 8
    for (int i = 0; i < 32; ++i) { const int kk = 2 * i + (lane >> 5); scr[kk * 33 + (lane & 31)] = W[(size_t)(k0 + kk) * N + n0 + (lane & 31)]; }
    LDS_WAIT(); asm volatile("" ::: "memory");
    const int c = lane & 7;
#pragma unroll
    for (int j = 0; j < 4; ++j) { const int n = (lane >> 3) + 8 * j; const LAS float* s = scr + (8 * c) * 33 + n;
        u32x4 o; o.x = cvt_pk_bf16(s[0 * 33], s[1 * 33]); o.y = cvt_pk_bf16(s[2 * 33], s[3 * 33]); o.z = cvt_pk_bf16(s[4 * 33], s[5 * 33]); o.w = cvt_pk_bf16(s[6 * 33], s[7 * 33]);
        *(u32x4*)(WT + (size_t)rm(n0 + n) * K + k0 + 8 * c) = o;
        if (WT8) *(u32x2*)(WT8 + (size_t)rm(n0 + n) * K + k0 + 8 * c) = (u32x2){cvt_pk4_fp8(s[0 * 33] * W8_SCALE, s[1 * 33] * W8_SCALE, s[2 * 33] * W8_SCALE, s[3 * 33] * W8_SCALE), cvt_pk4_fp8(s[4 * 33] * W8_SCALE, s[5 * 33] * W8_SCALE, s[6 * 33] * W8_SCALE, s[7 * 33] * W8_SCALE)}; }
    LDS_WAIT(); asm volatile("" ::: "memory");
}
struct RmId { __device__ __forceinline__ int operator()(int n) const { return n; } };
struct RmIn { __device__ __forceinline__ int operator()(int n) const { return n < 3360 ? n : n + 224; } };
__device__ __forceinline__ void tr_issue(const float* W, int N, int item, int lane, float (&v)[32]) {
    const int nblk = N / 32, kb = item / nblk, nb = item % nblk, k0 = 64 * kb, n0 = 32 * nb;
    const float* base = W + (size_t)k0 * N + n0;
    const int lo = (lane >> 5) * N + (lane & 31);
#pragma unroll
    for (int i = 0; i < 32; ++i) v[i] = (base + (size_t)(2 * i) * N)[lo];
}
template <class RowMap>
__device__ __forceinline__ void tr_finish(const float (&v)[32], int K, int N, unsigned char* WT, const RowMap& rm, LAS float* scr, int item, int lane) {
    const int nblk = N / 32, kb = item / nblk, nb = item % nblk, k0 = 64 * kb, n0 = 32 * nb;
#pragma unroll
    for (int i = 0; i < 32; ++i) { const int kk = 2 * i + (lane >> 5); scr[kk * 33 + (lane & 31)] = v[i]; }
    LDS_WAIT(); asm volatile("" ::: "memory");
    const int c = lane & 7;
#pragma unroll
    for (int j = 0; j < 4; ++j) { const int n = (lane >> 3) + 8 * j; const LAS float* s = scr + (8 * c) * 33 + n;
        const u32x2 o = (u32x2){cvt_pk4_fp8(s[0 * 33] * W8_SCALE, s[1 * 33] * W8_SCALE, s[2 * 33] * W8_SCALE, s[3 * 33] * W8_SCALE), cvt_pk4_fp8(s[4 * 33] * W8_SCALE, s[5 * 33] * W8_SCALE, s[6 * 33] * W8_SCALE, s[7 * 33] * W8_SCALE)};
        *(u32x2*)(WT + (size_t)rm(n0 + n) * K + k0 + 8 * c) = o; }
    LDS_WAIT(); asm volatile("" ::: "memory");
}
struct RmGu { __device__ __forceinline__ int operator()(int n) const { const int f = n >> 1, up = n & 1; return (f >> 7) * 256 + up * 128 + (f & 127); } };

__device__ __forceinline__ void p0_prologue(Frame& F, const Args& a) {
    unsigned char* ws = a.ws;
    bf16_t* Bin = (bf16_t*)(ws + WS_BIN); bf16_t* Bout = (bf16_t*)(ws + WS_BOUT); bf16_t* Bgu = (bf16_t*)(ws + WS_BGU); bf16_t* Bd = (bf16_t*)(ws + WS_BD);
    LAS float* scr = (LAS float*)(F.lds + RING_OFF + F.wave * 16384);
    const int gw = F.bid * NWAVES + F.wave, NGW = F.G * NWAVES;
    constexpr int I_IN = (D / 64) * (7456 / 32), I_OUT = (D / 64) * (D / 32), I_GU1 = (D / 64) * (2048 / 32), I_D1 = (FF / 64) * (D / 32);
    constexpr int NITEMS = I_IN + I_OUT;
    for (int it = gw; it < NITEMS; it += NGW) {
        int r = it;
        if (r < I_IN) { p0_transpose_item(a.in[I_WIN], D, 7456, Bin, RmIn(), scr, r, ((int)(threadIdx.x & 63u)), ws + WS_BIN8); continue; } r -= I_IN;
        p0_transpose_item(a.in[I_WOUT], D, D, Bout, RmId(), scr, r, ((int)(threadIdx.x & 63u)));
        (void)Bgu; (void)Bd; (void)I_GU1; (void)I_D1;
    }
    const int gt = F.bid * (NWAVES * 64) + ((int)threadIdx.x), NGT = F.G * NWAVES * 64;
    {
        u32x4* p = (u32x4*)(Bin + (size_t)3360 * D);
        for (int i = gt; i < 224 * 128; i += NGT) p[i] = (u32x4){0u, 0u, 0u, 0u};
    }
    {   float* bz = (float*)(ws + WS_MISC + MO_BIASZ);
        for (int i = gt; i < NZ; i += NGT) bz[i] = (i >= ZC_GA) ? a.in[I_BGATE][i - ZC_GA] : 0.f;
    }
    {   float* bg = (float*)(ws + WS_MISC + MO_BGU);
        for (int i = gt; i < NE * 2048; i += NGT) { const int e = i >> 11, n = i & 2047; bg[(size_t)e * 2048 + RmGu()(n)] = a.in[I_BGU][i]; }
    }
    {   bf16_t* wh = (bf16_t*)(ws + WS_MISC + MO_WRT); bf16_t* wl = wh + NE * D;
        for (int i = gt; i < NE * D; i += NGT) { const int e = i >> 10, k = i & 1023; const float w = a.in[I_WR][(size_t)k * NE + e];
            const unsigned h = cvt_pk_bf16(w, 0.f) & 0xffffu; const float rlo = w - bf_lo(h); wh[i] = (bf16_t)h; wl[i] = (bf16_t)(cvt_pk_bf16(rlo, 0.f) & 0xffffu); }
    }
    {   bf16_t* lt = (bf16_t*)(ws + WS_MISC + MO_LT);
        for (int i = gt; i < D * 288; i += NGT) { const int n = i / 288, k = i - n * 288;
            const float w = (k < 64) ? a.in[I_WDU][(size_t)k * D + n] : (k < 128 ? a.in[I_AUP][(size_t)(k - 64) * D + n] : a.in[I_GUP][(size_t)(k - 128) * D + n]);
            lt[i] = (bf16_t)(cvt_pk_bf16(w, 0.f) & 0xffffu); }
    }
    const float* x = a.in[I_X]; const float* g1 = a.in[I_N1G]; bf16_t* Hh = (bf16_t*)(ws + WS_H);
    f32x4 gv[4];
#pragma unroll
    for (int j = 0; j < 4; ++j) gv[j] = *((const f32x4*)g1 + ((int)(threadIdx.x & 63u)) + 64 * j);
    for (int m = gw; m < T; m += NGW) {
        const f32x4* xr = (const f32x4*)(x + (size_t)m * D) + ((int)(threadIdx.x & 63u));
        f32x4 v[4]; float s = 0.f;
#pragma unroll
        for (int j = 0; j < 4; ++j) { v[j] = xr[64 * j]; s += (v[j].x * v[j].x + v[j].y * v[j].y) + (v[j].z * v[j].z + v[j].w * v[j].w); }
        const float rstd = __builtin_amdgcn_rsqf(wave_sum(s) * (1.f / D) + RMS_EPS);
        u32x2* o8 = (u32x2*)(Hh + (size_t)m * D) + ((int)(threadIdx.x & 63u));
#pragma unroll
        for (int j = 0; j < 4; ++j) { const f32x4 y = v[j] * rstd * gv[j]; o8[64 * j] = (u32x2){cvt_pk_bf16(y.x, y.y), cvt_pk_bf16(y.z, y.w)};
            ((unsigned*)(ws + WS_H8 + (size_t)m * D))[((int)(threadIdx.x & 63u)) + 64 * j] = cvt_pk4_fp8(clamp448(y.x), clamp448(y.y), clamp448(y.z), clamp448(y.w)); }
    }
}

constexpr int TC = 32, NMC = TC / 4, NCH = 2048 / TC;
constexpr int RC_AT = 0;
constexpr int RC_RT = RC_AT + TC * 128;
constexpr int RC_BT = RC_RT + TC * 128;
constexpr int RC_KT = RC_BT + TC * 128;
constexpr int SB_CUMF = RC_KT + TC * 128;
constexpr int RC_VB = SB_CUMF + TC * 256;
constexpr int RC_P4 = RC_VB + TC * 128;
constexpr int RC_SCL = RC_P4 + NMC * 256;
constexpr int SB_RB = RC_SCL + NMC * 128;
constexpr int SB_KP = SB_RB + TC * 128;
constexpr int SB_V = SB_KP + TC * 256;
constexpr int SB_G = SB_V + TC * 256;
constexpr int SB_GA0 = SB_G + TC * 256;
constexpr int SB_WRAW = SB_GA0 + 2 * TC * 128;
constexpr int SB_ARAW = SB_WRAW + TC * 256;
constexpr int SB_Y = SB_WRAW;
constexpr int SB_LABF = SB_ARAW;
constexpr int SB_TIMG = SB_LABF + 2048;
constexpr int SB_LAKIMG = SB_TIMG + 2048;
constexpr int SB_MRIMG = SB_LAKIMG + 2048;
constexpr int SB_RAWRKV = SB_ARAW + TC * 256;
constexpr int SB_ALT = SB_RAWRKV + (TC + 1) * 384;
constexpr int SB_END = SB_ALT + TC * 576;
constexpr int SB_PBAR = LDSCTL_OFF + 1536;
constexpr int SB_CST = LDSCTL_OFF + 2048;
static_assert(SB_END + 4 * 8448 <= LDSCTL_OFF && SB_CST + 2560 <= LDS_BYTES, "scan LDS map (+ 4 conversion scratch tiles)");
constexpr int NP_RKV = (TC + 1) * 24;

__device__ __forceinline__ f32x4 ld_bf4(const bf16_t* p) { const u32x2 v = *(const u32x2*)p; return (f32x4){bf_lo(v.x), bf_hi(v.x), bf_lo(v.y), bf_hi(v.y)}; }
__device__ __forceinline__ f32x4 lds_bf4(const LAS unsigned char* p) { const u32x2 v = *(const LAS u32x2*)p; return (f32x4){bf_lo(v.x), bf_hi(v.x), bf_lo(v.y), bf_hi(v.y)}; }
__device__ __forceinline__ void ld_bf8(const bf16_t* p, float (&o)[8]) { const u32x4 v = *(const u32x4*)p;
    o[0] = bf_lo(v.x); o[1] = bf_hi(v.x); o[2] = bf_lo(v.y); o[3] = bf_hi(v.y); o[4] = bf_lo(v.z); o[5] = bf_hi(v.z); o[6] = bf_lo(v.w); o[7] = bf_hi(v.w); }
__device__ __forceinline__ void un8(const u32x4 v, float (&o)[8]) {
    o[0] = bf_lo(v.x); o[1] = bf_hi(v.x); o[2] = bf_lo(v.y); o[3] = bf_hi(v.y); o[4] = bf_lo(v.z); o[5] = bf_hi(v.z); o[6] = bf_lo(v.w); o[7] = bf_hi(v.w); }
__device__ __forceinline__ bf16x8 pack8(const float (&o)[8]) { u32x4 w; w.x = cvt_pk_bf16(o[0], o[1]); w.y = cvt_pk_bf16(o[2], o[3]); w.z = cvt_pk_bf16(o[4], o[5]); w.w = cvt_pk_bf16(o[6], o[7]); return __builtin_bit_cast(bf16x8, w); }

__device__ __forceinline__ void p2a_act(Frame& F, const Args& a) {
    const bf16_t* Z = (const bf16_t*)(a.ws + WS_Z); bf16_t* AL = (bf16_t*)(a.ws + WS_AL);
    const float* tml = a.in[I_TMIX] + TM_DL;
    const int gt = F.bid * (NWAVES * 64) + ((int)threadIdx.x), NGT = F.G * NWAVES * 64;
    for (int it = gt; it < T * 36; it += NGT) { const int t = it / 36, p = it - t * 36;
        float c[8], pv[8], m8[8];
        ld_bf8(Z + (size_t)t * NZ2 + Z2_L + 8 * p, c);
        if ((t & (SEQ - 1)) != 0) ld_bf8(Z + (size_t)(t - 1) * NZ2 + Z2_L + 8 * p, pv); else {
#pragma unroll
            for (int j = 0; j < 8; ++j) pv[j] = 0.f; }
        const f32x4 ta = *(const f32x4*)(tml + 8 * p), tb = *(const f32x4*)(tml + 8 * p + 4);
#pragma unroll
        for (int j = 0; j < 8; ++j) { const float tmj = (j < 4) ? ta[j] : tb[j - 4]; m8[j] = c[j] + (pv[j] - c[j]) * tmj; }
        if (p < 8) {
#pragma unroll
            for (int j = 0; j < 8; ++j) m8[j] = 1.0f - 2.0f * __builtin_amdgcn_rcpf(1.0f + __expf(2.0f * m8[j])); }
        else if (p >= 16) {
#pragma unroll
            for (int j = 0; j < 8; ++j) m8[j] = sigmoidf_(m8[j]); }
        *(bf16x8*)(AL + (size_t)t * 288 + 8 * p) = pack8(m8);
    }
}

template <int SUB> __device__ __forceinline__ void scan_sub(f32x4 (&acc)[4], const LAS unsigned char* L, int fn, int g, int row) {
    const LAS unsigned char* xa = L + RC_AT + (16 * SUB + fn) * 128 + 8 * g; const LAS unsigned char* xr = L + RC_RT + (16 * SUB + fn) * 128 + 8 * g;
    u32x4 xa0, xa1, xr0, xr1;
    { const u32x2 p0 = *(const LAS u32x2*)(xa), p1 = *(const LAS u32x2*)(xa + 32), p2 = *(const LAS u32x2*)(xa + 64), p3 = *(const LAS u32x2*)(xa + 96);
      xa0 = (u32x4){p0.x, p0.y, p1.x, p1.y}; xa1 = (u32x4){p2.x, p2.y, p3.x, p3.y}; }
    { const u32x2 p0 = *(const LAS u32x2*)(xr), p1 = *(const LAS u32x2*)(xr + 32), p2 = *(const LAS u32x2*)(xr + 64), p3 = *(const LAS u32x2*)(xr + 96);
      xr0 = (u32x4){p0.x, p0.y, p1.x, p1.y}; xr1 = (u32x4){p2.x, p2.y, p3.x, p3.y}; }
    const bf16x8 tf = *(const LAS bf16x8*)(L + SB_TIMG + ((SUB * 16 + fn) * 4 + g) * 16), lakf = *(const LAS bf16x8*)(L + SB_LAKIMG + ((SUB * 16 + fn) * 4 + g) * 16),
                 mrf = *(const LAS bf16x8*)(L + SB_MRIMG + ((SUB * 16 + fn) * 4 + g) * 16);
    const int trow = (16 * SUB + 4 * g + (fn >> 2)) * 128 + 8 * (fn & 3);
    const u32x2 vt = __builtin_bit_cast(u32x2, __builtin_amdgcn_ds_read_tr16_b64_v4i16((LAS s16x4*)(L + RC_VB + trow + (row - fn) * 2)));
    bf16x8 bk[4]; f32x4 p16[4];
#pragma unroll
    for (int jb = 0; jb < 4; ++jb) { const u32x2 bq = __builtin_bit_cast(u32x2, __builtin_amdgcn_ds_read_tr16_b64_v4i16((LAS s16x4*)(L + RC_BT + trow + 32 * jb))),
                                                 kq = __builtin_bit_cast(u32x2, __builtin_amdgcn_ds_read_tr16_b64_v4i16((LAS s16x4*)(L + RC_KT + trow + 32 * jb)));
        bk[jb] = __builtin_bit_cast(bf16x8, (u32x4){bq.x, bq.y, kq.x, kq.y}); p16[jb] = *(const LAS f32x4*)(L + RC_P4 + (SUB * 64 + 16 * jb + 4 * g) * 4); }
    const u32x4 vq = (u32x4){vt.x, vt.y, 0u, 0u};
    const f32x4 lv = __builtin_amdgcn_mfma_f32_16x16x32_bf16(lakf, __builtin_bit_cast(bf16x8, vq), (f32x4){0.f, 0.f, 0.f, 0.f}, 0, 0, 0);
    float t0[8] = {acc[0][0], acc[0][1], acc[0][2], acc[0][3], acc[1][0], acc[1][1], acc[1][2], acc[1][3]}, t1[8] = {acc[2][0], acc[2][1], acc[2][2], acc[2][3], acc[3][0], acc[3][1], acc[3][2], acc[3][3]};
    const bf16x8 sf0 = pack8(t0), sf1 = pack8(t1);
    f32x4 gq = __builtin_amdgcn_mfma_f32_16x16x32_bf16(__builtin_bit_cast(bf16x8, xa0), sf0, lv, 0, 0, 0);
    gq = __builtin_amdgcn_mfma_f32_16x16x32_bf16(__builtin_bit_cast(bf16x8, xa1), sf1, gq, 0, 0, 0);
    f32x4 hq = __builtin_amdgcn_mfma_f32_16x16x32_bf16(__builtin_bit_cast(bf16x8, xr0), sf0, (f32x4){0.f, 0.f, 0.f, 0.f}, 0, 0, 0);
    hq = __builtin_amdgcn_mfma_f32_16x16x32_bf16(__builtin_bit_cast(bf16x8, xr1), sf1, hq, 0, 0, 0);
    const u32x4 gl = (u32x4){cvt_pk_bf16(gq[0], gq[1]), cvt_pk_bf16(gq[2], gq[3]), 0u, 0u};
    const f32x4 uq = __builtin_amdgcn_mfma_f32_16x16x32_bf16(tf, __builtin_bit_cast(bf16x8, gl), (f32x4){0.f, 0.f, 0.f, 0.f}, 0, 0, 0);
    const u32x4 uv = (u32x4){cvt_pk_bf16(uq[0], uq[1]), cvt_pk_bf16(uq[2], uq[3]), vt.x, vt.y};
    const bf16x8 uvf = __builtin_bit_cast(bf16x8, uv);
    const f32x4 yq = __builtin_amdgcn_mfma_f32_16x16x32_bf16(mrf, uvf, hq, 0, 0, 0);
#pragma unroll
    for (int jb = 0; jb < 4; ++jb) acc[jb] = __builtin_amdgcn_mfma_f32_16x16x32_bf16(bk[jb], uvf, acc[jb], 0, 0, 0);
#pragma unroll
    for (int r = 0; r < 4; ++r) *(LAS float*)((LAS unsigned char*)L + SB_Y + (16 * SUB + 4 * g + r) * 256 + 4 * row) = yq[r];
#pragma unroll
    for (int jb = 0; jb < 4; ++jb) acc[jb] = acc[jb] * p16[jb];
    __builtin_amdgcn_sched_barrier(0);
    if constexpr (SUB + 1 < TC / 16) scan_sub<SUB + 1>(acc, L, fn, g, row);
}
__device__ __forceinline__ void pbar(LAS unsigned* cnt, unsigned target) {
    asm volatile("s_waitcnt lgkmcnt(0)" ::: "memory");
    if ((threadIdx.x & 63u) == 0u) __hip_atomic_fetch_add(cnt, 1u, __ATOMIC_RELAXED, __HIP_MEMORY_SCOPE_WORKGROUP);
    while (__hip_atomic_load(cnt, __ATOMIC_RELAXED, __HIP_MEMORY_SCOPE_WORKGROUP) < target) __builtin_amdgcn_s_sleep(1);
    asm volatile("" ::: "memory");
}

__device__ __forceinline__ void parrive(LAS unsigned* cnt) {
    asm volatile("s_waitcnt lgkmcnt(0)" ::: "memory");
    if ((threadIdx.x & 63u) == 0u) __hip_atomic_fetch_add(cnt, 1u, __ATOMIC_RELAXED, __HIP_MEMORY_SCOPE_WORKGROUP);
}
constexpr int SB_DUMMY = 150528;
__device__ __forceinline__ void glds_touch(const void* g, unsigned ldsoff) {
    unsigned sv;
    asm volatile("s_mov_b32 %0, m0\n\ts_mov_b32 m0, %2\n\ts_nop 0\n\tglobal_load_lds_dwordx4 %1, off\n\ts_mov_b32 m0, %0" : "=&s"(sv) : "v"(g), "s"(ldsoff) : "memory");
}
__device__ __forceinline__ void p2_scan(Frame& F, const Args& a, size_t mo_off = WS_M) {
    const unsigned char* HMb = a.ws + WS_HM; bf16_t* Mo = (bf16_t*)(a.ws + mo_off); const bf16_t* AL = (const bf16_t*)(a.ws + WS_AL);
    LAS unsigned char* L = F.lds;
    LAS unsigned* PB = (LAS unsigned*)(F.lds + SB_PBAR);
    const int w = F.wave, tid = ((int)threadIdx.x);
    const float* tmix = a.in[I_TMIX];
    for (int unit = F.bid; unit < NB_ * NH; unit += F.G) {
        const int b = unit / NH, h = unit % NH;
        const size_t trow0 = (size_t)b * SEQ;
        {   LAS float* CST = (LAS float*)(F.lds + SB_CST);
            for (int i = tid; i < 640; i += NWAVES * 64) { const int a_ = i >> 6, c_ = h * HD + (i & 63);
                const float* sp = (a_ == 0) ? tmix + TM_R : (a_ == 1) ? tmix + TM_K : (a_ == 2) ? tmix + TM_V : (a_ == 3) ? a.in[I_W0] : (a_ == 4) ? a.in[I_A0] : (a_ == 5) ? a.in[I_KK] : (a_ == 6) ? a.in[I_KA] : (a_ == 7) ? a.in[I_RK] : (a_ == 8) ? a.in[I_GNW] : a.in[I_GNB];
                CST[i] = sp[c_]; }
            if (tid == 0) *PB = 0u;
        }
        bf16x8 Bw[2], Ba[2], Bg[5];
        {   const int lane0 = tid & 63; const bf16_t* lp = (const bf16_t*)(a.ws + WS_MISC + MO_LT) + (size_t)(h * HD + (w & 3) * 16 + (lane0 & 15)) * 288 + 8 * (lane0 >> 4);
#pragma unroll
            for (int sx = 0; sx < 2; ++sx) { Bw[sx] = *(const bf16x8*)(lp + 32 * sx); Ba[sx] = *(const bf16x8*)(lp + 64 + 32 * sx); }
#pragma unroll
            for (int sx = 0; sx < 5; ++sx) Bg[sx] = *(const bf16x8*)(lp + 128 + 32 * sx);
        }
        unsigned pbt = 0u;
        f32x4 acc[4];
#pragma unroll
        for (int g = 0; g < 4; ++g) acc[g] = (f32x4){0.f, 0.f, 0.f, 0.f};
        __syncthreads();
        for (int ch = -1; ch < NCH; ++ch) {
            int tidv = tid; asm volatile("" : "+v"(tidv));
            const int lane = tidv & 63, fn = lane & 15, kg = lane >> 4;
            const int tl = tidv >> 4, q = tidv & 15, col4 = h * HD + 4 * q;
            const LAS f32x4* CQ = (const LAS f32x4*)(F.lds + SB_CST) + q;
            if (w < 4) {
                if (ch >= 0) {
                    scan_sub<0>(acc, L, fn, kg, 16 * w + fn);
                }
            } else {
                const int ts = tidv - 256, pw = w - 4;
                const bool do_cv = (ch >= 0 && (ch & 3) < 3 && F.G == 256);
                const int cvi = F.bid * 192 + pw * 48 + (ch >> 2) * 3 + (ch & 3);
                float cv[32];
                if (do_cv) { if (cvi < NE * 1024) tr_issue(a.in[I_WGU] + (size_t)(cvi >> 10) * D * 2048, 2048, cvi & 1023, lane, cv);
                             else { const int r_ = cvi - NE * 1024; tr_issue(a.in[I_WD] + (size_t)(r_ >> 9) * FF * D, D, r_ & 511, lane, cv); } }
                if (ch + 1 < NCH) {
                    const unsigned char* cb_ = HMb + ((long)unit * SEQ + (long)(ch + 1) * TC - 1) * 512L;
                    const unsigned char* ab_ = (const unsigned char*)(AL + (trow0 + (size_t)(ch + 1) * TC) * 288);
                    u32x4 R4[4], G1, A5[5];
#pragma unroll
                    for (int j = 0; j < 4; ++j) { const int pid = ts + 256 * j; R4[j] = (u32x4){0u, 0u, 0u, 0u};
                        if (pid < NP_RKV && !(ch + 1 == 0 && pid < 24)) { const int row = pid / 24, pc = pid % 24, arr = pc >> 3, c8 = pc & 7; R4[j] = *(const u32x4*)(cb_ + row * 512 + (arr * 8 + c8) * 16); } }
                    G1 = *(const u32x4*)(cb_ + ((ts >> 3) + 1) * 512 + 384 + (ts & 7) * 16);
#pragma unroll
                    for (int j = 0; j < 5; ++j) if (ts + 256 * j < TC * 36) A5[j] = *(const u32x4*)(ab_ + (ts + 256 * j) * 16);
#pragma unroll
                    for (int j = 0; j < 4; ++j) if (ts + 256 * j < NP_RKV) *(LAS u32x4*)(L + SB_RAWRKV + (ts + 256 * j) * 16) = R4[j];
                    *(LAS u32x4*)(L + SB_GA0 + ((ch + 1) & 1) * (TC * 128) + ts * 16) = G1;
#pragma unroll
                    for (int j = 0; j < 5; ++j) if (ts + 256 * j < TC * 36) *(LAS u32x4*)(L + SB_ALT + (ts + 256 * j) * 16) = A5[j];
                }
                if (do_cv) { LAS float* scr = (LAS float*)(L + SB_END + pw * 8448);
                    if (cvi < NE * 1024) tr_finish(cv, D, 2048, (unsigned char*)(a.ws + WS_BGU) + (size_t)(cvi >> 10) * 2048 * D, RmGu(), scr, cvi & 1023, lane);
                    else { const int r_ = cvi - NE * 1024; tr_finish(cv, FF, D, (unsigned char*)(a.ws + WS_BD) + (size_t)(r_ >> 9) * D * FF, RmId(), scr, r_ & 511, lane); } }
            }
            __syncthreads();
            const int mb = w >> 2, nb = w & 3;
            if (ch >= 0) {
                const int t = ch * TC + tl; const int o = tl * 256 + 16 * q;
                const f32x4 kpv = *(const LAS f32x4*)(L + SB_KP + o), vv = *(const LAS f32x4*)(L + SB_V + o), gv = *(const LAS f32x4*)(L + SB_G + o);
                const f32x4 y = *(const LAS f32x4*)(L + SB_Y + o);
                const f32x4 rv = lds_bf4(L + SB_RB + tl * 128 + 8 * q);
                const float mean = allsum16((y[0] + y[1]) + (y[2] + y[3])) * (1.0f / 64.0f);
                const f32x4 dv = y - mean;
                const float var = allsum16((dv[0] * dv[0] + dv[1] * dv[1]) + (dv[2] * dv[2] + dv[3] * dv[3])) * (1.0f / 64.0f);
                const float rstd = __builtin_amdgcn_rsqf(var + GN_EPS);
                const f32x4 c_rk = CQ[16 * 7], c_gw = CQ[16 * 8], c_gb = CQ[16 * 9];
                const float bonus = allsum16((rv[0] * kpv[0] * c_rk[0] + rv[1] * kpv[1] * c_rk[1]) + (rv[2] * kpv[2] * c_rk[2] + rv[3] * kpv[3] * c_rk[3]));
                const f32x4 ga = lds_bf4(L + SB_GA0 + (ch & 1) * (TC * 128) + tl * 128 + 8 * q);
                f32x4 ov;
#pragma unroll
                for (int j = 0; j < 4; ++j) ov[j] = ((dv[j] * rstd * c_gw[j] + c_gb[j]) + bonus * vv[j]) * gv[j] * ga[j];
                *(u32x2*)(Mo + (trow0 + t) * D + col4) = (u32x2){cvt_pk_bf16(ov[0], ov[1]), cvt_pk_bf16(ov[2], ov[3])};
            }
            __syncthreads();
            if (ch + 1 < NCH) {
                {   f32x4 aw = (f32x4){0.f, 0.f, 0.f, 0.f}, aa = aw, ag = aw;
                    const LAS unsigned char* ap = L + SB_ALT + (16 * mb + fn) * 576 + kg * 16;
#pragma unroll
                    for (int sx = 0; sx < 9; ++sx) { const bf16x8 af = *(const LAS bf16x8*)(ap + sx * 64);
                        if (sx < 2) aw = __builtin_amdgcn_mfma_f32_16x16x32_bf16(Bw[sx], af, aw, 0, 0, 0);
                        else if (sx < 4) aa = __builtin_amdgcn_mfma_f32_16x16x32_bf16(Ba[sx - 2], af, aa, 0, 0, 0);
                        else ag = __builtin_amdgcn_mfma_f32_16x16x32_bf16(Bg[sx - 4], af, ag, 0, 0, 0); }
                    const int o = (16 * mb + fn) * 256 + (nb * 16 + 4 * kg) * 4;
                    const LAS f32x4* CW = (const LAS f32x4*)(F.lds + SB_CST) + (4 * nb + kg); const f32x4 c_w0 = CW[48], c_a0 = CW[64];
                    f32x4 cumv;
#pragma unroll
                    for (int r = 0; r < 4; ++r) { aw[r] = -0.60653066f * sigmoidf_(aw[r] + c_w0[r]);
                        aa[r] = sigmoidf_(aa[r] + c_a0[r]);
                        float x = aw[r]; x += dpp<0x111>(x); x += dpp<0x112>(x); x += dpp<0x114>(x); x += dpp<0x118>(x); cumv[r] = x; }
                    *(LAS f32x4*)(L + SB_WRAW + o) = aw; *(LAS f32x4*)(L + SB_ARAW + o) = aa; *(LAS f32x4*)(L + SB_CUMF + o) = cumv; *(LAS f32x4*)(L + SB_G + o) = ag;
                }
                __syncthreads();
                {   const LAS unsigned char* rc = L + SB_RAWRKV + (tl + 1) * 384 + 8 * q; const LAS unsigned char* rp_ = rc - 384;
                    f32x4 r = lds_bf4(rc), k = lds_bf4(rc + 128), v = lds_bf4(rc + 256);
                    const f32x4 rp = lds_bf4(rp_), kp_ = lds_bf4(rp_ + 128), vp = lds_bf4(rp_ + 256);
                    const f32x4 tm_r = CQ[0], tm_k = CQ[16], tm_v = CQ[32], c_kk = CQ[80], c_ka = CQ[96];
                    r = r + (rp - r) * tm_r; k = k + (kp_ - k) * tm_k; v = v + (vp - v) * tm_v;
                    const int o = tl * 256 + 16 * q;
                    const f32x4 lw = *(const LAS f32x4*)(L + SB_WRAW + o), av = *(const LAS f32x4*)(L + SB_ARAW + o), cum = *(const LAS f32x4*)(L + SB_CUMF + o);
                    f32x4 kk, kpv, nbv; float ss = 0.f;
#pragma unroll
                    for (int j = 0; j < 4; ++j) { kk[j] = k[j] * c_kk[j]; ss += kk[j] * kk[j]; kpv[j] = k[j] * (1.0f + (av[j] - 1.0f) * c_ka[j]); }
                    ss = allsum16(ss);
                    const float inv = __builtin_amdgcn_rcpf(fmaxf(__builtin_amdgcn_sqrtf(ss), 1e-12f));
#pragma unroll
                    for (int j = 0; j < 4; ++j) { kk[j] *= inv; nbv[j] = -kk[j] * av[j]; }
                    f32x4 at, bt, kt, rt, p4;
#pragma unroll
                    for (int j = 0; j < 4; ++j) { const float P = __expf(cum[j]), iP = __builtin_amdgcn_rcpf(P), Pm1 = __expf(cum[j] - lw[j]);
                        at[j] = kk[j] * Pm1; bt[j] = nbv[j] * iP; kt[j] = kpv[j] * iP; rt[j] = r[j] * P; p4[j] = P; }
                    *(LAS u32x2*)(L + RC_AT + tl * 128 + 8 * q) = (u32x2){cvt_pk_bf16(at[0], at[1]), cvt_pk_bf16(at[2], at[3])};
                    *(LAS u32x2*)(L + RC_RT + tl * 128 + 8 * q) = (u32x2){cvt_pk_bf16(rt[0], rt[1]), cvt_pk_bf16(rt[2], rt[3])};
                    *(LAS u32x2*)(L + RC_BT + tl * 128 + 8 * q) = (u32x2){cvt_pk_bf16(bt[0], bt[1]), cvt_pk_bf16(bt[2], bt[3])};
                    *(LAS u32x2*)(L + RC_KT + tl * 128 + 8 * q) = (u32x2){cvt_pk_bf16(kt[0], kt[1]), cvt_pk_bf16(kt[2], kt[3])};
                    *(LAS u32x2*)(L + RC_VB + tl * 128 + 8 * q) = (u32x2){cvt_pk_bf16(v[0], v[1]), cvt_pk_bf16(v[2], v[3])};
                    if ((tl & 15) == 15) *(LAS f32x4*)(L + RC_P4 + ((tl >> 4) * 64 + 4 * q) * 4) = p4;
                    *(LAS u32x2*)(L + SB_RB + tl * 128 + 8 * q) = (u32x2){cvt_pk_bf16(r[0], r[1]), cvt_pk_bf16(r[2], r[3])};
                    *(LAS f32x4*)(L + SB_KP + o) = kpv; *(LAS f32x4*)(L + SB_V + o) = v;
                }
                __syncthreads();
                {   const int sub = w >> 2, mx = w & 3;
                    const LAS unsigned char* Ai = L + ((mx & 2) ? RC_RT : RC_AT) + (16 * sub + fn) * 128 + kg * 16; const LAS unsigned char* Bi = L + ((mx & 1) ? RC_KT : RC_BT) + (16 * sub + fn) * 128 + kg * 16;
                    const bf16x8 a0 = *(const LAS bf16x8*)(Ai), a1 = *(const LAS bf16x8*)(Ai + 64), b0 = *(const LAS bf16x8*)(Bi), b1 = *(const LAS bf16x8*)(Bi + 64);
                    f32x4 dt = __builtin_amdgcn_mfma_f32_16x16x32_bf16(b0, a0, (f32x4){0.f, 0.f, 0.f, 0.f}, 0, 0, 0);
                    dt = __builtin_amdgcn_mfma_f32_16x16x32_bf16(b1, a1, dt, 0, 0, 0);
                    if (mx != 0) {
#pragma unroll
                        for (int r = 0; r < 4; ++r) { const int s_ = 4 * kg + r; const bool keep = (mx < 2) ? (s_ < fn) : (s_ <= fn); dt[r] = keep ? dt[r] : 0.f; }
                        const u32x2 pk = (u32x2){cvt_pk_bf16(dt[0], dt[1]), cvt_pk_bf16(dt[2], dt[3])};
                        if (mx == 1) *(LAS u32x4*)(L + SB_LAKIMG + ((sub * 16 + fn) * 4 + kg) * 16) = (u32x4){pk.x, pk.y, 0u, 0u};
                        else *(LAS u32x2*)(L + SB_MRIMG + ((sub * 16 + fn) * 4 + kg) * 16 + ((mx == 3) ? 8 : 0)) = pk;
                    } else {
#define MM16(XT, Y, C) __builtin_amdgcn_mfma_f32_16x16x4f32((XT)[3], (Y)[3], __builtin_amdgcn_mfma_f32_16x16x4f32((XT)[2], (Y)[2], __builtin_amdgcn_mfma_f32_16x16x4f32((XT)[1], (Y)[1], \
                                       __builtin_amdgcn_mfma_f32_16x16x4f32((XT)[0], (Y)[0], (C), 0, 0, 0), 0, 0, 0), 0, 0, 0), 0, 0, 0)
                        f32x4 d = __builtin_amdgcn_mfma_f32_16x16x32_bf16(a0, b0, (f32x4){0.f, 0.f, 0.f, 0.f}, 0, 0, 0);
                        d = __builtin_amdgcn_mfma_f32_16x16x32_bf16(a1, b1, d, 0, 0, 0);
                        f32x4 Lm, Lt, T1, T1t; const f32x4 z4 = (f32x4){0.f, 0.f, 0.f, 0.f};
#pragma unroll
                        for (int r = 0; r < 4; ++r) { const int e_ = 4 * kg + r; Lm[r] = (fn < e_) ? d[r] : 0.f; Lt[r] = (e_ < fn) ? dt[r] : 0.f; const float id = (e_ == fn) ? 1.0f : 0.f; T1[r] = Lm[r] + id; T1t[r] = Lt[r] + id; }
                        const f32x4 X2 = MM16(Lt, Lm, z4), X2t = MM16(Lm, Lt, z4);
                        const f32x4 T2 = MM16(X2t, T1, T1), T2t = MM16(T1, X2t, T1t);
                        const f32x4 X4 = MM16(X2t, X2, z4), X4t = MM16(X2, X2t, z4);
                        const f32x4 T3 = MM16(X4t, T2, T2), T3t = MM16(T2, X4t, T2t);
                        const f32x4 X8t = MM16(X4, X4t, z4);
                        const f32x4 T4t = MM16(T3, X8t, T3t);
#undef MM16
                        *(LAS u32x4*)(L + SB_TIMG + ((sub * 16 + fn) * 4 + kg) * 16) = (u32x4){cvt_pk_bf16(T4t[0], T4t[1]), cvt_pk_bf16(T4t[2], T4t[3]), 0u, 0u};
                    }
                }
                __syncthreads();
            }
        }
    }
}

constexpr int VN_STRIDE = 272;
struct TrQ { u32x2 a[8], b[8]; };
__device__ __forceinline__ void p3_gmlp(Frame& F, const Args& a) {
    const bf16_t* Z = (const bf16_t*)(a.ws + WS_Z); const bf16_t* Mo = (const bf16_t*)(a.ws + WS_M); bf16_t* M2 = (bf16_t*)(a.ws + WS_M2);
    LAS unsigned char* VN = F.lds + RING_OFF;
    LAS f32x2* ST = (LAS f32x2*)(F.lds + RING_OFF + 128 * VN_STRIDE);
    LAS f32x2* SP = ST + 128;
    const int lane = ((int)(threadIdx.x & 63u)), w = F.wave, tid = ((int)threadIdx.x);
    const float* lng = a.in[I_LNVG]; const float* lnb = a.in[I_LNVB]; const float* wsp = a.in[I_WSP]; const float* bsp = a.in[I_BSP];
    for (int unit = F.bid; unit < NB_ * (SEQ / 128); unit += F.G) {
        const size_t t0 = (size_t)unit * 128;
#pragma unroll 4
        for (int rr = 0; rr < 16; ++rr) { const int j = 16 * w + rr;
            const bf16_t* p = Z + (t0 + j) * NZ2 + Z2_VG + 16 * lane; float c0[8], c1[8]; ld_bf8(p, c0); ld_bf8(p + 8, c1);
            float s = 0.f, s2 = 0.f;
#pragma unroll
            for (int i = 0; i < 8; ++i) { s += c0[i] + c1[i]; s2 += c0[i] * c0[i] + c1[i] * c1[i]; }
            s = allsum16(s); s2 = allsum16(s2);
            if ((lane & 15) == 0) SP[j * 4 + (lane >> 4)] = (f32x2){s, s2};
        }
        __syncthreads();
        if (tid < 128) { const f32x2 p0 = SP[tid * 4], p1 = SP[tid * 4 + 1], p2 = SP[tid * 4 + 2], p3 = SP[tid * 4 + 3];
            const float s = (p0.x + p1.x) + (p2.x + p3.x), s2 = (p0.y + p1.y) + (p2.y + p3.y);
            const float mean = s * (1.0f / 1024.0f), var = fmaxf(s2 * (1.0f / 1024.0f) - mean * mean, 0.f);
            ST[tid] = (f32x2){mean, __builtin_amdgcn_rsqf(var + LN_EPS)}; }
        __syncthreads();
        const int lr = tid >> 4, lc = tid & 15;
        u32x4 raw[4];
#pragma unroll
        for (int it = 0; it < 4; ++it) raw[it] = *(const u32x4*)(Z + (t0 + lr + 32 * it) * NZ2 + Z2_VG + lc * 8);
        for (int g = 0; g < 8; ++g) {
            {   const f32x4 g0 = *(const f32x4*)(lng + g * 128 + lc * 8), g1 = *(const f32x4*)(lng + g * 128 + lc * 8 + 4);
                const f32x4 b0 = *(const f32x4*)(lnb + g * 128 + lc * 8), b1 = *(const f32x4*)(lnb + g * 128 + lc * 8 + 4);
#pragma unroll
                for (int it = 0; it < 4; ++it) { const int j = lr + 32 * it; const f32x2 st = ST[j];
                    float c[8], o[8]; un8(raw[it], c);
#pragma unroll
                    for (int i = 0; i < 8; ++i) { const float gg = (i < 4) ? g0[i] : g1[i - 4], bb = (i < 4) ? b0[i] : b1[i - 4]; o[i] = (c[i] - st.x) * st.y * gg + bb; }
                    *(LAS bf16x8*)(VN + j * VN_STRIDE + lc * 16) = pack8(o); }
                if (g + 1 < 8) {
#pragma unroll
                    for (int it = 0; it < 4; ++it) raw[it] = *(const u32x4*)(Z + (t0 + lr + 32 * it) * NZ2 + Z2_VG + (g + 1) * 128 + lc * 8); }
            }
            __syncthreads();
            {   const int fi = lane & 15, kg = lane >> 4, i = 16 * w + fi, tq = fi >> 2, tp = fi & 3;
                f32x4 acc[8];
#pragma unroll
                for (int n = 0; n < 8; ++n) acc[n] = (f32x4){0.f, 0.f, 0.f, 0.f};
                const float* wrow = wsp + ((size_t)g * 128 + i) * 128;
                const size_t trow = t0 + i;
                u32x4 eu[4], eg[4], em[4]; f32x4 wq[4][2];
#pragma unroll
                for (int u = 0; u < 4; ++u) { const int dcol = g * 128 + 32 * u + 8 * kg;
                    eu[u] = *(const u32x4*)(Z + trow * NZ2 + Z2_U + dcol); eg[u] = *(const u32x4*)(Z + trow * NZ2 + Z2_GB + dcol); em[u] = *(const u32x4*)(Mo + trow * D + dcol); }
#pragma unroll
                for (int s = 0; s < 4; ++s) if (32 * s <= 16 * w + 15) { wq[s][0] = *(const f32x4*)(wrow + 32 * s + 8 * kg); wq[s][1] = *(const f32x4*)(wrow + 32 * s + 8 * kg + 4); }
                const unsigned trb = (unsigned)(size_t)(VN + (8 * kg + tq) * VN_STRIDE + tp * 16);
#pragma unroll
                for (int s = 0; s < 4; ++s) {
                    if (32 * s <= 16 * w + 15) {
                        const int jb = 32 * s + 8 * kg;
                        const f32x4 w0 = wq[s][0], w1 = wq[s][1];
                        float m8[8];
#pragma unroll
                        for (int jj = 0; jj < 8; ++jj) { const float v = (jj < 4) ? w0[jj] : w1[jj - 4]; m8[jj] = (jb + jj <= i) ? v : 0.f; }
                        const bf16x8 wf = pack8(m8);
                        TrQ t;
                        const unsigned ad = trb + (unsigned)(32 * s * VN_STRIDE);
                        asm volatile(
                            "ds_read_b64_tr_b16 %0, %16 offset:0\n\tds_read_b64_tr_b16 %1, %16 offset:8\n\tds_read_b64_tr_b16 %2, %16 offset:64\n\tds_read_b64_tr_b16 %3, %16 offset:72\n\t"
                            "ds_read_b64_tr_b16 %4, %16 offset:128\n\tds_read_b64_tr_b16 %5, %16 offset:136\n\tds_read_b64_tr_b16 %6, %16 offset:192\n\tds_read_b64_tr_b16 %7, %16 offset:200\n\t"
                            "ds_read_b64_tr_b16 %8, %16 offset:1088\n\tds_read_b64_tr_b16 %9, %16 offset:1096\n\tds_read_b64_tr_b16 %10, %16 offset:1152\n\tds_read_b64_tr_b16 %11, %16 offset:1160\n\t"
                            "ds_read_b64_tr_b16 %12, %16 offset:1216\n\tds_read_b64_tr_b16 %13, %16 offset:1224\n\tds_read_b64_tr_b16 %14, %16 offset:1280\n\tds_read_b64_tr_b16 %15, %16 offset:1288\n\t"
                            "s_waitcnt lgkmcnt(0)"
                            : "=&v"(t.a[0]), "=&v"(t.a[1]), "=&v"(t.a[2]), "=&v"(t.a[3]), "=&v"(t.a[4]), "=&v"(t.a[5]), "=&v"(t.a[6]), "=&v"(t.a[7]),
                              "=&v"(t.b[0]), "=&v"(t.b[1]), "=&v"(t.b[2]), "=&v"(t.b[3]), "=&v"(t.b[4]), "=&v"(t.b[5]), "=&v"(t.b[6]), "=&v"(t.b[7])
                            : "v"(ad) : "memory");
#pragma unroll
                        for (int n = 0; n < 8; ++n) { const u32x4 vq = (u32x4){t.a[n].x, t.a[n].y, t.b[n].x, t.b[n].y};
                            acc[n] = __builtin_amdgcn_mfma_f32_16x16x32_bf16(__builtin_bit_cast(bf16x8, vq), wf, acc[n], 0, 0, 0); }
                    }
                }
                const float bs = bsp[g * 128 + i];
#pragma unroll
                for (int u = 0; u < 4; ++u) { const int dcol = g * 128 + 32 * u + 8 * kg;
                    float uu[8], gb[8], mm[8], o[8];
                    un8(eu[u], uu); un8(eg[u], gb); un8(em[u], mm);
#pragma unroll
                    for (int r = 0; r < 4; ++r) { o[r] = mm[r] + uu[r] * (acc[2 * u][r] + bs) * gb[r]; o[4 + r] = mm[4 + r] + uu[4 + r] * (acc[2 * u + 1][r] + bs) * gb[4 + r]; }
                    *(bf16x8*)(M2 + trow * D + dcol) = pack8(o); }
            }
            __syncthreads();
        }
    }
}

__device__ __forceinline__ void p5_router(Frame& F, const Args& a) {
    const bf16_t* X2 = (const bf16_t*)(a.ws + WS_H); unsigned char* Hh = (unsigned char*)(a.ws + WS_H2);
    const bf16_t* Wh = (const bf16_t*)(a.ws + WS_MISC + MO_WRT); const bf16_t* Wl = Wh + NE * D;
    int* tok_of = (int*)(a.ws + WS_TOK); int* asg = (int*)(a.ws + WS_MISC + MO_ASG); float* gate = (float*)(a.ws + WS_MISC + MO_GATE);
    const float* g2 = a.in[I_N2G]; const float* br = a.in[I_BR];
    LAS float* LG = (LAS float*)(F.lds + RING_OFF) + F.wave * 512;
    LAS unsigned* LCNT = (LAS unsigned*)(F.lds + RING_OFF + 32768);
    LAS unsigned* LBASE = LCNT + 32;
    const int lane = ((int)(threadIdx.x & 63u)), w = F.wave, tid = ((int)threadIdx.x), fm = lane & 15, kg = lane >> 4;
    for (int blk = F.bid; blk < T / 128; blk += F.G) {
        if (tid < 32) LCNT[tid] = 0u;
        __syncthreads();
        const int tb = blk * 128 + 16 * w;
        const bf16_t* xr = X2 + (size_t)(tb + fm) * D + 8 * kg;
        float ss = 0.f;
        for (int s = 0; s < 32; ++s) { float x8[8]; ld_bf8(xr + 32 * s, x8);
            ss += (x8[0] * x8[0] + x8[1] * x8[1]) + (x8[2] * x8[2] + x8[3] * x8[3]) + (x8[4] * x8[4] + x8[5] * x8[5]) + (x8[6] * x8[6] + x8[7] * x8[7]); }
        ss += __shfl_xor(ss, 16); ss += __shfl_xor(ss, 32);
        const float rstd = __builtin_amdgcn_rsqf(ss * (1.0f / D) + RMS_EPS);
        f32x4 acc[2]; acc[0] = (f32x4){0.f, 0.f, 0.f, 0.f}; acc[1] = acc[0];
        unsigned char* hrow = Hh + (size_t)(tb + fm) * D + 8 * kg;
        u32x4 xq_n = *(const u32x4*)(xr); f32x4 ga_n = *(const f32x4*)(g2 + 8 * kg), gb_n = *(const f32x4*)(g2 + 8 * kg + 4);
        bf16x8 bh_n[2], bl_n[2];
#pragma unroll
        for (int n = 0; n < 2; ++n) { const size_t wo = (size_t)(16 * n + fm) * D + 8 * kg; bh_n[n] = *(const bf16x8*)(Wh + wo); bl_n[n] = *(const bf16x8*)(Wl + wo); }
        for (int s = 0; s < 32; ++s) {
            const u32x4 xq = xq_n; const f32x4 ga = ga_n, gb = gb_n; const bf16x8 bh[2] = {bh_n[0], bh_n[1]}, bl[2] = {bl_n[0], bl_n[1]};
            { const int s1 = (s + 1 < 32) ? s + 1 : 31;
              xq_n = *(const u32x4*)(xr + 32 * s1); ga_n = *(const f32x4*)(g2 + 32 * s1 + 8 * kg); gb_n = *(const f32x4*)(g2 + 32 * s1 + 8 * kg + 4);
#pragma unroll
              for (int n = 0; n < 2; ++n) { const size_t wo = (size_t)(16 * n + fm) * D + 32 * s1 + 8 * kg; bh_n[n] = *(const bf16x8*)(Wh + wo); bl_n[n] = *(const bf16x8*)(Wl + wo); } }
            const float x8[8] = {bf_lo(xq.x), bf_hi(xq.x), bf_lo(xq.y), bf_hi(xq.y), bf_lo(xq.z), bf_hi(xq.z), bf_lo(xq.w), bf_hi(xq.w)};
            float hv[8], lo[8];
#pragma unroll
            for (int j = 0; j < 4; ++j) { hv[j] = x8[j] * rstd * ga[j]; hv[4 + j] = x8[4 + j] * rstd * gb[j]; }
            u32x4 hp; hp.x = cvt_pk_bf16(hv[0], hv[1]); hp.y = cvt_pk_bf16(hv[2], hv[3]); hp.z = cvt_pk_bf16(hv[4], hv[5]); hp.w = cvt_pk_bf16(hv[6], hv[7]);
            *(u32x2*)(hrow + 32 * s) = (u32x2){cvt_pk4_fp8(clamp448(hv[0]), clamp448(hv[1]), clamp448(hv[2]), clamp448(hv[3])), cvt_pk4_fp8(clamp448(hv[4]), clamp448(hv[5]), clamp448(hv[6]), clamp448(hv[7]))};
            lo[0] = hv[0] - bf_lo(hp.x); lo[1] = hv[1] - bf_hi(hp.x); lo[2] = hv[2] - bf_lo(hp.y); lo[3] = hv[3] - bf_hi(hp.y);
            lo[4] = hv[4] - bf_lo(hp.z); lo[5] = hv[5] - bf_hi(hp.z); lo[6] = hv[6] - bf_lo(hp.w); lo[7] = hv[7] - bf_hi(hp.w);
            const bf16x8 ah = __builtin_bit_cast(bf16x8, hp), al = pack8(lo);
#pragma unroll
            for (int n = 0; n < 2; ++n) {
                acc[n] = __builtin_amdgcn_mfma_f32_16x16x32_bf16(bh[n], ah, acc[n], 0, 0, 0);
                acc[n] = __builtin_amdgcn_mfma_f32_16x16x32_bf16(bh[n], al, acc[n], 0, 0, 0);
                acc[n] = __builtin_amdgcn_mfma_f32_16x16x32_bf16(bl[n], ah, acc[n], 0, 0, 0); }
        }
#pragma unroll
        for (int n = 0; n < 2; ++n) { const f32x4 bb = *(const f32x4*)(br + 16 * n + 4 * kg); *(LAS f32x4*)(LG + fm * 32 + 16 * n + 4 * kg) = acc[n] + bb; }
        LDS_WAIT(); asm volatile("" ::: "memory");
        int se[4] = {0, 0, 0, 0}; unsigned sr[4] = {0u, 0u, 0u, 0u}; float sg[4] = {0.f, 0.f, 0.f, 0.f};
        if (lane < 16) {
            float lv[32];
#pragma unroll
            for (int e4 = 0; e4 < 8; ++e4) { const f32x4 v = *(LAS f32x4*)(LG + lane * 32 + 4 * e4); lv[4 * e4] = v.x; lv[4 * e4 + 1] = v.y; lv[4 * e4 + 2] = v.z; lv[4 * e4 + 3] = v.w; }
            float tv[4];
#pragma unroll
            for (int k = 0; k < 4; ++k) { float best = -3.0e38f; int bi = 0;
#pragma unroll
                for (int e = 0; e < 32; ++e) { const bool taken = (k > 0 && se[0] == e) || (k > 1 && se[1] == e) || (k > 2 && se[2] == e); if (!taken && lv[e] > best) { best = lv[e]; bi = e; } }
                se[k] = bi; tv[k] = best; }
            const float e1 = __expf(tv[1] - tv[0]), e2 = __expf(tv[2] - tv[0]), e3 = __expf(tv[3] - tv[0]); const float inv = 1.0f / (1.0f + e1 + e2 + e3);
            sg[0] = inv; sg[1] = e1 * inv; sg[2] = e2 * inv; sg[3] = e3 * inv;
#pragma unroll
            for (int k = 0; k < 4; ++k) sr[k] = atomicAdd((unsigned*)(LCNT + se[k]), 1u);
        }
        __syncthreads();
        if (tid < 32) LBASE[tid] = atomicAdd(F.ctl + CW_CNT + 64 * tid, (unsigned)LCNT[tid]);
        __syncthreads();
        if (lane < 16) { const int tok = tb + lane;
#pragma unroll
            for (int k = 0; k < 4; ++k) { const int pos = (int)(LBASE[se[k]] + sr[k]);
                tok_of[(size_t)se[k] * T + pos] = tok; asg[(size_t)tok * 8 + 2 * k] = se[k]; asg[(size_t)tok * 8 + 2 * k + 1] = pos; gate[(size_t)tok * 4 + k] = sg[k]; }
        }
        __syncthreads();
    }
}

__device__ __forceinline__ void moe_tables(Frame& F) {
    LAS int* cnt = (LAS int*)(F.lds + SCHED_OFF); LAS int* mts = cnt + 32;
    if (((int)threadIdx.x) == 0) { int acc = 0;
        for (int e = 0; e < NE; ++e) { const int c = (int)__hip_atomic_load(F.ctl + CW_CNT + 64 * e, RLX_AGENT); cnt[e] = c; mts[e] = acc; acc += (c + 255) >> 8; }
        mts[NE] = acc; }
    __syncthreads();
}
template <int NTN, bool GATH>
struct MoeOrder {
    static constexpr int MOE_ROWB = 1024;
    static constexpr bool GATHER = GATH;
    LAS const int* cnt; LAS const int* mts; const char* A; const char* B; const int* tok_of; int G, c, Mtiles;
    __device__ void init(Frame& F, const void* A_, const void* B_, const int* tok) { cnt = (LAS const int*)(F.lds + SCHED_OFF); mts = cnt + 32; A = (const char*)A_; B = (const char*)B_; tok_of = tok; G = F.G; c = F.bid; Mtiles = mts[NE]; }
    __device__ bool next(int i, pg8::Unit& u) const {
        constexpr int MPS = 32 / NTN;
        int mt, nt_;
        if ((G & 7) == 0) { const int s = i * 8 + (c & 7), j = (c >> 3) + 0; const int per = G >> 3;
            if (per == 32) { mt = s * MPS + (j % MPS); nt_ = j / MPS; }
            else { const int L = i * G + c; mt = L / NTN; nt_ = L % NTN; } }
        else { const int L = i * G + c; mt = L / NTN; nt_ = L % NTN; }
        if (mt >= Mtiles) return false;
        int e = 0;
        for (int k = 1; k < NE; ++k) e += (mts[k] <= mt) ? 1 : 0;
        const int mloc = mt - mts[e];
        u.e = e; u.r0 = mt * 256; u.c0 = nt_ * 256; u.aux = mloc;
        u.B = B + ((size_t)e * NTN + nt_) * (256 * MOE_ROWB);
        u.A = GATH ? A : A + (size_t)mt * (256 * MOE_ROWB);
        return true;
    }
    __device__ __forceinline__ void a_offs(const pg8::Unit& u, unsigned (&ga)[2][2], const int (&R)[2], const int (&C)[2]) const {
        if constexpr (GATH) {
            const int n = cnt[u.e]; const int* tp = tok_of + (size_t)u.e * T + u.aux * 256;
            int tk[2][2];
#pragma unroll
            for (int h = 0; h < 2; ++h)
#pragma unroll
                for (int i = 0; i < 2; ++i) tk[h][i] = tp[h * 128 + R[i]];
            VM_WAIT();
#pragma unroll
            for (int h = 0; h < 2; ++h)
#pragma unroll
                for (int i = 0; i < 2; ++i) { const int t_ = (u.aux * 256 + h * 128 + R[i] < n) ? tk[h][i] : 0; ga[h][i] = (unsigned)(t_ * MOE_ROWB + C[i] * 2); }
        } else {
#pragma unroll
            for (int h = 0; h < 2; ++h)
#pragma unroll
                for (int i = 0; i < 2; ++i) ga[h][i] = (unsigned)((h * 128 + R[i]) * MOE_ROWB + C[i] * 2);
        }
    }
};

__device__ __forceinline__ void p8_final(Frame& F, const Args& a) {
    int ln_ = (int)threadIdx.x; asm volatile("" : "+v"(ln_)); ln_ &= 63;
    LAS const int* mts = (LAS const int*)(F.lds + SCHED_OFF) + 32;
    const bf16_t* YS = (const bf16_t*)(a.ws + WS_YS); const int* asg = (const int*)(a.ws + WS_MISC + MO_ASG); const float* gate = (const float*)(a.ws + WS_MISC + MO_GATE);
    float* out = a.out; const float* gf = a.in[I_NFG];
    const int gw = F.bid * NWAVES + F.wave, NGW = F.G * NWAVES;
    f32x4 gv[4];
#pragma unroll
    for (int j = 0; j < 4; ++j) gv[j] = *((const f32x4*)gf + ln_ + 64 * j);
    for (int m = gw; m < T; m += NGW) {
        f32x4* xr = (f32x4*)(out + (size_t)m * D) + ln_;
        const bf16_t* x2r = (const bf16_t*)(a.ws + WS_H) + (size_t)m * D + 4 * ln_;
        f32x4 v[4];
#pragma unroll
        for (int j = 0; j < 4; ++j) v[j] = ld_bf4(x2r + 256 * j);
#pragma unroll
        for (int k = 0; k < 4; ++k) { const int e = asg[(size_t)m * 8 + 2 * k], pos = asg[(size_t)m * 8 + 2 * k + 1]; const float gk = gate[(size_t)m * 4 + k];
            const bf16_t* yr = YS + ((size_t)mts[e] * 256 + pos) * D + 4 * ln_;
#pragma unroll
            for (int j = 0; j < 4; ++j) v[j] += gk * ld_bf4(yr + 256 * j); }
        float s = 0.f;
#pragma unroll
        for (int j = 0; j < 4; ++j) s += (v[j].x * v[j].x + v[j].y * v[j].y) + (v[j].z * v[j].z + v[j].w * v[j].w);
        const float rstd = __builtin_amdgcn_rsqf(wave_sum(s) * (1.f / D) + RMS_EPS);
#pragma unroll
        for (int j = 0; j < 4; ++j) xr[64 * j] = v[j] * rstd * gv[j];
    }
}

constexpr int N_PHASES = 10;
__global__ void __launch_bounds__(NWAVES * 64, 2) mk_fwd(Args args) {
    extern __shared__ __attribute__((aligned(16))) unsigned char lds[];
    Frame F;
    F.lds = (LAS unsigned char*)lds;
    F.MISC = (volatile LAS unsigned*)(F.lds + MISC_OFF);
    F.wave = __builtin_amdgcn_readfirstlane(((int)threadIdx.x) >> 6);
    F.G = gridDim.x; F.bid = blockIdx.x;
    F.ctl = (unsigned*)(args.ws + WS_CTL);
    for (int u = ((int)threadIdx.x); u < (LDS_BYTES - LDSCTL_OFF) / 4; u += NWAVES * 64) ((LAS unsigned*)(F.lds + LDSCTL_OFF))[u] = 0u;
    __syncthreads();
    const int lo = args.ph_lo, hi = args.ph_hi;
    const bool multi = (hi - lo) > 1;
    XcdBarrier bar; bar.bar = F.ctl + CW_BAR; bar.x = 0; bar.st = nullptr;
    if (multi) bar = xcd_barrier_post(F.ctl + CW_BAR, F.MISC + 8);
#define IN(k) (lo <= (k) && (k) < hi)
#define SEAM(k) do { if (IN(k) && IN((k) + 1)) xcd_barrier(bar); } while (0)
    unsigned char* ws = args.ws;

#define P1_BODY {     \
        { pg8::StaticOrderT<false> S; S.init(ws + WS_H, ws + WS_BIN, T, P1_BFN * 256, F.G, F.bid); S.wgm = P1_WGM; S.n_add0 = P1_BF0; \
          pg8::EpiZT<false> E{(bf16_t*)(ws + WS_Z), (const float*)(ws + WS_MISC + MO_BIASZ), (bf16_t*)(ws + WS_HM)}; \
          pg8::gemm_phase<pg8::EpiZT<false>, pg8::StaticOrderT<false>, true>(F.lds + RING_OFF, S, E); } \
        { pg8::StaticOrderT<true> S; S.init(ws + WS_H8, ws + WS_BIN8, T, NZ - P1_BFN * 256, F.G, F.bid); S.wgm = P1_WGM; S.n_split = P1_BF0; S.n_add0 = 0; S.n_add1 = P1_BFN; \
          pg8::EpiZT<true> E{(bf16_t*)(ws + WS_Z), (const float*)(ws + WS_MISC + MO_BIASZ), (bf16_t*)(ws + WS_HM)}; \
          pg8::gemm_phase<pg8::EpiZT<true>, pg8::StaticOrderT<true>, true>(F.lds + RING_OFF, S, E); } }
#define P4_BODY {     \
        pg8::StaticOrder S; S.init(ws + WS_M2, ws + WS_BOUT, T, D, F.G, F.bid); \
        pg8::EpiRes E{(bf16_t*)(ws + WS_H), args.in[I_X]}; \
        pg8::gemm_phase<pg8::EpiRes, pg8::StaticOrder, true>(F.lds + RING_OFF, S, E); }
#define P6_BODY {     \
        moe_tables(F); \
        MoeOrder<8, true> S; S.init(F, ws + WS_H2, ws + WS_BGU, (const int*)(ws + WS_TOK)); \
        pg8::EpiSwiglu E{(unsigned char*)(ws + WS_ACT), (const float*)(ws + WS_MISC + MO_BGU)}; \
        pg8::gemm_phase<pg8::EpiSwiglu, MoeOrder<8, true>, true>(F.lds + RING_OFF, S, E); }
#define P7_BODY {     \
        moe_tables(F); \
        MoeOrder<4, false> S; S.init(F, ws + WS_ACT, ws + WS_BD, nullptr); \
        pg8::EpiDown E{(bf16_t*)(ws + WS_YS), args.in[I_BDN]}; \
        pg8::gemm_phase<pg8::EpiDown, MoeOrder<4, false>, true>(F.lds + RING_OFF, S, E); }
    if (IN(0)) { p0_prologue(F, args); if (PROBE_REP == 0) p0_prologue(F, args); SEAM(0); }
    if (IN(1)) { P1_BODY if (PROBE_REP == 1) P1_BODY SEAM(1); }
    if (IN(2)) { p2a_act(F, args); SEAM(2); }
    if (IN(3)) { p2_scan(F, args); if (PROBE_REP == 2) p2_scan(F, args); SEAM(3); }
    if (IN(4)) { for (int rep_ = 0; rep_ < (PROBE_REP == 3 ? 2 : 1); ++rep_) p3_gmlp(F, args); SEAM(4); }
    if (IN(5)) { P4_BODY if (PROBE_REP == 4) P4_BODY SEAM(5); }
    if (IN(6)) { p5_router(F, args); SEAM(6); }
    if (IN(7)) { P6_BODY if (PROBE_REP == 6) P6_BODY SEAM(7); }
    if (IN(8)) { P7_BODY if (PROBE_REP == 7) P7_BODY SEAM(8); }
    if (IN(9)) { moe_tables(F); p8_final(F, args); }
#undef IN
#undef SEAM
}

extern "C" void kernel_launch(void* const* d_in, const int* in_sizes, int n_in, void* d_out, int out_size, void* d_ws, size_t ws_size, hipStream_t stream) {
    static int grid = 0;
    if (grid == 0) {
        if (n_in != 28 || out_size != T * D || ws_size < WS_END) { fprintf(stderr, "kernel_launch: unexpected problem (n_in %d, out %d, ws %zu); nothing launched\n", n_in, out_size, ws_size); grid = -1; return; }
        int dev = 0, cus = 0, per_cu = 0;
        if (hipGetDevice(&dev) != hipSuccess || hipDeviceGetAttribute(&cus, hipDeviceAttributeMultiprocessorCount, dev) != hipSuccess) { grid = -1; return; }
        if (hipFuncSetAttribute((const void*)mk_fwd, hipFuncAttributeMaxDynamicSharedMemorySize, LDS_BYTES) != hipSuccess) { fprintf(stderr, "kernel_launch: hipFuncSetAttribute failed\n"); grid = -1; return; }
        if (hipOccupancyMaxActiveBlocksPerMultiprocessor(&per_cu, (const void*)mk_fwd, NWAVES * 64, LDS_BYTES) != hipSuccess || per_cu < 1)
            fprintf(stderr, "kernel_launch: note: occupancy query reports %d workgroups per CU\n", per_cu);
        (void)hipGetLastError();
        grid = cus;
    }
    if (grid < 0) return;
    if (hipMemsetAsync((char*)d_ws + WS_CTL, 0, CTL_ZERO_BYTES, stream) != hipSuccess) return;
    Args a{};
    for (int i = 0; i < 28; ++i) a.in[i] = (const float*)d_in[i];
    a.out = (float*)d_out; a.ws = (unsigned char*)d_ws;
    if (MK_N_LAUNCHES == 1) { a.ph_lo = 0; a.ph_hi = N_PHASES; hipLaunchKernelGGL(mk_fwd, dim3(grid), dim3(NWAVES * 64), LDS_BYTES, stream, a); }
    else for (int p = 0; p < N_PHASES; ++p) { a.ph_lo = p; a.ph_hi = p + 1; hipLaunchKernelGGL(mk_fwd, dim3(grid), dim3(NWAVES * 64), LDS_BYTES, stream, a); }
}
```
